# Optimizing an MI355X kernel written in HIP

```python
import jax, jax.numpy as jnp
from jax import lax
import numpy as np

D_MODEL = 1024
BATCH = 2
SEQ = 8192
DEPTH = 2

CTX_LEN = 256
GRID_W = 64
D_MIX = D_MODEL
GLA_WIDTH = D_MIX // 2
CONV_WIDTH = D_MIX // 4
POOL_WIDTH = D_MIX - GLA_WIDTH - CONV_WIDTH
GLA_HEADS = 4
GLA_DV = GLA_WIDTH // GLA_HEADS
GLA_DK = GLA_DV // 2
GLA_KEY_WIDTH = GLA_HEADS * GLA_DK
GATE_RANK = 16
GATE_TAU = 16.0
CHUNK = 64
CONV_K = 3
CONV_HEADS = 4
POOL_WINDOWS = (2, 4, 8, 16)
POOL_GROUP = POOL_WIDTH // len(POOL_WINDOWS)
D_FF = 4 * D_MODEL
N_MOD = 6
EPS = 1e-6

Q_OFF = 0
K_OFF = Q_OFF + GLA_KEY_WIDTH
V_OFF = K_OFF + GLA_KEY_WIDTH
G_OFF = V_OFF + GLA_WIDTH
R_OFF = G_OFF + 2 * GATE_RANK
CB_OFF = R_OFF + GLA_WIDTH
CC_OFF = CB_OFF + CONV_WIDTH
CH_OFF = CC_OFF + CONV_WIDTH
P_OFF = CH_OFF + CONV_WIDTH
IN_COLS = P_OFF + POOL_WIDTH

kernel_name = 'hybrid_gla_conv_pool_dit_trunk'


def rmsnorm(x, w):
    xf = x.astype(jnp.float32)
    y = xf * lax.rsqrt(jnp.mean(xf * xf, axis=-1, keepdims=True) + EPS)
    return (y * w.astype(jnp.float32)).astype(x.dtype)


def modulate(x, w, shift, scale):
    return rmsnorm(x, w) * (1 + scale) + shift


def adaln(cvec, w_mod, b_mod, n):
    m = jax.nn.silu(cvec) @ w_mod[:, : n * D_MODEL] + b_mod[: n * D_MODEL]
    return jnp.split(m, n, axis=-1)


def to_heads(t, h):
    b, n, w = t.shape
    return t.reshape(b, n, h, w // h).transpose(0, 2, 1, 3)


def rev(t):
    return jnp.flip(t, axis=2)


def gla_kvg(k_raw, v_raw, z_raw, gate_w, gate_b):
    k = to_heads(k_raw, GLA_HEADS).astype(jnp.float32)
    v = to_heads(v_raw, GLA_HEADS).astype(jnp.float32)
    gates = tuple(
        to_heads(jax.nn.log_sigmoid((z_raw[..., d * GATE_RANK:(d + 1) * GATE_RANK] @ gate_w[d]
                                     + gate_b[d]).astype(jnp.float32)) / GATE_TAU, GLA_HEADS)
        for d in range(2))
    return k, v, gates


def gla_chunked(q, k, v, g, s0):
    bsz, h, n, _ = q.shape
    nc = n // CHUNK
    ch = lambda t: t.reshape(bsz, h, nc, CHUNK, t.shape[-1])
    q, k, v, g = ch(q), ch(k), ch(v), ch(g)
    b = jnp.cumsum(g, axis=3)
    b_last = b[:, :, :, -1:, :]
    u = jnp.einsum('bhncd,bhnce->bhnde', k * jnp.exp(b_last - b), v)
    decay = jnp.exp(b_last[:, :, :, 0, :])

    def step(s, inp):
        u_n, a_n = inp
        return a_n[..., None] * s + u_n, s

    s_final, s_before = lax.scan(step, s0, (jnp.moveaxis(u, 2, 0), jnp.moveaxis(decay, 2, 0)))
    s_before = jnp.moveaxis(s_before, 0, 2)
    qe = q * jnp.exp(b)
    ki = k * jnp.exp(-b)
    tri = jnp.tril(jnp.ones((CHUNK, CHUNK), dtype=bool))
    a = jnp.where(tri, jnp.einsum('bhntd,bhnsd->bhnts', qe, ki), 0.0)
    o = jnp.einsum('bhnts,bhnse->bhnte', a, v) + jnp.einsum('bhntd,bhnde->bhnte', qe, s_before)
    return o.reshape(bsz, h, n, -1), s_final


def gla_final_state(k, v, g):
    gc = jnp.cumsum(g, axis=2)
    return jnp.einsum('bhnd,bhne->bhde', k * jnp.exp(gc[:, :, -1:, :] - gc), v)


def gla_bidir(q, k, v, gates, s_init):
    o_f, s_f = gla_chunked(q, k, v, gates[0], s_init[0])
    o_b, s_b = gla_chunked(rev(q), rev(k), rev(v), rev(gates[1]), s_init[1])
    return o_f + rev(o_b), (s_f, s_b)


def gla_out(o, r, norm_w):
    o = o * lax.rsqrt(jnp.mean(o * o, axis=-1, keepdims=True) + EPS) * norm_w.astype(jnp.float32)
    bsz, h, n, dv = o.shape
    o = o.transpose(0, 2, 1, 3).reshape(bsz, n, h * dv)
    return (o * jax.nn.silu(r.astype(jnp.float32))).astype(r.dtype)


def short_conv(bg, cg, hv, conv_w):
    z = cg * hv
    length = z.shape[-2]
    zp = jnp.pad(z, [(0, 0)] * (z.ndim - 2) + [(CONV_K // 2, CONV_K // 2), (0, 0)])
    y = sum(conv_w[j] * zp[..., j:j + length, :] for j in range(CONV_K))
    return bg * y


def multi_scale_pool(u, pool_w, pool_scale):
    length = u.shape[-2]
    uf = u.astype(jnp.float32)
    cs = jnp.concatenate([jnp.zeros_like(uf[..., :1, :]), jnp.cumsum(uf, axis=-2)], axis=-2)
    t = np.arange(length)
    outs = []
    for gi, w in enumerate(POOL_WINDOWS):
        lo = np.clip(t - w // 2, 0, length)
        hi = np.clip(t + w // 2, 0, length)
        sl = slice(gi * POOL_GROUP, (gi + 1) * POOL_GROUP)
        csg = cs[..., sl]
        mean = (jnp.take(csg, hi, axis=-2) - jnp.take(csg, lo, axis=-2)) / (hi - lo).astype(np.float32)[:, None]
        outs.append(mean - uf[..., sl])
    p = jnp.stack(outs, axis=-2)
    y = jnp.einsum('...lgc,gcd->...lgd', p, pool_w.astype(jnp.float32))
    y = y.reshape(y.shape[:-2] + (POOL_WIDTH,)) * pool_scale.astype(jnp.float32)
    return y.astype(u.dtype)


def mix_and_mlp(x, proj, o_gla, n_seg, g1, sh2, sc2, g2, norm2_w, gla_norm_w, conv_w, pool_w,
                pool_scale, w_out, w_mlp1, w_mlp2):
    bsz, n, _ = proj.shape
    seg = lambda t: t.reshape(bsz, n_seg, n // n_seg, t.shape[-1])
    y_gla = gla_out(o_gla, proj[..., R_OFF:CB_OFF], gla_norm_w)
    y_conv = short_conv(seg(proj[..., CB_OFF:CC_OFF]), seg(proj[..., CC_OFF:CH_OFF]),
                        seg(proj[..., CH_OFF:P_OFF]), conv_w).reshape(bsz, n, CONV_WIDTH)
    y_pool = multi_scale_pool(seg(proj[..., P_OFF:IN_COLS]), pool_w, pool_scale).reshape(bsz, n, POOL_WIDTH)
    mix = jnp.concatenate([y_gla, y_conv, y_pool], axis=-1) @ w_out
    x = x + g1 * mix
    h2 = modulate(x, norm2_w, sh2, sc2)
    return x + g2 * (jnp.square(jax.nn.relu(h2 @ w_mlp1)) @ w_mlp2)


def setup_inputs(seed: int = 0) -> dict:
    key = jax.random.key(seed)
    ks = jax.random.split(key, 20)
    f32 = jnp.float32
    nrm = lambda k, shape, s: jax.random.normal(k, shape, f32) * s
    return {
        'x': nrm(ks[0], (BATCH, SEQ, D_MODEL), 1.0),
        'c': nrm(ks[1], (BATCH, D_MODEL), 1.0),
        'ctx': nrm(ks[2], (BATCH, CTX_LEN, D_MODEL), 1.0),
        'c_ctx': nrm(ks[3], (D_MODEL,), 1.0),
        'w_mod': nrm(ks[4], (DEPTH, D_MODEL, N_MOD * D_MODEL), 0.5 * D_MODEL ** -0.5),
        'b_mod': nrm(ks[5], (DEPTH, N_MOD * D_MODEL), 0.02),
        'norm1_w': 1.0 + nrm(ks[6], (DEPTH, D_MODEL), 0.02),
        'norm2_w': 1.0 + nrm(ks[7], (DEPTH, D_MODEL), 0.02),
        'w_in': nrm(ks[8], (DEPTH, D_MODEL, IN_COLS), D_MODEL ** -0.5),
        'gla_gate_w': nrm(ks[9], (DEPTH, 2, GATE_RANK, GLA_KEY_WIDTH), GATE_RANK ** -0.5),
        'gla_gate_b': jax.random.uniform(ks[10], (DEPTH, 2, GLA_KEY_WIDTH), f32, 1.0, 5.0),
        'gla_norm_w': 1.0 + nrm(ks[11], (DEPTH, GLA_DV), 0.02),
        'conv_w': nrm(ks[12], (DEPTH, CONV_K, CONV_WIDTH), CONV_K ** -0.5),
        'pool_w': nrm(ks[13], (DEPTH, len(POOL_WINDOWS), POOL_GROUP, POOL_GROUP), POOL_GROUP ** -0.5),
        'pool_scale': 1.0 + nrm(ks[14], (DEPTH, POOL_WIDTH), 0.02),
        'w_out': nrm(ks[15], (DEPTH, D_MIX, D_MODEL), D_MIX ** -0.5),
        'w_mlp1': nrm(ks[16], (DEPTH, D_MODEL, D_FF), D_MODEL ** -0.5),
        'w_mlp2': nrm(ks[17], (DEPTH, D_FF, D_MODEL), D_FF ** -0.5),
        'final_norm_w': 1.0 + nrm(ks[18], (D_MODEL,), 0.02),
    }


def reference(x, c, ctx, c_ctx, w_mod, b_mod, norm1_w, norm2_w, w_in, gla_gate_w, gla_gate_b,
              gla_norm_w, conv_w, pool_w, pool_scale, w_out, w_mlp1, w_mlp2, final_norm_w):
    bsz, n, _ = x.shape
    rows = n // GRID_W
    xc = ctx
    for l in range(DEPTH):
        last = l == DEPTH - 1
        sh1, sc1, g1, sh2, sc2, g2 = [m[:, None, :] for m in adaln(c, w_mod[l], b_mod[l], N_MOD)]
        h = modulate(x, norm1_w[l], sh1, sc1)
        proj = h @ w_in[l]
        q = to_heads(proj[..., Q_OFF:K_OFF], GLA_HEADS).astype(jnp.float32) * GLA_DK ** -0.5
        k, v, gates = gla_kvg(proj[..., K_OFF:V_OFF], proj[..., V_OFF:G_OFF], proj[..., G_OFF:R_OFF],
                              gla_gate_w[l], gla_gate_b[l])
        if last:
            csh1, csc1 = adaln(c_ctx, w_mod[l], b_mod[l], 2)
            hc = modulate(xc, norm1_w[l], csh1, csc1)
            pc = hc @ w_in[l][:, K_OFF:R_OFF]
            kc, vc, gc = gla_kvg(pc[..., :V_OFF - K_OFF], pc[..., V_OFF - K_OFF:G_OFF - K_OFF],
                                 pc[..., G_OFF - K_OFF:], gla_gate_w[l], gla_gate_b[l])
            s_ctx = (gla_final_state(kc, vc, gc[0]), gla_final_state(rev(kc), rev(vc), rev(gc[1])))
        else:
            csh1, csc1, cg1, csh2, csc2, cg2 = adaln(c_ctx, w_mod[l], b_mod[l], N_MOD)
            hc = modulate(xc, norm1_w[l], csh1, csc1)
            pc = hc @ w_in[l]
            qc = to_heads(pc[..., Q_OFF:K_OFF], GLA_HEADS).astype(jnp.float32) * GLA_DK ** -0.5
            kc, vc, gc = gla_kvg(pc[..., K_OFF:V_OFF], pc[..., V_OFF:G_OFF], pc[..., G_OFF:R_OFF],
                                 gla_gate_w[l], gla_gate_b[l])
            s0 = jnp.zeros((bsz, GLA_HEADS, GLA_DK, GLA_DV), jnp.float32)
            oc, s_ctx = gla_bidir(qc, kc, vc, gc, (s0, s0))
            xc = mix_and_mlp(xc, pc, oc, 1, cg1, csh2, csc2, cg2, norm2_w[l], gla_norm_w[l], conv_w[l],
                             pool_w[l], pool_scale[l], w_out[l], w_mlp1[l], w_mlp2[l])
        o_lat, _ = gla_bidir(q, k, v, gates, s_ctx)
        x = mix_and_mlp(x, proj, o_lat, rows, g1, sh2, sc2, g2, norm2_w[l], gla_norm_w[l], conv_w[l],
                        pool_w[l], pool_scale[l], w_out[l], w_mlp1[l], w_mlp2[l])
    return rmsnorm(x, final_norm_w)
```

```cpp
#include <hip/hip_runtime.h>
#include <hip/hip_cooperative_groups.h>
#include <cstdio>
namespace cg = cooperative_groups;
__device__ __forceinline__ int tid_opaque() { int t = threadIdx.x; asm volatile("" : "+v"(t)); return t; }
__device__ __forceinline__ int bid_opaque() { int t = blockIdx.x; asm volatile("" : "+s"(t)); return t; }
namespace pg8 {
#define PG8_LAS __attribute__((address_space(3)))
typedef unsigned short bf16_t;
typedef short bf16x8 __attribute__((ext_vector_type(8)));
typedef float f32x4 __attribute__((ext_vector_type(4)));
typedef unsigned u32x4 __attribute__((ext_vector_type(4)));
constexpr int BM = 256, BK = 64, HALF = 128, HTB = HALF * BK * 2  , STAGE_BYTES = 8 * HTB, NXCD = 8, WGM = 8;

__host__ __device__ __forceinline__ int lds_byte(int r, int c) { const int st = (r >> 4) * 2 + (c >> 5), rr = r & 15, cc = c & 31, ob = rr * 64 + cc * 2; return st * 1024 + (ob ^ (((ob >> 9) & 1) << 5)); }
__host__ __device__ __forceinline__ void stage_rc(int b, int& R, int& C) { const int st = b / 1024, sb = b % 1024, swz = sb ^ (((sb >> 9) & 1) << 5); R = (st >> 1) * 16 + swz / 64; C = (st & 1) * 32 + (swz % 64) / 2; }
__host__ __device__ __forceinline__ int perm32(int rho) { const int n = rho >> 4, i = rho & 15; return 8 * (i >> 2) + 4 * n + (i & 3); }

struct Unit { int pm, pn, kofs, nt; };
struct Gemm { const bf16_t* A; const bf16_t* Bt; int M, N, K, ld; };

struct StaticOrder {
    int nM, nN, nwg, G, c, ntk;
    __host__ __device__ void init(int M, int N, int G_, int c_) { nM = M / BM; nN = N / BM; nwg = nM * nN; G = G_; c = c_; }
    __host__ __device__ bool next(int i, Unit& u) const {
        const long L = (long)i * G + c; if (L >= nwg) return false;
        int wgid = (int)L; { const int q = nwg / NXCD, r = nwg % NXCD, xcd = wgid % NXCD, off = wgid / NXCD; wgid = (xcd < r ? xcd * (q + 1) : r * (q + 1) + (xcd - r) * q) + off; }
        const int nig = WGM * nN, gid = wgid / nig, fm = gid * WGM, gsz = (nM - fm) < WGM ? (nM - fm) : WGM;
        u.pm = fm + ((wgid % nig) % gsz); u.pn = (wgid % nig) / gsz; u.kofs = 0; u.nt = ntk; return true;
    }
    __device__ __forceinline__ void a_ready(const Unit&) const {}
    __device__ __forceinline__ void done(const Unit&) const {}
};
struct MixedOrder {
    StaticOrder lat; int nks, kslice;
    __device__ __forceinline__ bool next(int i, Unit& u) const {
        const int L = i * lat.G + lat.c;
        if (L < lat.nwg) return lat.next(i, u);
        const int j = L - lat.nwg; if (j >= 8 * nks) return false;
        u.pm = 64 + (j & 1); u.pn = (j >> 1) & 3; u.kofs = (j >> 3) * kslice; u.nt = kslice / BK; return true;
    }
    __device__ __forceinline__ void a_ready(const Unit&) const {}
    __device__ __forceinline__ void done(const Unit&) const {}
};
__device__ __forceinline__ unsigned cvt_pk_bf16(float lo, float hi) { unsigned r; asm volatile("v_cvt_pk_bf16_f32 %0, %1, %2" : "=v"(r) : "v"(lo), "v"(hi)); return r; }
template <class Epi, class Sched, bool ALIGN_EPI = false, bool SP2 = false>
__device__ __forceinline__ void gemm_phase(PG8_LAS unsigned char* lds, const Gemm g, const Sched& S, const Epi& E) {
    const int tid = tid_opaque(), wid = __builtin_amdgcn_readfirstlane(tid >> 6), lane = tid & 63, wr = wid >> 2, wc = wid & 3, fr = lane & 15, fq = lane >> 4;
    const int LD = g.ld;
    unsigned voffA[2], voffB[2];
#pragma unroll
    for (int i = 0; i < 2; ++i) { int R, C; stage_rc(tid * 16 + i * 8192, R, C); const int Rb = Epi::PERM ? ((R & ~31) + perm32(R & 31)) : R;
        voffA[i] = (unsigned)(R * LD + C) * 2u; voffB[i] = (unsigned)(Rb * LD + C) * 2u; }
    const size_t kstep = (size_t)(BK * 2);
    const size_t hstep = (size_t)HALF * LD * 2;
    const size_t tstep = 2 * hstep;
    const unsigned ldsw = (unsigned)wid * 1024u;
    const int aoff = lds_byte(wr * 64 + fr, fq * 8), boff = lds_byte(wc * 32 + fr, fq * 8);
#define PG8_SA(b, h) (((b) * 2 + (h)) * HTB)
#define PG8_SB(b, h) ((4 + (b) * 2 + (h)) * HTB)
#define PG8_STAGE(bufoff, gbase, voff) do { _Pragma("unroll") for (int _i = 0; _i < 2; ++_i) \
        __builtin_amdgcn_global_load_lds((const unsigned*)((const char*)(gbase) + (voff)[_i]), (PG8_LAS unsigned*)(lds + (bufoff) + ldsw + _i * 8192), 16, 0, 0); } while (0)
#define PG8_LDA(dst, b, h) do { _Pragma("unroll") for (int m = 0; m < 4; ++m) _Pragma("unroll") for (int k = 0; k < 2; ++k) dst[m][k] = *(const PG8_LAS bf16x8*)(lds + PG8_SA(b, h) + aoff + m * 2048 + k * 1024); } while (0)
#define PG8_LDB(dst, b, h) do { _Pragma("unroll") for (int n = 0; n < 2; ++n) _Pragma("unroll") for (int k = 0; k < 2; ++k) dst[n][k] = *(const PG8_LAS bf16x8*)(lds + PG8_SB(b, h) + boff + n * 2048 + k * 1024); } while (0)
#define PG8_MMA(ai, bj, At, Bt) do { __builtin_amdgcn_s_setprio(1); _Pragma("unroll") for (int m = 0; m < 4; ++m) _Pragma("unroll") for (int n = 0; n < 2; ++n) _Pragma("unroll") for (int k = 0; k < 2; ++k) \
        acc[ai][bj][m][n] = __builtin_amdgcn_mfma_f32_16x16x32_bf16(Bt[n][k], At[m][k], acc[ai][bj][m][n], 0, 0, 0); __builtin_amdgcn_s_setprio(0); } while (0)
#define PG8_WAIT_V(n) asm volatile("s_waitcnt vmcnt(" #n ")" ::: "memory")
#define PG8_WAIT_L(n) asm volatile("s_waitcnt lgkmcnt(" #n ")" ::: "memory")
#define PG8_BAR __builtin_amdgcn_s_barrier()
#define PG8_SCHED __builtin_amdgcn_sched_barrier(0)
    Unit cur, nxt; int ui = 0;
    if (!S.next(0, cur)) return;
    f32x4 acc[2][2][4][2];
#pragma unroll
    for (int a = 0; a < 2; ++a)
#pragma unroll
        for (int b = 0; b < 2; ++b)
#pragma unroll
            for (int m = 0; m < 4; ++m)
#pragma unroll
                for (int n = 0; n < 2; ++n) acc[a][b][m][n] = (f32x4){0.f, 0.f, 0.f, 0.f};
    bf16x8 At[4][2], B0[2][2], B1[2][2];
    const char* cA = (const char*)g.A + (size_t)cur.pm * tstep + (size_t)cur.kofs * 2; const char* cB = (const char*)g.Bt + (size_t)cur.pn * tstep + (size_t)cur.kofs * 2;
    S.a_ready(cur);
    if constexpr (SP2) {
        PG8_STAGE(PG8_SB(0, 0), cB, voffB); PG8_STAGE(PG8_SB(0, 1), cB + hstep, voffB); PG8_STAGE(PG8_SA(0, 0), cA, voffA); PG8_STAGE(PG8_SA(0, 1), cA + hstep, voffA);
        if (wr == 1) PG8_BAR;
        PG8_WAIT_V(2); PG8_BAR;
        PG8_STAGE(PG8_SB(1, 0), cB + kstep, voffB); PG8_STAGE(PG8_SA(1, 0), cA + kstep, voffA); PG8_STAGE(PG8_SB(1, 1), cB + hstep + kstep, voffB);
        PG8_WAIT_V(6); PG8_BAR;
    } else {
        PG8_STAGE(PG8_SB(0, 0), cB, voffB); PG8_STAGE(PG8_SA(0, 0), cA, voffA); PG8_STAGE(PG8_SB(0, 1), cB + hstep, voffB); PG8_STAGE(PG8_SA(0, 1), cA + hstep, voffA);
        if (wr == 1) PG8_BAR;
        PG8_WAIT_V(4); PG8_BAR;
        PG8_STAGE(PG8_SB(1, 0), cB + kstep, voffB); PG8_STAGE(PG8_SA(1, 0), cA + kstep, voffA); PG8_STAGE(PG8_SB(1, 1), cB + hstep + kstep, voffB);
        PG8_WAIT_V(6); PG8_BAR;
    }
    for (;;) {
        const bool has_next = S.next(ui + 1, nxt);
        const char* nA = has_next ? (const char*)g.A + (size_t)nxt.pm * tstep + (size_t)nxt.kofs * 2 : cA; const char* nB = has_next ? (const char*)g.Bt + (size_t)nxt.pn * tstep + (size_t)nxt.kofs * 2 : cB;
        const int nt = cur.nt;
        for (int t = 0; t < nt; t += 2) {
            const bool last = (t == nt - 2);
            const char* a1 = cA + (size_t)(t + 1) * kstep;
            const char* a2 = last ? nA : cA + (size_t)(t + 2) * kstep; const char* b2 = last ? nB : cB + (size_t)(t + 2) * kstep;
            const char* a3 = a2 + kstep; const char* b3 = b2 + kstep;
            if (last && has_next) S.a_ready(nxt);
            if constexpr (SP2) {
            PG8_LDB(B0, 0, 0); PG8_LDB(B1, 0, 1); PG8_SCHED; PG8_LDA(At, 0, 0); PG8_STAGE(PG8_SA(1, 1), a1 + hstep, voffA);
            PG8_WAIT_V(8); PG8_WAIT_L(0); PG8_BAR; PG8_MMA(0, 0, At, B0); PG8_MMA(0, 1, At, B1); PG8_BAR; PG8_SCHED;
            PG8_LDA(At, 0, 1); PG8_STAGE(PG8_SB(0, 0), b2, voffB); PG8_STAGE(PG8_SB(0, 1), b2 + hstep, voffB); PG8_STAGE(PG8_SA(0, 0), a2, voffA);
            PG8_WAIT_V(8); PG8_WAIT_L(0); PG8_BAR; PG8_MMA(1, 0, At, B0); PG8_MMA(1, 1, At, B1); PG8_BAR; PG8_SCHED;
            PG8_LDB(B0, 1, 0); PG8_LDB(B1, 1, 1); PG8_SCHED; PG8_LDA(At, 1, 0); PG8_STAGE(PG8_SA(0, 1), a2 + hstep, voffA);
            PG8_WAIT_V(8); PG8_WAIT_L(0); PG8_BAR; PG8_MMA(0, 0, At, B0); PG8_MMA(0, 1, At, B1); PG8_BAR; PG8_SCHED;
            PG8_LDA(At, 1, 1); PG8_STAGE(PG8_SB(1, 0), b3, voffB); PG8_STAGE(PG8_SB(1, 1), b3 + hstep, voffB); PG8_STAGE(PG8_SA(1, 0), a3, voffA);
            PG8_WAIT_V(8); PG8_WAIT_L(0); PG8_BAR; PG8_MMA(1, 0, At, B0); PG8_MMA(1, 1, At, B1); PG8_BAR; PG8_SCHED;
            } else {
            PG8_LDB(B0, 0, 0); PG8_SCHED; PG8_LDA(At, 0, 0); PG8_STAGE(PG8_SA(1, 1), a1 + hstep, voffA);
            PG8_WAIT_L(8); PG8_BAR; PG8_WAIT_L(0); PG8_MMA(0, 0, At, B0); PG8_BAR; PG8_SCHED;
            PG8_LDB(B1, 0, 1); PG8_STAGE(PG8_SB(0, 0), b2, voffB);
            PG8_BAR; PG8_WAIT_L(0); PG8_MMA(0, 1, At, B1); PG8_BAR;
            PG8_LDA(At, 0, 1); PG8_STAGE(PG8_SA(0, 0), a2, voffA);
            PG8_BAR; PG8_WAIT_L(0); PG8_MMA(1, 0, At, B0); PG8_BAR; PG8_SCHED;
            PG8_STAGE(PG8_SB(0, 1), b2 + hstep, voffB);
            PG8_WAIT_V(6); PG8_BAR; PG8_MMA(1, 1, At, B1); PG8_BAR;
            PG8_LDB(B0, 1, 0); PG8_SCHED; PG8_LDA(At, 1, 0); PG8_STAGE(PG8_SA(0, 1), a2 + hstep, voffA);
            PG8_WAIT_L(8); PG8_BAR; PG8_WAIT_L(0); PG8_MMA(0, 0, At, B0); PG8_BAR; PG8_SCHED;
            PG8_LDB(B1, 1, 1); PG8_STAGE(PG8_SB(1, 0), b3, voffB);
            PG8_BAR; PG8_WAIT_L(0); PG8_MMA(0, 1, At, B1); PG8_BAR;
            PG8_LDA(At, 1, 1); PG8_STAGE(PG8_SA(1, 0), a3, voffA);
            PG8_BAR; PG8_WAIT_L(0); PG8_MMA(1, 0, At, B0); PG8_BAR; PG8_SCHED;
            PG8_STAGE(PG8_SB(1, 1), b3 + hstep, voffB);
            PG8_WAIT_V(6); PG8_BAR; PG8_MMA(1, 1, At, B1); PG8_BAR;
            }
        }
        if constexpr (ALIGN_EPI) { if (wr == 0) PG8_BAR; }
        if constexpr (!Epi::AFTER_DRAIN) { E(acc, cur, wr, wc, fr, fq); S.done(cur); }
        if (!has_next) break;
#pragma unroll
        for (int a = 0; a < 2; ++a)
#pragma unroll
            for (int b = 0; b < 2; ++b)
#pragma unroll
                for (int m = 0; m < 4; ++m)
#pragma unroll
                    for (int n = 0; n < 2; ++n) acc[a][b][m][n] = (f32x4){0.f, 0.f, 0.f, 0.f};
        cur = nxt; cA = nA; cB = nB; ++ui;
        if constexpr (ALIGN_EPI) { if (wr == 1) PG8_BAR; }
    }
    PG8_WAIT_V(0);
    if constexpr (!ALIGN_EPI) { if (wr == 0) PG8_BAR; }
    PG8_BAR;
    if constexpr (Epi::AFTER_DRAIN) { E.fused(acc, cur, wr, wc, fr, fq, lds, wid, lane); S.done(cur); }
#undef PG8_SA
#undef PG8_SB
#undef PG8_STAGE
#undef PG8_LDA
#undef PG8_LDB
#undef PG8_MMA
#undef PG8_WAIT_V
#undef PG8_WAIT_L
#undef PG8_BAR
#undef PG8_SCHED
}
}

#define LAS __attribute__((address_space(3)))
typedef unsigned short bf16_t;
typedef short bf16x8 __attribute__((ext_vector_type(8)));
typedef float f32x4 __attribute__((ext_vector_type(4)));
typedef unsigned u32x4 __attribute__((ext_vector_type(4)));
typedef unsigned u32x2 __attribute__((ext_vector_type(2)));

#ifndef GEMM_SP2
#define GEMM_SP2 true
#endif
#ifndef GEMM_ALIGN
#define GEMM_ALIGN true
#endif

constexpr int D = 1024, MLAT = 16384, MCTX = 512, MALL = 16896, HALFLAT = 8192;
constexpr int INC = 2592, INP = 2816, FF = 4096;
constexpr int K_OFF = 256, V_OFF = 512, G_OFF = 1024, R_OFF = 1056, CB_OFF = 1568, CC_OFF = 1824, CH_OFF = 2080, P_OFF = 2336;
constexpr int NPOS = 132, NMODV = 6144;
constexpr size_t PQ = 0, PK = PQ + (size_t)4 * MALL * 64, PV = PK + (size_t)4 * MALL * 64, PZ = PV + (size_t)4 * MALL * 128, PR = PZ + (size_t)MALL * 32,
                 PC = PR + (size_t)4 * MALL * 128, PP = PC + (size_t)MALL * 768;
static_assert(PP + (size_t)MALL * 256 == (size_t)MALL * INC, "PROJ segments");
constexpr float EPS = 1e-6f;
constexpr int NTHREADS = 512, NWAVES = 8;
constexpr int LDS_BYTES = 147456;
constexpr int NPHASES = 20;

constexpr size_t MiB = 1u << 20;
constexpr size_t WS_MOD = 0;
constexpr size_t WS_WIN = 1 * MiB;
constexpr size_t WS_WOUT = 12 * MiB;
constexpr size_t WS_W1 = 16 * MiB;
constexpr size_t WS_W2 = 32 * MiB;
constexpr size_t WS_XC = 48 * MiB;
constexpr size_t WS_X = 50 * MiB;
constexpr size_t WS_PROJ = 83 * MiB;
constexpr size_t WS_Y = 167 * MiB;
constexpr size_t WS_ACT = 83 * MiB;
constexpr size_t WS_S = 215 * MiB;
constexpr size_t WS_PART = 215 * MiB;
constexpr size_t WS_DEC = 248 * MiB;
constexpr size_t WS_BAR = 250 * MiB;
constexpr size_t BAR_BYTES = 16384;
constexpr size_t WS_END = 251 * MiB;

struct Args {
    const float* in[19];
    float* out;
    unsigned char* ws;
    int ph_lo, ph_hi;
};

__device__ __forceinline__ float bf2f(unsigned h) { return __uint_as_float(h << 16); }
__device__ __forceinline__ float bflo(unsigned w) { return __uint_as_float(w << 16); }
__device__ __forceinline__ float bfhi(unsigned w) { return __uint_as_float(w & 0xffff0000u); }
typedef __bf16 bf16v2_t __attribute__((ext_vector_type(2)));
typedef float f32v2_t __attribute__((ext_vector_type(2)));
__device__ __forceinline__ unsigned pk2(float lo, float hi) { const f32v2_t v = {lo, hi}; const bf16v2_t b = __builtin_convertvector(v, bf16v2_t); return __builtin_bit_cast(unsigned, b); }
__device__ __forceinline__ bf16_t f2bf(float f) { return (bf16_t)(pk2(f, 0.f) & 0xffffu); }
__device__ __forceinline__ float wave_sum(float v) {
#pragma unroll
    for (int o = 1; o < 64; o <<= 1) v += __shfl_xor(v, o);
    return v;
}
__device__ __forceinline__ float siluf(float x) { return x * __builtin_amdgcn_rcpf(1.0f + __builtin_amdgcn_exp2f(-1.4426950409f * x)); }
__device__ __forceinline__ int modvec_of_row(int row) { return row < HALFLAT ? 0 : (row < MLAT ? 1 : 2); }

struct EpiProj {
    static constexpr bool PERM = true, AFTER_DRAIN = false;
    bf16_t* O;
    __device__ __forceinline__ void operator()(const f32x4 (&acc)[2][2][4][2], const pg8::Unit& u, int wr, int wc, int fr, int fq) const {
        const int row0 = u.pm * 256 + wr * 64 + fr, colt = u.pn * 256;
#pragma unroll
        for (int bj = 0; bj < 2; ++bj) {
            const int cb = colt + bj * 128 + wc * 32;
            if (cb >= INC) continue;
            size_t off0; int pitch;
            if (cb < K_OFF)       { off0 = PQ + (size_t)(cb >> 6) * MALL * 64 + (cb & 63); pitch = 64; }
            else if (cb < V_OFF)  { const int c = cb - K_OFF;  off0 = PK + (size_t)(c >> 6) * MALL * 64 + (c & 63); pitch = 64; }
            else if (cb < G_OFF)  { const int c = cb - V_OFF;  off0 = PV + (size_t)(c >> 7) * MALL * 128 + (c & 127); pitch = 128; }
            else if (cb < R_OFF)  { off0 = PZ; pitch = 32; }
            else if (cb < CB_OFF) { const int c = cb - R_OFF;  off0 = PR + (size_t)(c >> 7) * MALL * 128 + (c & 127); pitch = 128; }
            else if (cb < P_OFF)  { off0 = PC + (cb - CB_OFF); pitch = 768; }
            else                  { off0 = PP + (cb - P_OFF); pitch = 256; }
            bf16_t* base = O + off0 + 8 * fq;
#pragma unroll
            for (int ai = 0; ai < 2; ++ai)
#pragma unroll
                for (int m = 0; m < 4; ++m) {
                    const f32x4 v0 = acc[ai][bj][m][0], v1 = acc[ai][bj][m][1];
                    u32x4 w; w.x = pk2(v0[0], v0[1]); w.y = pk2(v0[2], v0[3]); w.z = pk2(v1[0], v1[1]); w.w = pk2(v1[2], v1[3]);
                    *(u32x4*)(base + (size_t)(row0 + ai * 128 + m * 16) * pitch) = w;
                }
        }
    }
};
struct EpiAct {
    static constexpr bool PERM = true, AFTER_DRAIN = false;
    bf16_t* O;
    __device__ __forceinline__ void operator()(const f32x4 (&acc)[2][2][4][2], const pg8::Unit& u, int wr, int wc, int fr, int fq) const {
        const int row0 = u.pm * 256 + wr * 64 + fr, colt = u.pn * 256;
#pragma unroll
        for (int ai = 0; ai < 2; ++ai)
#pragma unroll
            for (int m = 0; m < 4; ++m) {
                bf16_t* rowp = O + (size_t)(row0 + ai * 128 + m * 16) * FF + colt + wc * 32 + 8 * fq;
#pragma unroll
                for (int bj = 0; bj < 2; ++bj) {
                    f32x4 v0 = acc[ai][bj][m][0], v1 = acc[ai][bj][m][1];
#pragma unroll
                    for (int j = 0; j < 4; ++j) { const float a = fmaxf(v0[j], 0.f), b = fmaxf(v1[j], 0.f); v0[j] = a * a; v1[j] = b * b; }
                    u32x4 w; w.x = pk2(v0[0], v0[1]); w.y = pk2(v0[2], v0[3]); w.z = pk2(v1[0], v1[1]); w.w = pk2(v1[2], v1[3]);
                    *(u32x4*)(rowp + bj * 128) = w;
                }
            }
    }
};
struct EpiRes {
    static constexpr bool PERM = true, AFTER_DRAIN = false;
    const float* xin_f32; bf16_t* X; float* part; const float* gate;
    __device__ __forceinline__ void operator()(const f32x4 (&acc)[2][2][4][2], const pg8::Unit& u, int wr, int wc, int fr, int fq) const {
        asm volatile("" ::: "memory");
        const int rbase = __builtin_amdgcn_readfirstlane(u.pm * 256), cbase = __builtin_amdgcn_readfirstlane(u.pn * 256);
        const unsigned c32 = (unsigned)(wc * 32 + 8 * fq), o32 = (unsigned)((wr * 64 + fr) * D) + c32;
        if (rbase < MLAT) {
            const float* gp = gate + (rbase < HALFLAT ? 0 : NMODV) + cbase;
            f32x4 gv[2][2];
#pragma unroll
            for (int bj = 0; bj < 2; ++bj)
#pragma unroll
                for (int n = 0; n < 2; ++n) gv[bj][n] = *(const f32x4*)(gp + c32 + bj * 128 + 4 * n);
            bf16_t* xo = X + (size_t)rbase * D + cbase;
            if (xin_f32) {
                const float* xi = xin_f32 + (size_t)rbase * D + cbase;
#pragma unroll
                for (int ai = 0; ai < 2; ++ai) {
                    f32x4 xv[4][2][2];
#pragma unroll
                    for (int m = 0; m < 4; ++m)
#pragma unroll
                        for (int bj = 0; bj < 2; ++bj)
#pragma unroll
                            for (int n = 0; n < 2; ++n) xv[m][bj][n] = *(const f32x4*)(xi + (size_t)(ai * 128 + m * 16) * D + o32 + bj * 128 + 4 * n);
#pragma unroll
                    for (int m = 0; m < 4; ++m)
#pragma unroll
                        for (int bj = 0; bj < 2; ++bj) {
                            const f32x4 y0 = xv[m][bj][0] + gv[bj][0] * acc[ai][bj][m][0], y1 = xv[m][bj][1] + gv[bj][1] * acc[ai][bj][m][1];
                            *(u32x4*)(xo + (size_t)(ai * 128 + m * 16) * D + o32 + bj * 128) = (u32x4){pk2(y0[0], y0[1]), pk2(y0[2], y0[3]), pk2(y1[0], y1[1]), pk2(y1[2], y1[3])};
                        }
                    asm volatile("" ::: "memory");
                }
            } else {
#pragma unroll
                for (int ai = 0; ai < 2; ++ai) {
                    u32x4 xb[4][2];
#pragma unroll
                    for (int m = 0; m < 4; ++m)
#pragma unroll
                        for (int bj = 0; bj < 2; ++bj) xb[m][bj] = *(const u32x4*)(xo + (size_t)(ai * 128 + m * 16) * D + o32 + bj * 128);
#pragma unroll
                    for (int m = 0; m < 4; ++m)
#pragma unroll
                        for (int bj = 0; bj < 2; ++bj) {
                            const u32x4 w = xb[m][bj];
                            const f32x4 x0 = (f32x4){bflo(w.x), bfhi(w.x), bflo(w.y), bfhi(w.y)}, x1 = (f32x4){bflo(w.z), bfhi(w.z), bflo(w.w), bfhi(w.w)};
                            const f32x4 y0 = x0 + gv[bj][0] * acc[ai][bj][m][0], y1 = x1 + gv[bj][1] * acc[ai][bj][m][1];
                            *(u32x4*)(xo + (size_t)(ai * 128 + m * 16) * D + o32 + bj * 128) = (u32x4){pk2(y0[0], y0[1]), pk2(y0[2], y0[3]), pk2(y1[0], y1[1]), pk2(y1[2], y1[3])};
                        }
                    asm volatile("" ::: "memory");
                }
            }
        } else {
            float* xo = part + ((size_t)(u.kofs >> 8) * MCTX + (size_t)(rbase - MLAT)) * D + cbase; const float* gp = gate + 2 * NMODV + cbase;
#pragma unroll
            for (int ai = 0; ai < 2; ++ai)
#pragma unroll
                for (int m = 0; m < 4; ++m) {
                    float* xw = xo + (size_t)(ai * 128 + m * 16) * D;
#pragma unroll
                    for (int bj = 0; bj < 2; ++bj)
#pragma unroll
                        for (int n = 0; n < 2; ++n) {
                            const f32x4 gv = *(const f32x4*)(gp + c32 + bj * 128 + 4 * n);
                            *(f32x4*)(xw + o32 + bj * 128 + 4 * n) = gv * acc[ai][bj][m][n];
                        }
                    asm volatile("" ::: "memory");
                }
        }
    }
};

__device__ __forceinline__ void transpose_item(const float* W, int N, bf16_t* WT, int ldt, LAS float* scr, int item, int lane) {
    const int nblk = N / 32, kb = item / nblk, nb = item % nblk, k0 = 64 * kb, n0 = 32 * nb;
#pragma unroll 8
    for (int i = 0; i < 32; ++i) { const int kk = 2 * i + (lane >> 5); scr[kk * 33 + (lane & 31)] = W[(size_t)(k0 + kk) * N + n0 + (lane & 31)]; }
    asm volatile("s_waitcnt lgkmcnt(0)" ::: "memory");
    const int c = lane & 7;
#pragma unroll
    for (int j = 0; j < 4; ++j) { const int n = (lane >> 3) + 8 * j; const LAS float* s = scr + (8 * c) * 33 + n;
        u32x4 o; o.x = pk2(s[0 * 33], s[1 * 33]); o.y = pk2(s[2 * 33], s[3 * 33]); o.z = pk2(s[4 * 33], s[5 * 33]); o.w = pk2(s[6 * 33], s[7 * 33]);
        *(u32x4*)(WT + (size_t)(n0 + n) * ldt + k0 + 8 * c) = o; }
    asm volatile("s_waitcnt lgkmcnt(0)" ::: "memory");
}

__device__ __forceinline__ void phase_prep(const Args& a, LAS unsigned char* lds) {
    const int tid = tid_opaque(), lane = tid & 63, wave = tid >> 6, G = gridDim.x;
    unsigned char* ws = a.ws;
    {
        LAS float* sc = (LAS float*)lds;
        LAS float* part = (LAS float*)(lds + 12288);
        bool have = false;
        for (int it = bid_opaque(); it < 192; it += G) {
            if (!have) {
                for (int i = tid; i < 3072; i += NTHREADS) { const int v = i >> 10, k = i & 1023; const float cv = v < 2 ? a.in[1][v * D + k] : a.in[3][k]; sc[i] = siluf(cv); }
                have = true; __syncthreads();
            }
            const int l = it / 96, cgp = it % 96, col = tid & 63, ks = tid >> 6;
            const float* W = a.in[4] + (size_t)l * D * NMODV + cgp * 64 + col;
            float a0 = 0.f, a1 = 0.f, a2 = 0.f;
#pragma unroll 32
            for (int k = ks * 128; k < ks * 128 + 128; ++k) { const float w = W[(size_t)k * NMODV]; a0 += sc[k] * w; a1 += sc[1024 + k] * w; a2 += sc[2048 + k] * w; }
            part[(ks * 3 + 0) * 64 + col] = a0; part[(ks * 3 + 1) * 64 + col] = a1; part[(ks * 3 + 2) * 64 + col] = a2;
            __syncthreads();
            if (tid < 192) { const int v = tid >> 6, c2 = tid & 63; float s = a.in[5][l * NMODV + cgp * 64 + c2];
#pragma unroll
                for (int q = 0; q < 8; ++q) s += part[(q * 3 + v) * 64 + c2];
                ((float*)(ws + WS_MOD))[(l * 3 + v) * NMODV + cgp * 64 + c2] = s; }
            __syncthreads();
        }
        __syncthreads();
    }
    {
        LAS float* scr = (LAS float*)(lds + wave * 16384);
        const int gw = bid_opaque() * NWAVES + wave, NGW = G * NWAVES;
        constexpr int I_IN = 16 * 81, I_OUT = 12 * 32, I_1 = 16 * 128, I_2 = 64 * 32, I_L = I_IN + I_OUT + I_1 + I_2;
        for (int it = gw; it < 2 * I_L; it += NGW) {
            const int l = it / I_L; int r = it % I_L;
            if (r < I_IN) { transpose_item(a.in[8] + (size_t)l * D * INC, INC, (bf16_t*)(ws + WS_WIN) + (size_t)l * INP * D, D, scr, r, lane); continue; } r -= I_IN;
            if (r < I_OUT) { transpose_item(a.in[15] + (size_t)l * D * D, D, (bf16_t*)(ws + WS_WOUT) + (size_t)l * D * D, D, scr, r, lane); continue; } r -= I_OUT;
            if (r < I_1) { transpose_item(a.in[16] + (size_t)l * D * FF, FF, (bf16_t*)(ws + WS_W1) + (size_t)l * FF * D, D, scr, r, lane); continue; } r -= I_1;
            transpose_item(a.in[17] + (size_t)l * FF * D, D, (bf16_t*)(ws + WS_W2) + (size_t)l * D * FF, FF, scr, r, lane);
        }
        for (int i = bid_opaque() * NTHREADS + tid; i < 2 * 224 * 128; i += G * NTHREADS) {
            const int l = i / (224 * 128), r = i % (224 * 128);
            *(u32x4*)((bf16_t*)(ws + WS_WIN) + (size_t)l * INP * D + (size_t)INC * D + (size_t)r * 8) = (u32x4){0u, 0u, 0u, 0u};
        }
    }
    {
        for (int i = bid_opaque() * NTHREADS + tid; i < 2 * 32 * 1024; i += G * NTHREADS) {
            const int l = i >> 15, r = i & 32767, n = r & 1023, kc8 = (r >> 10) * 8, g = kc8 >> 6, c0 = kc8 & 63;
            const float* pw = a.in[13] + ((size_t)(l * 4 + g) * 64 + c0) * 64;
            const float* sc = a.in[14] + l * 256 + g * 64;
            const float* wo = a.in[15] + (size_t)l * D * D + (size_t)(768 + g * 64) * D + n;
            float acc[8];
#pragma unroll
            for (int j = 0; j < 8; ++j) acc[j] = 0.f;
            for (int d = 0; d < 64; ++d) { const float w = wo[(size_t)d * D] * sc[d];
#pragma unroll
                for (int j = 0; j < 8; ++j) acc[j] += pw[j * 64 + d] * w; }
            u32x4 o; o.x = pk2(acc[0], acc[1]); o.y = pk2(acc[2], acc[3]); o.z = pk2(acc[4], acc[5]); o.w = pk2(acc[6], acc[7]);
            *(u32x4*)((bf16_t*)(ws + WS_WOUT) + (size_t)l * D * D + (size_t)n * D + 768 + kc8) = o;
        }
    }
}

__device__ __forceinline__ void load_row_f32(f32x4 (&v)[4], const float* p, int lane) {
#pragma unroll
    for (int j = 0; j < 2; ++j) { v[2 * j] = *(const f32x4*)(p + 8 * lane + 512 * j); v[2 * j + 1] = *(const f32x4*)(p + 8 * lane + 512 * j + 4); }
}
__device__ __forceinline__ void load_row_bf16(f32x4 (&v)[4], const bf16_t* p, int lane) {
#pragma unroll
    for (int j = 0; j < 2; ++j) { const u32x4 w = *(const u32x4*)(p + 8 * lane + 512 * j);
        v[2 * j] = (f32x4){bflo(w.x), bfhi(w.x), bflo(w.y), bfhi(w.y)}; v[2 * j + 1] = (f32x4){bflo(w.z), bfhi(w.z), bflo(w.w), bfhi(w.w)}; }
}
__device__ __forceinline__ float row_sumsq(const f32x4 (&v)[4]) {
    float s = 0.f;
#pragma unroll
    for (int j = 0; j < 4; ++j) s += (v[j].x * v[j].x + v[j].y * v[j].y) + (v[j].z * v[j].z + v[j].w * v[j].w);
    return s;
}
__device__ __forceinline__ void phase_norm(const float* xlat32, const bf16_t* X, const float* xctx, int nrows, const float* nw, const float* mod, int sh_off, int sc_off, bf16_t* H,
                                           const float* part, int npart, float* xc_store) {
    const int tid = tid_opaque(), lane = tid & 63, wave = tid >> 6;
    const int gw = bid_opaque() * NWAVES + wave, NGW = gridDim.x * NWAVES;
    int cur_v = -1; f32x4 aw[4], shv[4];
#pragma unroll
    for (int j = 0; j < 4; ++j) { aw[j] = (f32x4){0.f, 0.f, 0.f, 0.f}; shv[j] = aw[j]; }
    for (int r = gw; r < nrows; r += 2 * NGW) {
        const int rowA = nrows - 1 - r, rowB0 = rowA - NGW;
        const bool hasB = rowB0 >= 0; const int rowB = hasB ? rowB0 : rowA;
        f32x4 va[4], vb[4];
        if (rowA >= MLAT) load_row_f32(va, xctx + (size_t)(rowA - MLAT) * D, lane);
        else if (xlat32) load_row_f32(va, xlat32 + (size_t)rowA * D, lane);
        else load_row_bf16(va, X + (size_t)rowA * D, lane);
        if (rowB >= MLAT) load_row_f32(vb, xctx + (size_t)(rowB - MLAT) * D, lane);
        else if (xlat32) load_row_f32(vb, xlat32 + (size_t)rowB * D, lane);
        else load_row_bf16(vb, X + (size_t)rowB * D, lane);
        if (rowA >= MLAT && npart > 0) {
            const float* pr = part + (size_t)(rowA - MLAT) * D;
            for (int k = 0; k < npart; k += 2) {
                f32x4 t0[4], t1[4];
                load_row_f32(t0, pr + (size_t)k * MCTX * D, lane); load_row_f32(t1, pr + (size_t)(k + 1) * MCTX * D, lane);
#pragma unroll
                for (int j = 0; j < 4; ++j) va[j] += t0[j] + t1[j];
            }
            float* xs = xc_store + (size_t)(rowA - MLAT) * D;
#pragma unroll
            for (int j = 0; j < 2; ++j) { *(f32x4*)(xs + 8 * lane + 512 * j) = va[2 * j]; *(f32x4*)(xs + 8 * lane + 512 * j + 4) = va[2 * j + 1]; }
        }
        float sa = row_sumsq(va), sb = row_sumsq(vb);
#pragma unroll
        for (int o = 1; o < 64; o <<= 1) { sa += __shfl_xor(sa, o); sb += __shfl_xor(sb, o); }
        const float ra = rsqrtf(sa * (1.0f / D) + EPS), rb = rsqrtf(sb * (1.0f / D) + EPS);
#pragma unroll 1
        for (int which = 0; which < 2; ++which) {
            if (which == 1 && !hasB) break;
            const int row = which ? rowB : rowA; const float rstd = which ? rb : ra;
            const int v = modvec_of_row(row);
            if (v != cur_v) {
                const float* mv = mod + v * NMODV;
#pragma unroll
                for (int j = 0; j < 4; ++j) { const int c = 8 * lane + 512 * (j >> 1) + 4 * (j & 1); aw[j] = *(const f32x4*)(nw + c) * (*(const f32x4*)(mv + sc_off + c) + 1.0f); shv[j] = *(const f32x4*)(mv + sh_off + c); }
                cur_v = v;
            }
#pragma unroll
            for (int j = 0; j < 2; ++j) {
                const f32x4 y0 = ((which ? vb[2 * j] : va[2 * j]) * rstd) * aw[2 * j] + shv[2 * j], y1 = ((which ? vb[2 * j + 1] : va[2 * j + 1]) * rstd) * aw[2 * j + 1] + shv[2 * j + 1];
                *(u32x4*)(H + (size_t)row * D + 8 * lane + 512 * j) = (u32x4){pk2(y0.x, y0.y), pk2(y0.z, y0.w), pk2(y1.x, y1.y), pk2(y1.z, y1.w)};
            }
        }
    }
}
__device__ __forceinline__ void phase_final(const bf16_t* X, float* out, const float* nw) {
    const int tid = tid_opaque(), lane = tid & 63, wave = tid >> 6;
    const int gw = bid_opaque() * NWAVES + wave, NGW = gridDim.x * NWAVES;
    f32x4 w[4];
    load_row_f32(w, nw, lane);
    for (int row = gw; row < MLAT; row += 2 * NGW) {
        const bool hasB = row + NGW < MLAT; const int rowB = hasB ? row + NGW : row;
        f32x4 va[4], vb[4];
        load_row_bf16(va, X + (size_t)row * D, lane); load_row_bf16(vb, X + (size_t)rowB * D, lane);
        float sa = row_sumsq(va), sb = row_sumsq(vb);
#pragma unroll
        for (int o = 1; o < 64; o <<= 1) { sa += __shfl_xor(sa, o); sb += __shfl_xor(sb, o); }
        const float ra = rsqrtf(sa * (1.0f / D) + EPS), rb = rsqrtf(sb * (1.0f / D) + EPS);
        float* oa = out + (size_t)row * D; float* ob = out + (size_t)rowB * D;
#pragma unroll
        for (int j = 0; j < 2; ++j) { *(f32x4*)(oa + 8 * lane + 512 * j) = (va[2 * j] * ra) * w[2 * j]; *(f32x4*)(oa + 8 * lane + 512 * j + 4) = (va[2 * j + 1] * ra) * w[2 * j + 1]; }
        if (hasB) {
#pragma unroll
            for (int j = 0; j < 2; ++j) { *(f32x4*)(ob + 8 * lane + 512 * j) = (vb[2 * j] * rb) * w[2 * j]; *(f32x4*)(ob + 8 * lane + 512 * j + 4) = (vb[2 * j + 1] * rb) * w[2 * j + 1]; }
        }
    }
}

constexpr int L_ZS = 0, L_GW = 8192, L_GB = 16384, L_SEG = 16896;
constexpr int BPITCH = 68;
constexpr int L_BF = 21504, L_BB = L_BF + 64 * BPITCH * 4;
constexpr int L_QEF = 56320, L_QEB = L_QEF + 9216, L_KIF = L_QEB + 9216, L_KIB = L_KIF + 9216, L_VT = L_KIB + 9216, L_PF = L_VT + 18432, L_PB = L_PF + 9216;
constexpr int PITCH = 72;
static_assert(L_PB + 9216 <= 131072, "GLA LDS map");

struct ChunkInfo { int r0, b, posf, posb, seg_lo, seg_hi; };
__device__ __forceinline__ ChunkInfo chunk_info(int cidx) {
    ChunkInfo ci;
    if (cidx < 256) { ci.b = cidx >> 7; const int c = cidx & 127; ci.r0 = cidx * 64; ci.posf = 4 + c; ci.posb = 4 + (127 - c); ci.seg_lo = ci.r0; ci.seg_hi = ci.r0 + 64; }
    else { const int cc = cidx - 256; ci.b = cc >> 2; const int j = cc & 3; ci.r0 = MLAT + cc * 64; ci.posf = j; ci.posb = 3 - j; ci.seg_lo = MLAT + ci.b * 256; ci.seg_hi = ci.seg_lo + 256; }
    return ci;
}
__device__ __forceinline__ float pick8(const f32x4& a, const f32x4& b, int i) { return i < 4 ? a[i & 3] : b[i & 3]; }
__device__ __forceinline__ float logsigmoidf(float x) { return fminf(x, 0.f) - 0.6931471806f * __builtin_amdgcn_logf(1.0f + __builtin_amdgcn_exp2f(-1.4426950409f * fabsf(x))); }

struct GFirst { u32x4 zf[4]; u32x4 k, q, v0, v1; };
__device__ __forceinline__ void gla_load_a(GFirst& R, const bf16_t* proj, int r0, int tid) {
    const int fr = tid & 15, fq = (tid >> 4) & 3;
#pragma unroll
    for (int tt = 0; tt < 4; ++tt) R.zf[tt] = *(const u32x4*)(proj + PZ + (size_t)(r0 + 16 * tt + fr) * 32 + 8 * fq);
}
struct GateConst { bf16x8 bfrag; float gbias; int h; };
__device__ __forceinline__ void gate_const(GateConst& gc, const float* gate_w, const float* gate_b, int h, int tid) {
    const int fr = tid & 15, fq = (tid >> 4) & 3, w = tid >> 6, d = w >> 2, n = h * 64 + (w & 3) * 16 + fr;
    float v[8];
#pragma unroll
    for (int j = 0; j < 8; ++j) v[j] = 0.f;
    if ((fq >> 1) == d) {
        const unsigned o = (unsigned)((d * 16 + 8 * (fq & 1)) * 256 + n);
#pragma unroll
        for (int j = 0; j < 8; ++j) v[j] = gate_w[o + (unsigned)(j * 256)];
    }
    const u32x4 p = (u32x4){pk2(v[0], v[1]), pk2(v[2], v[3]), pk2(v[4], v[5]), pk2(v[6], v[7])};
    gc.bfrag = __builtin_bit_cast(bf16x8, p);
    gc.gbias = gate_b[d * 256 + n]; gc.h = h;
}
template <bool WITH_Q>
__device__ __forceinline__ void gla_load_b(GFirst& R, const bf16_t* proj, int r0, int h, int tid) {
    const int t = tid & 63, cg = tid >> 6;
    const size_t hr = (size_t)h * MALL + (size_t)(r0 + t);
    R.k = *(const u32x4*)(proj + PK + hr * 64 + cg * 8);
    if (WITH_Q) R.q = *(const u32x4*)(proj + PQ + hr * 64 + cg * 8);
    R.v0 = *(const u32x4*)(proj + PV + hr * 128 + cg * 8);
    R.v1 = *(const u32x4*)(proj + PV + hr * 128 + 64 + cg * 8);
}
template <bool WITH_Q>
__device__ __forceinline__ void gla_load_first(GFirst& R, const bf16_t* proj, int r0, int h, int tid) {
    gla_load_a(R, proj, r0, tid); gla_load_b<WITH_Q>(R, proj, r0, h, tid);
}

__device__ __forceinline__ void gla_gates(const GFirst& R, const GateConst& gc, LAS unsigned char* lds, int tid) {
    const int lane = tid & 63, fr = lane & 15, fq = lane >> 4, w = tid >> 6, d = w >> 2, j = (w & 3) * 16 + fr;
    LAS float* BX = (LAS float*)(lds + (d ? L_BB : L_BF));
    float g[4][4];
#pragma unroll
    for (int tt = 0; tt < 4; ++tt) {
        const f32x4 acc = __builtin_amdgcn_mfma_f32_16x16x32_bf16(__builtin_bit_cast(bf16x8, R.zf[tt]), gc.bfrag, (f32x4){0.f, 0.f, 0.f, 0.f}, 0, 0, 0);
#pragma unroll
        for (int r = 0; r < 4; ++r) g[tt][r] = logsigmoidf(acc[r] + gc.gbias) * (1.0f / 16.0f);
    }
    if (d == 0) {
        float off = 0.f;
#pragma unroll
        for (int tt = 0; tt < 4; ++tt) {
            const float p0 = g[tt][0], p1 = p0 + g[tt][1], p2 = p1 + g[tt][2], p3 = p2 + g[tt][3];
            float s = p3; float v = __shfl(s, (lane - 16) & 63); s += fq >= 1 ? v : 0.f; v = __shfl(s, (lane - 32) & 63); s += fq >= 2 ? v : 0.f;
            const float e = off + (s - p3), tot = __shfl(s, 48 + fr);
            LAS float* bp = BX + (16 * tt + 4 * fq) * BPITCH + j;
            bp[0] = e + p0; bp[BPITCH] = e + p1; bp[2 * BPITCH] = e + p2; bp[3 * BPITCH] = e + p3;
            off += tot;
        }
    } else {
        float off = 0.f;
#pragma unroll
        for (int tt = 3; tt >= 0; --tt) {
            const float s3 = g[tt][3], s2 = s3 + g[tt][2], s1 = s2 + g[tt][1], s0 = s1 + g[tt][0];
            float s = s0; float v = __shfl(s, (lane + 16) & 63); s += fq <= 2 ? v : 0.f; v = __shfl(s, (lane + 32) & 63); s += fq <= 1 ? v : 0.f;
            const float e = off + (s - s0), tot = __shfl(s, fr);
            LAS float* bp = BX + (16 * tt + 4 * fq) * BPITCH + j;
            bp[0] = e + s0; bp[BPITCH] = e + s1; bp[2 * BPITCH] = e + s2; bp[3 * BPITCH] = e + s3;
            off += tot;
        }
    }
    __syncthreads();
}
__device__ __forceinline__ void gla_write_vt(const GFirst& R, LAS unsigned char* lds, int tid) {
    LAS bf16_t* VT = (LAS bf16_t*)(lds + L_VT); const int t = tid & 63, cg = tid >> 6;
    const unsigned a[4] = {R.v0.x, R.v0.y, R.v0.z, R.v0.w}, b[4] = {R.v1.x, R.v1.y, R.v1.z, R.v1.w};
#pragma unroll
    for (int i = 0; i < 4; ++i) {
        VT[(cg * 8 + 2 * i) * PITCH + t] = (bf16_t)(a[i] & 0xffffu); VT[(cg * 8 + 2 * i + 1) * PITCH + t] = (bf16_t)(a[i] >> 16);
        VT[(64 + cg * 8 + 2 * i) * PITCH + t] = (bf16_t)(b[i] & 0xffffu); VT[(64 + cg * 8 + 2 * i + 1) * PITCH + t] = (bf16_t)(b[i] >> 16);
    }
}

__device__ __forceinline__ void phase_gla_u(const Args& a, int l, LAS unsigned char* lds) {
    const int tid = tid_opaque(), lane = tid & 63, wave = tid >> 6;
    const bf16_t* proj = (const bf16_t*)(a.ws + WS_PROJ);
    bf16_t* U = (bf16_t*)a.out; float* DEC = (float*)(a.ws + WS_DEC);
    const float* gate_w = a.in[9] + (size_t)l * 2 * 16 * 256; const float* gate_b = a.in[10] + (size_t)l * 2 * 256;
    LAS float* BF = (LAS float*)(lds + L_BF); LAS float* BB = (LAS float*)(lds + L_BB);
    LAS bf16_t* KTF = (LAS bf16_t*)(lds + L_QEF); LAS bf16_t* KTB = (LAS bf16_t*)(lds + L_QEB); LAS bf16_t* VT = (LAS bf16_t*)(lds + L_VT);
    constexpr int NIT = 264 * 4;
    GFirst R; GateConst gc; gc.h = -1;
    if (bid_opaque() < NIT) { const ChunkInfo c0 = chunk_info(bid_opaque() >> 2); gla_load_first<false>(R, proj, c0.r0, bid_opaque() & 3, tid); }
#pragma unroll 1
    for (int it = bid_opaque(); it < NIT; it += gridDim.x) {
        const int cidx = it >> 2, h = it & 3; const ChunkInfo ci = chunk_info(cidx);
        const int itn = it + gridDim.x; const ChunkInfo cn = chunk_info((itn < NIT ? itn : it) >> 2);
        if (gc.h != h) gate_const(gc, gate_w, gate_b, h, tid);
        GFirst Rn;
#pragma unroll
        for (int tt = 0; tt < 4; ++tt) Rn.zf[tt] = R.zf[tt];
        if (itn < NIT) gla_load_a(Rn, proj, cn.r0, tid);
        gla_gates(R, gc, lds, tid);
        { const int t = tid & 63, cg = tid >> 6;
          const unsigned ww[4] = {R.k.x, R.k.y, R.k.z, R.k.w};
          const f32x4 bfa = *(const LAS f32x4*)(BF + t * BPITCH + cg * 8), bfb = *(const LAS f32x4*)(BF + t * BPITCH + cg * 8 + 4);
          const f32x4 bba = *(const LAS f32x4*)(BB + t * BPITCH + cg * 8), bbb = *(const LAS f32x4*)(BB + t * BPITCH + cg * 8 + 4);
          const f32x4 fla = *(const LAS f32x4*)(BF + 63 * BPITCH + cg * 8), flb = *(const LAS f32x4*)(BF + 63 * BPITCH + cg * 8 + 4);
          const f32x4 b0a = *(const LAS f32x4*)(BB + cg * 8), b0b = *(const LAS f32x4*)(BB + cg * 8 + 4);
#pragma unroll
          for (int i = 0; i < 8; ++i) { const int dk = cg * 8 + i; const float kf = (i & 1) ? bfhi(ww[i >> 1]) : bflo(ww[i >> 1]);
              KTF[dk * PITCH + t] = f2bf(kf * __expf(pick8(fla, flb, i) - pick8(bfa, bfb, i)));
              KTB[dk * PITCH + t] = f2bf(kf * __expf(pick8(b0a, b0b, i) - pick8(bba, bbb, i))); } }
        gla_write_vt(R, lds, tid);
        if (tid < 128) { const int d = tid >> 6, j = tid & 63;
            DEC[((size_t)((ci.b * 4 + h) * 2 + d) * NPOS + (d ? ci.posb : ci.posf)) * 64 + j] = __expf(d ? BB[j] : BF[63 * BPITCH + j]); }
        if (itn < NIT) gla_load_b<false>(R, proj, cn.r0, itn & 3, tid);
        __syncthreads();
        {
            const int dir = wave >> 2, jv = (wave & 3) * 32, fr = lane & 15, fq = lane >> 4;
            const LAS bf16_t* KT = dir ? KTB : KTF;
            bf16x8 af[4][2], bfr[2][2];
#pragma unroll
            for (int i = 0; i < 4; ++i)
#pragma unroll
                for (int ks = 0; ks < 2; ++ks) af[i][ks] = *(const LAS bf16x8*)(KT + (i * 16 + fr) * PITCH + ks * 32 + 8 * fq);
#pragma unroll
            for (int jt = 0; jt < 2; ++jt)
#pragma unroll
                for (int ks = 0; ks < 2; ++ks) bfr[jt][ks] = *(const LAS bf16x8*)(VT + (jv + jt * 16 + fr) * PITCH + ks * 32 + 8 * fq);
            bf16_t* Ub = U + ((size_t)((ci.b * 4 + h) * 2 + dir) * NPOS + (dir ? ci.posb : ci.posf)) * 8192;
#pragma unroll
            for (int i = 0; i < 4; ++i)
#pragma unroll
                for (int jt = 0; jt < 2; ++jt) {
                    f32x4 acc = (f32x4){0.f, 0.f, 0.f, 0.f};
#pragma unroll
                    for (int ks = 0; ks < 2; ++ks) acc = __builtin_amdgcn_mfma_f32_16x16x32_bf16(af[i][ks], bfr[jt][ks], acc, 0, 0, 0);
                    u32x2 o; o.x = pk2(acc[0], acc[1]); o.y = pk2(acc[2], acc[3]);
                    *(u32x2*)(Ub + (size_t)(jv + jt * 16 + fr) * 64 + i * 16 + 4 * fq) = o;
                }
        }
#pragma unroll
        for (int tt = 0; tt < 4; ++tt) R.zf[tt] = Rn.zf[tt];
    }
}

__device__ __forceinline__ void phase_gla_scan(const Args& a, LAS unsigned char* lds) {
    const unsigned* U = (const unsigned*)a.out; unsigned* S = (unsigned*)(a.ws + WS_S); const float* DEC = (const float*)(a.ws + WS_DEC);
    constexpr int SEGL = NPOS / 4;
    const int tid = tid_opaque(), lane = tid & 63, wave = tid >> 6, seg = wave & 3, grp = wave >> 2;
    LAS float* X = (LAS float*)lds;
    for (int bi = bid_opaque(); bi < 16 * 4096 / 128; bi += gridDim.x) {
        const int pidx = bi * 128 + grp * 64 + lane, seq = pidx >> 12, e2 = pidx & 4095, dk = (e2 * 2) & 63, pl = grp * 64 + lane;
        const unsigned* up = U + ((size_t)seq * NPOS + seg * SEGL) * 4096 + e2; unsigned* sp = S + ((size_t)seq * NPOS + seg * SEGL) * 4096 + e2;
        const float* dp = DEC + ((size_t)seq * NPOS + seg * SEGL) * 64 + dk;
        unsigned u[SEGL]; float d0[SEGL], d1[SEGL];
#pragma unroll
        for (int i = 0; i < SEGL; ++i) { u[i] = up[(size_t)i * 4096]; const float2 dd = *(const float2*)(dp + i * 64); d0[i] = dd.x; d1[i] = dd.y; }
        float s0 = 0.f, s1 = 0.f, c0 = 1.f, c1 = 1.f;
#pragma unroll
        for (int i = 0; i < SEGL; ++i) { s0 = d0[i] * s0 + bflo(u[i]); s1 = d1[i] * s1 + bfhi(u[i]); c0 *= d0[i]; c1 *= d1[i]; }
        X[(0 * 4 + seg) * 128 + pl] = s0; X[(1 * 4 + seg) * 128 + pl] = s1; X[(2 * 4 + seg) * 128 + pl] = c0; X[(3 * 4 + seg) * 128 + pl] = c1;
        __syncthreads();
        float k0 = 0.f, k1 = 0.f;
#pragma unroll
        for (int k = 0; k < 3; ++k) {
            if (k < seg) { k0 = X[(2 * 4 + k) * 128 + pl] * k0 + X[(0 * 4 + k) * 128 + pl]; k1 = X[(3 * 4 + k) * 128 + pl] * k1 + X[(1 * 4 + k) * 128 + pl]; }
        }
        s0 = k0; s1 = k1;
#pragma unroll
        for (int i = 0; i < SEGL; ++i) { sp[(size_t)i * 4096] = pk2(s0, s1); s0 = d0[i] * s0 + bflo(u[i]); s1 = d1[i] * s1 + bfhi(u[i]); }
        __syncthreads();
    }
}

template <int HALF>
__device__ __forceinline__ void pool_rows(const bf16_t* proj, bf16_t* Y, int c0, int t0, int seg_lo, int seg_hi) {
    constexpr int NR = 2 * HALF + 3;
    u32x4 uw[NR];
#pragma unroll
    for (int j = 0; j < NR; ++j) { const int rc = min(max(t0 - HALF + j, seg_lo), seg_hi - 1); uw[j] = *(const u32x4*)(proj + PP + (size_t)rc * 256 + c0); }
    float sm[8];
#pragma unroll
    for (int i = 0; i < 8; ++i) sm[i] = 0.f;
#pragma unroll
    for (int j = 0; j < NR; ++j) {
        const int rr = t0 - HALF + j; const bool inseg = rr >= seg_lo && rr < seg_hi;
        const unsigned uu[4] = {uw[j].x, uw[j].y, uw[j].z, uw[j].w};
        float uv[8];
#pragma unroll
        for (int i = 0; i < 4; ++i) { uv[2 * i] = inseg ? bflo(uu[i]) : 0.f; uv[2 * i + 1] = inseg ? bfhi(uu[i]) : 0.f; }
#pragma unroll
        for (int i = 0; i < 8; ++i) sm[i] += uv[i];
        if (j >= 2 * HALF - 1) {
            const int tt = j - (2 * HALF - 1), tk = t0 + tt, lo = max(tk - HALF, seg_lo), hi = min(tk + HALF, seg_hi);
            const float inv = 1.0f / (float)(hi - lo);
            const unsigned su[4] = {uw[HALF + tt].x, uw[HALF + tt].y, uw[HALF + tt].z, uw[HALF + tt].w};
            float pp[8];
#pragma unroll
            for (int i = 0; i < 8; ++i) pp[i] = sm[i] * inv - ((i & 1) ? bfhi(su[i >> 1]) : bflo(su[i >> 1]));
            *(u32x4*)(Y + (size_t)tk * D + 768 + c0) = (u32x4){pk2(pp[0], pp[1]), pk2(pp[2], pp[3]), pk2(pp[4], pp[5]), pk2(pp[6], pp[7])};
            const int jl = tt; const int rl = t0 - HALF + jl; const bool insl = rl >= seg_lo && rl < seg_hi;
            const unsigned ul[4] = {uw[jl].x, uw[jl].y, uw[jl].z, uw[jl].w};
#pragma unroll
            for (int i = 0; i < 4; ++i) { sm[2 * i] -= insl ? bflo(ul[i]) : 0.f; sm[2 * i + 1] -= insl ? bfhi(ul[i]) : 0.f; }
        }
    }
}

__device__ __forceinline__ void phase_gla_out(const Args& a, int l, int nchunks, LAS unsigned char* lds) {
    const int tid = tid_opaque(), lane = tid & 63, wave = tid >> 6, fr = lane & 15, fq = lane >> 4;
    const bf16_t* proj = (const bf16_t*)(a.ws + WS_PROJ);
    const bf16_t* S = (const bf16_t*)(a.ws + WS_S); bf16_t* Y = (bf16_t*)(a.ws + WS_Y);
    const float* gate_w = a.in[9] + (size_t)l * 2 * 16 * 256; const float* gate_b = a.in[10] + (size_t)l * 2 * 256;
    const float* gnw = a.in[11] + l * 128; const float* conv_w = a.in[12] + l * 3 * 256;
    LAS float* BF = (LAS float*)(lds + L_BF); LAS float* BB = (LAS float*)(lds + L_BB); LAS float* SSX = (LAS float*)(lds + L_SEG);
    LAS bf16_t* QEF = (LAS bf16_t*)(lds + L_QEF); LAS bf16_t* QEB = (LAS bf16_t*)(lds + L_QEB);
    LAS bf16_t* KIF = (LAS bf16_t*)(lds + L_KIF); LAS bf16_t* KIB = (LAS bf16_t*)(lds + L_KIB);
    LAS bf16_t* VT = (LAS bf16_t*)(lds + L_VT); LAS bf16_t* PF = (LAS bf16_t*)(lds + L_PF); LAS bf16_t* PB = (LAS bf16_t*)(lds + L_PB);
    const int n_gla = nchunks * 4;
    GFirst R; GateConst gc; gc.h = -1;
    if (bid_opaque() < n_gla) { const ChunkInfo c0 = chunk_info(bid_opaque() >> 2); gla_load_first<true>(R, proj, c0.r0, bid_opaque() & 3, tid); }
#pragma unroll 1
    for (int it = bid_opaque(); it < n_gla + nchunks; it += gridDim.x) {
        if (it < n_gla) {
            const int cidx = it >> 2, h = it & 3; const ChunkInfo ci = chunk_info(cidx);
            const int tt = wave & 3, dvh = wave >> 2, trow = tt * 16 + fr;
            bf16x8 sfa[2][4], sba[2][4]; u32x2 rw[4];
            {
                const bf16_t* Sf = S + ((size_t)((ci.b * 4 + h) * 2 + 0) * NPOS + ci.posf) * 8192;
                const bf16_t* Sb = S + ((size_t)((ci.b * 4 + h) * 2 + 1) * NPOS + ci.posb) * 8192;
#pragma unroll
                for (int ks = 0; ks < 2; ++ks)
#pragma unroll
                    for (int jd = 0; jd < 4; ++jd) { const int dv = dvh * 64 + jd * 16 + fr;
                        sfa[ks][jd] = *(const bf16x8*)(Sf + (size_t)dv * 64 + ks * 32 + 8 * fq); sba[ks][jd] = *(const bf16x8*)(Sb + (size_t)dv * 64 + ks * 32 + 8 * fq); }
#pragma unroll
                for (int jd = 0; jd < 4; ++jd) rw[jd] = *(const u32x2*)(proj + PR + ((size_t)h * MALL + (size_t)(ci.r0 + trow)) * 128 + dvh * 64 + jd * 16 + 4 * fq);
            }
            const int itn = it + gridDim.x; const ChunkInfo cn = chunk_info((itn < n_gla ? itn : it) >> 2);
            if (gc.h != h) gate_const(gc, gate_w, gate_b, h, tid);
            GFirst Rn;
#pragma unroll
            for (int tt = 0; tt < 4; ++tt) Rn.zf[tt] = R.zf[tt];
            if (itn < n_gla) gla_load_a(Rn, proj, cn.r0, tid);
            gla_gates(R, gc, lds, tid);
            { const int t = tid & 63, cg = tid >> 6;
              const unsigned qq[4] = {R.q.x, R.q.y, R.q.z, R.q.w}, kk[4] = {R.k.x, R.k.y, R.k.z, R.k.w};
              const f32x4 bfa = *(const LAS f32x4*)(BF + t * BPITCH + cg * 8), bfb = *(const LAS f32x4*)(BF + t * BPITCH + cg * 8 + 4);
              const f32x4 bba = *(const LAS f32x4*)(BB + t * BPITCH + cg * 8), bbb = *(const LAS f32x4*)(BB + t * BPITCH + cg * 8 + 4);
              unsigned oqf[4], oqb[4], okf[4], okb[4];
#pragma unroll
              for (int i = 0; i < 4; ++i) {
                  const float ef0 = __expf(pick8(bfa, bfb, 2 * i)), ef1 = __expf(pick8(bfa, bfb, 2 * i + 1)), eb0 = __expf(pick8(bba, bbb, 2 * i)), eb1 = __expf(pick8(bba, bbb, 2 * i + 1));
                  const float q0 = bflo(qq[i]) * 0.125f, q1 = bfhi(qq[i]) * 0.125f, k0 = bflo(kk[i]), k1 = bfhi(kk[i]);
                  oqf[i] = pk2(q0 * ef0, q1 * ef1); oqb[i] = pk2(q0 * eb0, q1 * eb1);
                  okf[i] = pk2(k0 * __builtin_amdgcn_rcpf(ef0), k1 * __builtin_amdgcn_rcpf(ef1)); okb[i] = pk2(k0 * __builtin_amdgcn_rcpf(eb0), k1 * __builtin_amdgcn_rcpf(eb1));
              }
              *(LAS u32x4*)(QEF + t * PITCH + cg * 8) = (u32x4){oqf[0], oqf[1], oqf[2], oqf[3]};
              *(LAS u32x4*)(QEB + t * PITCH + cg * 8) = (u32x4){oqb[0], oqb[1], oqb[2], oqb[3]};
              *(LAS u32x4*)(KIF + t * PITCH + cg * 8) = (u32x4){okf[0], okf[1], okf[2], okf[3]};
              *(LAS u32x4*)(KIB + t * PITCH + cg * 8) = (u32x4){okb[0], okb[1], okb[2], okb[3]}; }
            gla_write_vt(R, lds, tid);
            if (itn < n_gla) gla_load_b<true>(R, proj, cn.r0, itn & 3, tid);
            __syncthreads();
            {
                const int dir = wave >> 2;
                const LAS bf16_t* KI = dir ? KIB : KIF; const LAS bf16_t* QE = dir ? QEB : QEF; LAS bf16_t* P = dir ? PB : PF;
                bf16x8 qb[2];
#pragma unroll
                for (int ks = 0; ks < 2; ++ks) qb[ks] = *(const LAS bf16x8*)(QE + trow * PITCH + ks * 32 + 8 * fq);
#pragma unroll
                for (int st = 0; st < 4; ++st) {
                    f32x4 acc = (f32x4){0.f, 0.f, 0.f, 0.f};
#pragma unroll
                    for (int ks = 0; ks < 2; ++ks) { const bf16x8 ka = *(const LAS bf16x8*)(KI + (st * 16 + fr) * PITCH + ks * 32 + 8 * fq);
                        acc = __builtin_amdgcn_mfma_f32_16x16x32_bf16(ka, qb[ks], acc, 0, 0, 0); }
                    const int s0 = st * 16 + 4 * fq;
#pragma unroll
                    for (int r = 0; r < 4; ++r) { const int s = s0 + r; const bool keep = dir ? (s >= trow) : (s <= trow); acc[r] = keep ? acc[r] : 0.f; }
                    u32x2 o; o.x = pk2(acc[0], acc[1]); o.y = pk2(acc[2], acc[3]);
                    *(LAS u32x2*)(P + trow * PITCH + s0) = o;
                }
            }
            __syncthreads();
            {
                f32x4 acc[4];
#pragma unroll
                for (int jd = 0; jd < 4; ++jd) acc[jd] = (f32x4){0.f, 0.f, 0.f, 0.f};
#pragma unroll
                for (int ks = 0; ks < 2; ++ks) {
                    const bf16x8 pf = *(const LAS bf16x8*)(PF + trow * PITCH + ks * 32 + 8 * fq), pb = *(const LAS bf16x8*)(PB + trow * PITCH + ks * 32 + 8 * fq);
                    const bf16x8 qf = *(const LAS bf16x8*)(QEF + trow * PITCH + ks * 32 + 8 * fq), qb = *(const LAS bf16x8*)(QEB + trow * PITCH + ks * 32 + 8 * fq);
#pragma unroll
                    for (int jd = 0; jd < 4; ++jd) {
                        const int dv = dvh * 64 + jd * 16 + fr;
                        const bf16x8 va = *(const LAS bf16x8*)(VT + dv * PITCH + ks * 32 + 8 * fq);
                        acc[jd] = __builtin_amdgcn_mfma_f32_16x16x32_bf16(va, pf, acc[jd], 0, 0, 0);
                        acc[jd] = __builtin_amdgcn_mfma_f32_16x16x32_bf16(va, pb, acc[jd], 0, 0, 0);
                        acc[jd] = __builtin_amdgcn_mfma_f32_16x16x32_bf16(sfa[ks][jd], qf, acc[jd], 0, 0, 0);
                        acc[jd] = __builtin_amdgcn_mfma_f32_16x16x32_bf16(sba[ks][jd], qb, acc[jd], 0, 0, 0);
                    }
                }
                float ss = 0.f;
#pragma unroll
                for (int jd = 0; jd < 4; ++jd) ss += (acc[jd][0] * acc[jd][0] + acc[jd][1] * acc[jd][1]) + (acc[jd][2] * acc[jd][2] + acc[jd][3] * acc[jd][3]);
                ss += __shfl_xor(ss, 16); ss += __shfl_xor(ss, 32);
                if (fq == 0) SSX[dvh * 64 + trow] = ss;
                __syncthreads();
                const float rs = rsqrtf((SSX[trow] + SSX[64 + trow]) * (1.0f / 128.0f) + EPS);
                const size_t row = (size_t)(ci.r0 + trow);
#pragma unroll
                for (int jd = 0; jd < 4; ++jd) {
                    const int dv = dvh * 64 + jd * 16 + 4 * fq;
                    const f32x4 nw = *(const f32x4*)(gnw + dv);
                    const float y0 = acc[jd][0] * rs * nw.x * siluf(bflo(rw[jd].x)), y1 = acc[jd][1] * rs * nw.y * siluf(bfhi(rw[jd].x));
                    const float y2 = acc[jd][2] * rs * nw.z * siluf(bflo(rw[jd].y)), y3 = acc[jd][3] * rs * nw.w * siluf(bfhi(rw[jd].y));
                    u32x2 o; o.x = pk2(y0, y1); o.y = pk2(y2, y3);
                    *(u32x2*)(Y + row * D + h * 128 + dv) = o;
                }
            }
#pragma unroll
            for (int tt = 0; tt < 4; ++tt) R.zf[tt] = Rn.zf[tt];
        } else {
            const ChunkInfo ci = chunk_info(it - n_gla);
            const int c0 = (tid & 31) * 8, t0 = ci.r0 + (tid >> 5) * 4;
            {
                float z[6][8];
#pragma unroll
                for (int j = 0; j < 6; ++j) {
                    const int rr = t0 + j - 1; const bool ok = rr >= ci.seg_lo && rr < ci.seg_hi; const int rc = min(max(rr, ci.seg_lo), ci.seg_hi - 1);
                    const u32x4 cw = *(const u32x4*)(proj + PC + (size_t)rc * 768 + 256 + c0), hw = *(const u32x4*)(proj + PC + (size_t)rc * 768 + 512 + c0);
                    const unsigned cc[4] = {cw.x, cw.y, cw.z, cw.w}, hh[4] = {hw.x, hw.y, hw.z, hw.w};
#pragma unroll
                    for (int i = 0; i < 4; ++i) { z[j][2 * i] = ok ? bflo(cc[i]) * bflo(hh[i]) : 0.f; z[j][2 * i + 1] = ok ? bfhi(cc[i]) * bfhi(hh[i]) : 0.f; }
                }
                float w0[8], w1[8], w2[8];
#pragma unroll
                for (int i = 0; i < 8; ++i) { w0[i] = conv_w[c0 + i]; w1[i] = conv_w[256 + c0 + i]; w2[i] = conv_w[512 + c0 + i]; }
#pragma unroll
                for (int tt = 0; tt < 4; ++tt) {
                    const u32x4 bw = *(const u32x4*)(proj + PC + (size_t)(t0 + tt) * 768 + c0);
                    const unsigned bbv[4] = {bw.x, bw.y, bw.z, bw.w};
                    float yc[8];
#pragma unroll
                    for (int i = 0; i < 8; ++i) { const float bgv = (i & 1) ? bfhi(bbv[i >> 1]) : bflo(bbv[i >> 1]); yc[i] = bgv * (w0[i] * z[tt][i] + w1[i] * z[tt + 1][i] + w2[i] * z[tt + 2][i]); }
                    *(u32x4*)(Y + (size_t)(t0 + tt) * D + 512 + c0) = (u32x4){pk2(yc[0], yc[1]), pk2(yc[2], yc[3]), pk2(yc[4], yc[5]), pk2(yc[6], yc[7])};
                }
            }
            {
                const int pg = __builtin_amdgcn_readfirstlane(wave & 3);
                const int pc0 = pg * 64 + (lane & 7) * 8, pt0 = ci.r0 + ((wave >> 2) * 8 + (lane >> 3)) * 4;
                if (pg == 0) pool_rows<1>(proj, Y, pc0, pt0, ci.seg_lo, ci.seg_hi);
                else if (pg == 1) pool_rows<2>(proj, Y, pc0, pt0, ci.seg_lo, ci.seg_hi);
                else if (pg == 2) pool_rows<4>(proj, Y, pc0, pt0, ci.seg_lo, ci.seg_hi);
                else pool_rows<8>(proj, Y, pc0, pt0, ci.seg_lo, ci.seg_hi);
            }
        }
    }
}

#define XB_TMO      128
#define XB_XCNT(j)  (256  + 64 * (j))
#define XB_XSUB(j)  (1280 + 64 * (j))
#define XB_XGEN(j)  (2304 + 64 * (j))
#define XB_TOP      3328
#define XB_TOPGEN   3392
#define XCD_BAR_WORDS 3456
#define XB_SPIN_CAP (1u << 18)

__device__ __forceinline__ unsigned xb_ld(unsigned* p)              { return __hip_atomic_load(p, __ATOMIC_RELAXED, __HIP_MEMORY_SCOPE_AGENT); }
__device__ __forceinline__ unsigned xb_add(unsigned* p, unsigned v) { return __hip_atomic_fetch_add(p, v, __ATOMIC_RELAXED, __HIP_MEMORY_SCOPE_AGENT); }
__device__ __forceinline__ unsigned xb_xcc_id() { return (unsigned)__builtin_amdgcn_s_getreg((3 << 11) | 20) & 0xFu; }
#define XB_SPIN(cond, bar) do { unsigned _sp = 0; while (cond) { __builtin_amdgcn_s_sleep(1); \
    if ((++_sp & 255u) == 0u) { if (xb_ld(&(bar)[XB_TMO])) break; if (_sp > XB_SPIN_CAP) { atomicAdd(&(bar)[XB_TMO], 1u); break; } } } } while (0)

struct XcdBarrier {
    unsigned* bar; unsigned x;
    volatile LAS unsigned* st;
};

__device__ __forceinline__ XcdBarrier xcd_barrier_post(unsigned* bar, volatile LAS unsigned* st) {
    XcdBarrier b; b.bar = bar; b.x = xb_xcc_id(); b.st = st;
    if (threadIdx.x == 0) (void)xb_add(&bar[XB_XCNT(b.x)], 1u);
    return b;
}
__device__ __forceinline__ void xcd_barrier_complete(unsigned* bar, unsigned x, unsigned& nloc, unsigned& nx) {
    const unsigned G = gridDim.x * gridDim.y * gridDim.z;
    unsigned sum, cnt, mine, sp = 0u;
    for (;;) {
        sum = 0u; cnt = 0u; mine = 0u;
#pragma unroll
        for (unsigned j = 0; j < 16; ++j) { const unsigned c = xb_ld(&bar[XB_XCNT(j)]); sum += c; cnt += (c > 0u) ? 1u : 0u; mine = (j == x) ? c : mine; }
        if (sum == G) break;
        __builtin_amdgcn_s_sleep(1);
        if ((++sp & 255u) == 0u) { if (xb_ld(&bar[XB_TMO])) break; if (sp > XB_SPIN_CAP) { atomicAdd(&bar[XB_TMO], 1u); break; } }
    }
    nloc = mine > 0u ? mine : 1u; nx = cnt > 0u ? cnt : 1u;
}

__device__ __forceinline__ void xcd_barrier(const XcdBarrier& b) {
    asm volatile("s_waitcnt vmcnt(0)" ::: "memory");
    __syncthreads();
    if (threadIdx.x == 0) {
        unsigned* bar = b.bar; asm volatile("" : "+s"(bar));
        __builtin_amdgcn_s_waitcnt(0);
        unsigned nloc = b.st[0], nx = b.st[1];
        if (nloc == 0u) { xcd_barrier_complete(bar, b.x, nloc, nx); b.st[0] = nloc; b.st[1] = nx; }
        const unsigned old = xb_add(&bar[XB_XSUB(b.x)], 1u);
        const unsigned gen = old / nloc;
        if (old + 1u == (gen + 1u) * nloc) {
            __builtin_amdgcn_fence(__ATOMIC_RELEASE, "agent");
            asm volatile("s_waitcnt vmcnt(0)" ::: "memory");
            const unsigned og = xb_add(&bar[XB_TOP], 1u);
            const unsigned tg = og / nx;
            if (og + 1u == (tg + 1u) * nx) xb_add(&bar[XB_TOPGEN], 1u);
            else XB_SPIN(xb_ld(&bar[XB_TOPGEN]) == tg, bar);
            __builtin_amdgcn_fence(__ATOMIC_ACQUIRE, "agent");
            xb_add(&bar[XB_XGEN(b.x)], 1u);
            asm volatile("s_waitcnt vmcnt(0)" ::: "memory");
        } else {
            XB_SPIN(xb_ld(&bar[XB_XGEN(b.x)]) == gen, bar);
            __builtin_amdgcn_fence(__ATOMIC_ACQUIRE, "agent");
            asm volatile("s_waitcnt vmcnt(0)" ::: "memory");
        }
    }
    __syncthreads();
}


__global__ void __launch_bounds__(NTHREADS, 2) hybrid_fwd(Args a) {
    extern __shared__ __attribute__((aligned(16))) unsigned char smem[];
    LAS unsigned char* lds = (LAS unsigned char*)smem;
    cg::grid_group grid = cg::this_grid();
    const int G = gridDim.x;
    volatile LAS unsigned* bst = (volatile LAS unsigned*)(lds + 131072 + 64);
    if (tid_opaque() < 2) bst[tid_opaque()] = 0u;
    __syncthreads();
    const XcdBarrier bar = xcd_barrier_post((unsigned*)(a.ws + WS_BAR), bst);
#pragma unroll 1
    for (int ph = a.ph_lo; ph < a.ph_hi; ++ph) {
      {
        unsigned char* ws = a.ws; asm volatile("" : "+s"(ws));
        float* MOD = (float*)(ws + WS_MOD);
        bf16_t* H = (bf16_t*)a.out; bf16_t* X = (bf16_t*)(ws + WS_X); bf16_t* PROJ = (bf16_t*)(ws + WS_PROJ); bf16_t* Yb = (bf16_t*)(ws + WS_Y); bf16_t* ACT = (bf16_t*)(ws + WS_ACT);
        float* XC = (float*)(ws + WS_XC);
        if (ph == 0) { phase_prep(a, lds); }
        else if (ph == NPHASES - 1) { phase_final(X, a.out, a.in[18]); }
        else {
            const int l = (ph - 1) / 9, sp = (ph - 1) % 9;
            const float* xctx = l == 0 ? a.in[2] : XC;
            const float* mod = MOD + l * 3 * NMODV;
            const int mrows = l == 0 ? MALL : MLAT;
            if (sp == 0) phase_norm(l == 0 ? a.in[0] : nullptr, X, xctx, MALL, a.in[6] + l * D, mod, 0, 1024, H, (const float*)(ws + WS_PART), l == 0 ? 0 : FF / 256, XC);
            else if (sp == 1) {
                pg8::Gemm g{H, (const bf16_t*)(ws + WS_WIN) + (size_t)l * INP * D, MALL, INP, D, D}; pg8::StaticOrder S; S.init(MALL, INP, G, bid_opaque()); S.ntk = D / 64;
                EpiProj E{PROJ}; pg8::gemm_phase<EpiProj, pg8::StaticOrder, GEMM_ALIGN, GEMM_SP2>(lds, g, S, E);
            }
            else if (sp == 2) phase_gla_u(a, l, lds);
            else if (sp == 3) phase_gla_scan(a, lds);
            else if (sp == 4) phase_gla_out(a, l, mrows / 64, lds);
            else if (sp == 5 || sp == 8) {
                const bool mix = sp == 5; const int KK = mix ? D : FF;
                const bf16_t* Ap = mix ? Yb : ACT; const bf16_t* Bp = mix ? (const bf16_t*)(ws + WS_WOUT) + (size_t)l * D * D : (const bf16_t*)(ws + WS_W2) + (size_t)l * D * FF;
                const float* gate = mod + (mix ? 2048 : 5120);
                pg8::Gemm g{Ap, Bp, MALL, D, KK, KK};
                pg8::MixedOrder S; S.lat.init(MLAT, D, G, bid_opaque()); S.lat.ntk = KK / 64; S.nks = l == 0 ? KK / 256 : 0; S.kslice = 256;
                EpiRes E{(mix && l == 0) ? a.in[0] : nullptr, X, (float*)(ws + WS_PART), gate};
                pg8::gemm_phase<EpiRes, pg8::MixedOrder, GEMM_ALIGN, GEMM_SP2>(lds, g, S, E);
            }
            else if (sp == 6) phase_norm(nullptr, X, l == 0 ? a.in[2] : (const float*)XC, mrows, a.in[7] + l * D, mod, 3072, 4096, H, (const float*)(ws + WS_PART), l == 0 ? D / 256 : 0, XC);
            else {
                pg8::Gemm g{H, (const bf16_t*)(ws + WS_W1) + (size_t)l * FF * D, mrows, FF, D, D}; pg8::StaticOrder S; S.init(mrows, FF, G, bid_opaque()); S.ntk = D / 64;
                EpiAct E{ACT}; pg8::gemm_phase<EpiAct, pg8::StaticOrder, GEMM_ALIGN, GEMM_SP2>(lds, g, S, E);
            }
        }
      }
        if (ph + 1 < a.ph_hi) {
            if (a.ph_hi > NPHASES) {
                __builtin_amdgcn_fence(__ATOMIC_RELEASE, "agent"); asm volatile("s_waitcnt vmcnt(0)" ::: "memory");
                grid.sync();
                __builtin_amdgcn_fence(__ATOMIC_ACQUIRE, "agent"); asm volatile("s_waitcnt vmcnt(0)" ::: "memory");
            }
            xcd_barrier(bar);
        }
    }
}

extern "C" void kernel_launch(void* const* d_in, const int* in_sizes, int n_in, void* d_out, int out_size, void* d_ws, size_t ws_size, hipStream_t stream) {
    static int grid = 0;
    if (grid == 0) {
        int dev = 0, cus = 0, per_cu = 0;
        hipGetDevice(&dev);
        hipDeviceGetAttribute(&cus, hipDeviceAttributeMultiprocessorCount, dev);
        hipFuncSetAttribute((const void*)hybrid_fwd, hipFuncAttributeMaxDynamicSharedMemorySize, LDS_BYTES);
        hipOccupancyMaxActiveBlocksPerMultiprocessor(&per_cu, (const void*)hybrid_fwd, NTHREADS, LDS_BYTES);
        if (per_cu < 1) { fprintf(stderr, "kernel_launch: occupancy query reports %d blocks per CU\n", per_cu); per_cu = 1; }
        (void)hipGetLastError();
        grid = cus * per_cu;
        if (n_in != 19 || ws_size < WS_END) fprintf(stderr, "kernel_launch: unexpected n_in %d / ws_size %zu\n", n_in, ws_size);
    }
    (void)hipMemsetAsync((char*)d_ws + WS_BAR, 0, BAR_BYTES, stream);
    Args a{};
    for (int i = 0; i < 19; ++i) a.in[i] = (const float*)d_in[i];
    a.out = (float*)d_out; a.ws = (unsigned char*)d_ws;
    a.ph_lo = 0; a.ph_hi = NPHASES;
    void* args[] = {&a};
    hipError_t e = hipLaunchCooperativeKernel((const void*)hybrid_fwd, dim3(grid), dim3(NTHREADS), args, LDS_BYTES, stream);
    if (e != hipSuccess) fprintf(stderr, "cooperative launch failed: %s (grid %d)\n", hipGetErrorString(e), grid);
}
```

```cpp
#include <hip/hip_runtime.h>
#include <hip/hip_cooperative_groups.h>
#include <cstdio>
namespace cg = cooperative_groups;
__device__ __forceinline__ int tid_opaque() { int t = threadIdx.x; asm volatile("" : "+v"(t)); return t; }
__device__ __forceinline__ int bid_opaque() { int t = blockIdx.x; asm volatile("" : "+s"(t)); return t; }
namespace pg8 {
#define PG8_LAS __attribute__((address_space(3)))
typedef unsigned short bf16_t;
typedef short bf16x8 __attribute__((ext_vector_type(8)));
typedef float f32x4 __attribute__((ext_vector_type(4)));
typedef unsigned u32x4 __attribute__((ext_vector_type(4)));
constexpr int BM = 256, BK = 64, HALF = 128, HTB = HALF * BK * 2  , STAGE_BYTES = 8 * HTB, NXCD = 8, WGM = 8;

__host__ __device__ __forceinline__ int lds_byte(int r, int c) { const int st = (r >> 4) * 2 + (c >> 5), rr = r & 15, cc = c & 31, ob = rr * 64 + cc * 2; return st * 1024 + (ob ^ (((ob >> 9) & 1) << 5)); }
__host__ __device__ __forceinline__ void stage_rc(int b, int& R, int& C) { const int st = b / 1024, sb = b % 1024, swz = sb ^ (((sb >> 9) & 1) << 5); R = (st >> 1) * 16 + swz / 64; C = (st & 1) * 32 + (swz % 64) / 2; }
__host__ __device__ __forceinline__ int perm32(int rho) { const int n = rho >> 4, i = rho & 15; return 8 * (i >> 2) + 4 * n + (i & 3); }

struct Unit { int pm, pn, kofs, nt; };
struct Gemm { const bf16_t* A; const bf16_t* Bt; int M, N, K, ld; };

struct StaticOrder {
    int nM, nN, nwg, G, c, ntk;
    __host__ __device__ void init(int M, int N, int G_, int c_) { nM = M / BM; nN = N / BM; nwg = nM * nN; G = G_; c = c_; }
    __host__ __device__ bool next(int i, Unit& u) const {
        const long L = (long)i * G + c; if (L >= nwg) return false;
        int wgid = (int)L; { const int q = nwg / NXCD, r = nwg % NXCD, xcd = wgid % NXCD, off = wgid / NXCD; wgid = (xcd < r ? xcd * (q + 1) : r * (q + 1) + (xcd - r) * q) + off; }
        const int nig = WGM * nN, gid = wgid / nig, fm = gid * WGM, gsz = (nM - fm) < WGM ? (nM - fm) : WGM;
        u.pm = fm + ((wgid % nig) % gsz); u.pn = (wgid % nig) / gsz; u.kofs = 0; u.nt = ntk; return true;
    }
    __device__ __forceinline__ void a_ready(const Unit&) const {}
    __device__ __forceinline__ void done(const Unit&) const {}
};
struct MixedOrder {
    StaticOrder lat; int nks, kslice;
    __device__ __forceinline__ bool next(int i, Unit& u) const {
        const int L = i * lat.G + lat.c;
        if (L < lat.nwg) return lat.next(i, u);
        const int j = L - lat.nwg; if (j >= 8 * nks) return false;
        u.pm = 64 + (j & 1); u.pn = (j >> 1) & 3; u.kofs = (j >> 3) * kslice; u.nt = kslice / BK; return true;
    }
    __device__ __forceinline__ void a_ready(const Unit&) const {}
    __device__ __forceinline__ void done(const Unit&) const {}
};
__device__ __forceinline__ unsigned cvt_pk_bf16(float lo, float hi) { unsigned r; asm volatile("v_cvt_pk_bf16_f32 %0, %1, %2" : "=v"(r) : "v"(lo), "v"(hi)); return r; }
template <class Epi, class Sched, bool ALIGN_EPI = false, bool SP2 = false>
__device__ __forceinline__ void gemm_phase(PG8_LAS unsigned char* lds, const Gemm g, const Sched& S, const Epi& E) {
    const int tid = tid_opaque(), wid = __builtin_amdgcn_readfirstlane(tid >> 6), lane = tid & 63, wr = wid >> 2, wc = wid & 3, fr = lane & 15, fq = lane >> 4;
    const int LD = g.ld;
    unsigned voffA[2], voffB[2];
#pragma unroll
    for (int i = 0; i < 2; ++i) { int R, C; stage_rc(tid * 16 + i * 8192, R, C); const int Rb = Epi::PERM ? ((R & ~31) + perm32(R & 31)) : R;
        voffA[i] = (unsigned)(R * LD + C) * 2u; voffB[i] = (unsigned)(Rb * LD + C) * 2u; }
    const size_t kstep = (size_t)(BK * 2);
    const size_t hstep = (size_t)HALF * LD * 2;
    const size_t tstep = 2 * hstep;
    const unsigned ldsw = (unsigned)wid * 1024u;
    const int aoff = lds_byte(wr * 64 + fr, fq * 8), boff = lds_byte(wc * 32 + fr, fq * 8);
#define PG8_SA(b, h) (((b) * 2 + (h)) * HTB)
#define PG8_SB(b, h) ((4 + (b) * 2 + (h)) * HTB)
#define PG8_STAGE(bufoff, gbase, voff) do { _Pragma("unroll") for (int _i = 0; _i < 2; ++_i) \
        __builtin_amdgcn_global_load_lds((const unsigned*)((const char*)(gbase) + (voff)[_i]), (PG8_LAS unsigned*)(lds + (bufoff) + ldsw + _i * 8192), 16, 0, 0); } while (0)
#define PG8_LDA(dst, b, h) do { _Pragma("unroll") for (int m = 0; m < 4; ++m) _Pragma("unroll") for (int k = 0; k < 2; ++k) dst[m][k] = *(const PG8_LAS bf16x8*)(lds + PG8_SA(b, h) + aoff + m * 2048 + k * 1024); } while (0)
#define PG8_LDB(dst, b, h) do { _Pragma("unroll") for (int n = 0; n < 2; ++n) _Pragma("unroll") for (int k = 0; k < 2; ++k) dst[n][k] = *(const PG8_LAS bf16x8*)(lds + PG8_SB(b, h) + boff + n * 2048 + k * 1024); } while (0)
#define PG8_MMA(ai, bj, At, Bt) do { __builtin_amdgcn_s_setprio(1); _Pragma("unroll") for (int m = 0; m < 4; ++m) _Pragma("unroll") for (int n = 0; n < 2; ++n) _Pragma("unroll") for (int k = 0; k < 2; ++k) \
        acc[ai][bj][m][n] = __builtin_amdgcn_mfma_f32_16x16x32_bf16(Bt[n][k], At[m][k], acc[ai][bj][m][n], 0, 0, 0); __builtin_amdgcn_s_setprio(0); } while (0)
#define PG8_WAIT_V(n) asm volatile("s_waitcnt vmcnt(" #n ")" ::: "memory")
#define PG8_WAIT_L(n) asm volatile("s_waitcnt lgkmcnt(" #n ")" ::: "memory")
#define PG8_BAR __builtin_amdgcn_s_barrier()
#define PG8_SCHED __builtin_amdgcn_sched_barrier(0)
    Unit cur, nxt; int ui = 0;
    if (!S.next(0, cur)) return;
    f32x4 acc[2][2][4][2];
#pragma unroll
    for (int a = 0; a < 2; ++a)
#pragma unroll
        for (int b = 0; b < 2; ++b)
#pragma unroll
            for (int m = 0; m < 4; ++m)
#pragma unroll
                for (int n = 0; n < 2; ++n) acc[a][b][m][n] = (f32x4){0.f, 0.f, 0.f, 0.f};
    bf16x8 At[4][2], B0[2][2], B1[2][2];
    const char* cA = (const char*)g.A + (size_t)cur.pm * tstep + (size_t)cur.kofs * 2; const char* cB = (const char*)g.Bt + (size_t)cur.pn * tstep + (size_t)cur.kofs * 2;
    S.a_ready(cur);
    if constexpr (SP2) {
        PG8_STAGE(PG8_SB(0, 0), cB, voffB); PG8_STAGE(PG8_SB(0, 1), cB + hstep, voffB); PG8_STAGE(PG8_SA(0, 0), cA, voffA); PG8_STAGE(PG8_SA(0, 1), cA + hstep, voffA);
        if (wr == 1) PG8_BAR;
        PG8_WAIT_V(2); PG8_BAR;
        PG8_STAGE(PG8_SB(1, 0), cB + kstep, voffB); PG8_STAGE(PG8_SA(1, 0), cA + kstep, voffA); PG8_STAGE(PG8_SB(1, 1), cB + hstep + kstep, voffB);
        PG8_WAIT_V(6); PG8_BAR;
    } else {
        PG8_STAGE(PG8_SB(0, 0), cB, voffB); PG8_STAGE(PG8_SA(0, 0), cA, voffA); PG8_STAGE(PG8_SB(0, 1), cB + hstep, voffB); PG8_STAGE(PG8_SA(0, 1), cA + hstep, voffA);
        if (wr == 1) PG8_BAR;
        PG8_WAIT_V(4); PG8_BAR;
        PG8_STAGE(PG8_SB(1, 0), cB + kstep, voffB); PG8_STAGE(PG8_SA(1, 0), cA + kstep, voffA); PG8_STAGE(PG8_SB(1, 1), cB + hstep + kstep, voffB);
        PG8_WAIT_V(6); PG8_BAR;
    }
    for (;;) {
        const bool has_next = S.next(ui + 1, nxt);
        const char* nA = has_next ? (const char*)g.A + (size_t)nxt.pm * tstep + (size_t)nxt.kofs * 2 : cA; const char* nB = has_next ? (const char*)g.Bt + (size_t)nxt.pn * tstep + (size_t)nxt.kofs * 2 : cB;
        const int nt = cur.nt;
        for (int t = 0; t < nt; t += 2) {
            const bool last = (t == nt - 2);
            const char* a1 = cA + (size_t)(t + 1) * kstep;
            const char* a2 = last ? nA : cA + (size_t)(t + 2) * kstep; const char* b2 = last ? nB : cB + (size_t)(t + 2) * kstep;
            const char* a3 = a2 + kstep; const char* b3 = b2 + kstep;
            if (last && has_next) S.a_ready(nxt);
            if constexpr (SP2) {
            PG8_LDB(B0, 0, 0); PG8_LDB(B1, 0, 1); PG8_SCHED; PG8_LDA(At, 0, 0); PG8_STAGE(PG8_SA(1, 1), a1 + hstep, voffA);
            PG8_WAIT_V(8); PG8_WAIT_L(0); PG8_BAR; PG8_MMA(0, 0, At, B0); PG8_MMA(0, 1, At, B1); PG8_BAR; PG8_SCHED;
            PG8_LDA(At, 0, 1); PG8_STAGE(PG8_SB(0, 0), b2, voffB); PG8_STAGE(PG8_SB(0, 1), b2 + hstep, voffB); PG8_STAGE(PG8_SA(0, 0), a2, voffA);
            PG8_WAIT_V(8); PG8_WAIT_L(0); PG8_BAR; PG8_MMA(1, 0, At, B0); PG8_MMA(1, 1, At, B1); PG8_BAR; PG8_SCHED;
            PG8_LDB(B0, 1, 0); PG8_LDB(B1, 1, 1); PG8_SCHED; PG8_LDA(At, 1, 0); PG8_STAGE(PG8_SA(0, 1), a2 + hstep, voffA);
            PG8_WAIT_V(8); PG8_WAIT_L(0); PG8_BAR; PG8_MMA(0, 0, At, B0); PG8_MMA(0, 1, At, B1); PG8_BAR; PG8_SCHED;
            PG8_LDA(At, 1, 1); PG8_STAGE(PG8_SB(1, 0), b3, voffB); PG8_STAGE(PG8_SB(1, 1), b3 + hstep, voffB); PG8_STAGE(PG8_SA(1, 0), a3, voffA);
            PG8_WAIT_V(8); PG8_WAIT_L(0); PG8_BAR; PG8_MMA(1, 0, At, B0); PG8_MMA(1, 1, At, B1); PG8_BAR; PG8_SCHED;
            } else {
            PG8_LDB(B0, 0, 0); PG8_SCHED; PG8_LDA(At, 0, 0); PG8_STAGE(PG8_SA(1, 1), a1 + hstep, voffA);
            PG8_WAIT_L(8); PG8_BAR; PG8_WAIT_L(0); PG8_MMA(0, 0, At, B0); PG8_BAR; PG8_SCHED;
            PG8_LDB(B1, 0, 1); PG8_STAGE(PG8_SB(0, 0), b2, voffB);
            PG8_BAR; PG8_WAIT_L(0); PG8_MMA(0, 1, At, B1); PG8_BAR;
            PG8_LDA(At, 0, 1); PG8_STAGE(PG8_SA(0, 0), a2, voffA);
            PG8_BAR; PG8_WAIT_L(0); PG8_MMA(1, 0, At, B0); PG8_BAR; PG8_SCHED;
            PG8_STAGE(PG8_SB(0, 1), b2 + hstep, voffB);
            PG8_WAIT_V(6); PG8_BAR; PG8_MMA(1, 1, At, B1); PG8_BAR;
            PG8_LDB(B0, 1, 0); PG8_SCHED; PG8_LDA(At, 1, 0); PG8_STAGE(PG8_SA(0, 1), a2 + hstep, voffA);
            PG8_WAIT_L(8); PG8_BAR; PG8_WAIT_L(0); PG8_MMA(0, 0, At, B0); PG8_BAR; PG8_SCHED;
            PG8_LDB(B1, 1, 1); PG8_STAGE(PG8_SB(1, 0), b3, voffB);
            PG8_BAR; PG8_WAIT_L(0); PG8_MMA(0, 1, At, B1); PG8_BAR;
            PG8_LDA(At, 1, 1); PG8_STAGE(PG8_SA(1, 0), a3, voffA);
            PG8_BAR; PG8_WAIT_L(0); PG8_MMA(1, 0, At, B0); PG8_BAR; PG8_SCHED;
            PG8_STAGE(PG8_SB(1, 1), b3 + hstep, voffB);
            PG8_WAIT_V(6); PG8_BAR; PG8_MMA(1, 1, At, B1); PG8_BAR;
            }
        }
        if constexpr (ALIGN_EPI) { if (wr == 0) PG8_BAR; }
        if constexpr (!Epi::AFTER_DRAIN) { E(acc, cur, wr, wc, fr, fq); S.done(cur); }
        if (!has_next) break;
#pragma unroll
        for (int a = 0; a < 2; ++a)
#pragma unroll
            for (int b = 0; b < 2; ++b)
#pragma unroll
                for (int m = 0; m < 4; ++m)
#pragma unroll
                    for (int n = 0; n < 2; ++n) acc[a][b][m][n] = (f32x4){0.f, 0.f, 0.f, 0.f};
        cur = nxt; cA = nA; cB = nB; ++ui;
        if constexpr (ALIGN_EPI) { if (wr == 1) PG8_BAR; }
    }
    PG8_WAIT_V(0);
    if constexpr (!ALIGN_EPI) { if (wr == 0) PG8_BAR; }
    PG8_BAR;
    if constexpr (Epi::AFTER_DRAIN) { E.fused(acc, cur, wr, wc, fr, fq, lds, wid, lane); S.done(cur); }
#undef PG8_SA
#undef PG8_SB
#undef PG8_STAGE
#undef PG8_LDA
#undef PG8_LDB
#undef PG8_MMA
#undef PG8_WAIT_V
#undef PG8_WAIT_L
#undef PG8_BAR
#undef PG8_SCHED
}
}

#define LAS __attribute__((address_space(3)))
typedef unsigned short bf16_t;
typedef short bf16x8 __attribute__((ext_vector_type(8)));
typedef float f32x4 __attribute__((ext_vector_type(4)));
typedef unsigned u32x4 __attribute__((ext_vector_type(4)));
typedef unsigned u32x2 __attribute__((ext_vector_type(2)));

#ifndef GEMM_SP2
#define GEMM_SP2 true
#endif
#ifndef GEMM_ALIGN
#define GEMM_ALIGN true
#endif

constexpr int D = 1024, MLAT = 16384, MCTX = 512, MALL = 16896, HALFLAT = 8192;
constexpr int INC = 2592, INP = 2816, FF = 4096;
constexpr int K_OFF = 256, V_OFF = 512, G_OFF = 1024, R_OFF = 1056, CB_OFF = 1568, CC_OFF = 1824, CH_OFF = 2080, P_OFF = 2336;
constexpr int NPOS = 132, NMODV = 6144;
constexpr size_t PQ = 0, PK = PQ + (size_t)4 * MALL * 64, PV = PK + (size_t)4 * MALL * 64, PZ = PV + (size_t)4 * MALL * 128, PR = PZ + (size_t)MALL * 32,
                 PC = PR + (size_t)4 * MALL * 128, PP = PC + (size_t)MALL * 768;
static_assert(PP + (size_t)MALL * 256 == (size_t)MALL * INC, "PROJ segments");
constexpr float EPS = 1e-6f;
constexpr int NTHREADS = 512, NWAVES = 8;
constexpr int LDS_BYTES = 147456;
constexpr int NPHASES = 20;

constexpr size_t MiB = 1u << 20;
constexpr size_t WS_MOD = 0;
constexpr size_t WS_WIN = 1 * MiB;
constexpr size_t WS_WOUT = 12 * MiB;
constexpr size_t WS_W1 = 16 * MiB;
constexpr size_t WS_W2 = 32 * MiB;
constexpr size_t WS_XC = 48 * MiB;
constexpr size_t WS_X = 50 * MiB;
constexpr size_t WS_PROJ = 83 * MiB;
constexpr size_t WS_Y = 167 * MiB;
constexpr size_t WS_ACT = 83 * MiB;
constexpr size_t WS_S = 215 * MiB;
constexpr size_t WS_PART = 215 * MiB;
constexpr size_t WS_DEC = 248 * MiB;
constexpr size_t WS_BAR = 250 * MiB;
constexpr size_t BAR_BYTES = 16384;
constexpr size_t WS_END = 251 * MiB;

struct Args {
    const float* in[19];
    float* out;
    unsigned char* ws;
    int ph_lo, ph_hi;
};

__device__ __forceinline__ float bf2f(unsigned h) { return __uint_as_float(h << 16); }
__device__ __forceinline__ float bflo(unsigned w) { return __uint_as_float(w << 16); }
__device__ __forceinline__ float bfhi(unsigned w) { return __uint_as_float(w & 0xffff0000u); }
typedef __bf16 bf16v2_t __attribute__((ext_vector_type(2)));
typedef float f32v2_t __attribute__((ext_vector_type(2)));
__device__ __forceinline__ unsigned pk2(float lo, float hi) { const f32v2_t v = {lo, hi}; const bf16v2_t b = __builtin_convertvector(v, bf16v2_t); return __builtin_bit_cast(unsigned, b); }
__device__ __forceinline__ bf16_t f2bf(float f) { return (bf16_t)(pk2(f, 0.f) & 0xffffu); }
__device__ __forceinline__ float wave_sum(float v) {
#pragma unroll
    for (int o = 1; o < 64; o <<= 1) v += __shfl_xor(v, o);
    return v;
}
__device__ __forceinline__ float siluf(float x) { return x * __builtin_amdgcn_rcpf(1.0f + __builtin_amdgcn_exp2f(-1.4426950409f * x)); }
__device__ __forceinline__ int modvec_of_row(int row) { return row < HALFLAT ? 0 : (row < MLAT ? 1 : 2); }

struct EpiProj {
    static constexpr bool PERM = true, AFTER_DRAIN = false;
    bf16_t* O;
    __device__ __forceinline__ void operator()(const f32x4 (&acc)[2][2][4][2], const pg8::Unit& u, int wr, int wc, int fr, int fq) const {
        const int row0 = u.pm * 256 + wr * 64 + fr, colt = u.pn * 256;
#pragma unroll
        for (int bj = 0; bj < 2; ++bj) {
            const int cb = colt + bj * 128 + wc * 32;
            if (cb >= INC) continue;
            size_t off0; int pitch;
            if (cb < K_OFF)       { off0 = PQ + (size_t)(cb >> 6) * MALL * 64 + (cb & 63); pitch = 64; }
            else if (cb < V_OFF)  { const int c = cb - K_OFF;  off0 = PK + (size_t)(c >> 6) * MALL * 64 + (c & 63); pitch = 64; }
            else if (cb < G_OFF)  { const int c = cb - V_OFF;  off0 = PV + (size_t)(c >> 7) * MALL * 128 + (c & 127); pitch = 128; }
            else if (cb < R_OFF)  { off0 = PZ; pitch = 32; }
            else if (cb < CB_OFF) { const int c = cb - R_OFF;  off0 = PR + (size_t)(c >> 7) * MALL * 128 + (c & 127); pitch = 128; }
            else if (cb < P_OFF)  { off0 = PC + (cb - CB_OFF); pitch = 768; }
            else                  { off0 = PP + (cb - P_OFF); pitch = 256; }
            bf16_t* base = O + off0 + 8 * fq;
#pragma unroll
            for (int ai = 0; ai < 2; ++ai)
#pragma unroll
                for (int m = 0; m < 4; ++m) {
                    const f32x4 v0 = acc[ai][bj][m][0], v1 = acc[ai][bj][m][1];
                    u32x4 w; w.x = pk2(v0[0], v0[1]); w.y = pk2(v0[2], v0[3]); w.z = pk2(v1[0], v1[1]); w.w = pk2(v1[2], v1[3]);
                    *(u32x4*)(base + (size_t)(row0 + ai * 128 + m * 16) * pitch) = w;
                }
        }
    }
};
struct EpiAct {
    static constexpr bool PERM = true, AFTER_DRAIN = false;
    bf16_t* O;
    __device__ __forceinline__ void operator()(const f32x4 (&acc)[2][2][4][2], const pg8::Unit& u, int wr, int wc, int fr, int fq) const {
        const int row0 = u.pm * 256 + wr * 64 + fr, colt = u.pn * 256;
#pragma unroll
        for (int ai = 0; ai < 2; ++ai)
#pragma unroll
            for (int m = 0; m < 4; ++m) {
                bf16_t* rowp = O + (size_t)(row0 + ai * 128 + m * 16) * FF + colt + wc * 32 + 8 * fq;
#pragma unroll
                for (int bj = 0; bj < 2; ++bj) {
                    f32x4 v0 = acc[ai][bj][m][0], v1 = acc[ai][bj][m][1];
#pragma unroll
                    for (int j = 0; j < 4; ++j) { const float a = fmaxf(v0[j], 0.f), b = fmaxf(v1[j], 0.f); v0[j] = a * a; v1[j] = b * b; }
                    u32x4 w; w.x = pk2(v0[0], v0[1]); w.y = pk2(v0[2], v0[3]); w.z = pk2(v1[0], v1[1]); w.w = pk2(v1[2], v1[3]);
                    *(u32x4*)(rowp + bj * 128) = w;
                }
            }
    }
};
struct EpiRes {
    static constexpr bool PERM = true, AFTER_DRAIN = false;
    const float* xin_f32; bf16_t* X; float* part; const float* gate;
    __device__ __forceinline__ void operator()(const f32x4 (&acc)[2][2][4][2], const pg8::Unit& u, int wr, int wc, int fr, int fq) const {
        asm volatile("" ::: "memory");
        const int rbase = __builtin_amdgcn_readfirstlane(u.pm * 256), cbase = __builtin_amdgcn_readfirstlane(u.pn * 256);
        const unsigned c32 = (unsigned)(wc * 32 + 8 * fq), o32 = (unsigned)((wr * 64 + fr) * D) + c32;
        if (rbase < MLAT) {
            const float* gp = gate + (rbase < HALFLAT ? 0 : NMODV) + cbase;
            f32x4 gv[2][2];
#pragma unroll
            for (int bj = 0; bj < 2; ++bj)
#pragma unroll
                for (int n = 0; n < 2; ++n) gv[bj][n] = *(const f32x4*)(gp + c32 + bj * 128 + 4 * n);
            bf16_t* xo = X + (size_t)rbase * D + cbase;
            if (xin_f32) {
                const float* xi = xin_f32 + (size_t)rbase * D + cbase;
#pragma unroll
                for (int ai = 0; ai < 2; ++ai) {
                    f32x4 xv[4][2][2];
#pragma unroll
                    for (int m = 0; m < 4; ++m)
#pragma unroll
                        for (int bj = 0; bj < 2; ++bj)
#pragma unroll
                            for (int n = 0; n < 2; ++n) xv[m][bj][n] = *(const f32x4*)(xi + (size_t)(ai * 128 + m * 16) * D + o32 + bj * 128 + 4 * n);
#pragma unroll
                    for (int m = 0; m < 4; ++m)
#pragma unroll
                        for (int bj = 0; bj < 2; ++bj) {
                            const f32x4 y0 = xv[m][bj][0] + gv[bj][0] * acc[ai][bj][m][0], y1 = xv[m][bj][1] + gv[bj][1] * acc[ai][bj][m][1];
                            *(u32x4*)(xo + (size_t)(ai * 128 + m * 16) * D + o32 + bj * 128) = (u32x4){pk2(y0[0], y0[1]), pk2(y0[2], y0[3]), pk2(y1[0], y1[1]), pk2(y1[2], y1[3])};
                        }
                    asm volatile("" ::: "memory");
                }
            } else {
#pragma unroll
                for (int ai = 0; ai < 2; ++ai) {
                    u32x4 xb[4][2];
#pragma unroll
                    for (int m = 0; m < 4; ++m)
#pragma unroll
                        for (int bj = 0; bj < 2; ++bj) xb[m][bj] = *(const u32x4*)(xo + (size_t)(ai * 128 + m * 16) * D + o32 + bj * 128);
#pragma unroll
                    for (int m = 0; m < 4; ++m)
#pragma unroll
                        for (int bj = 0; bj < 2; ++bj) {
                            const u32x4 w = xb[m][bj];
                            const f32x4 x0 = (f32x4){bflo(w.x), bfhi(w.x), bflo(w.y), bfhi(w.y)}, x1 = (f32x4){bflo(w.z), bfhi(w.z), bflo(w.w), bfhi(w.w)};
                            const f32x4 y0 = x0 + gv[bj][0] * acc[ai][bj][m][0], y1 = x1 + gv[bj][1] * acc[ai][bj][m][1];
                            *(u32x4*)(xo + (size_t)(ai * 128 + m * 16) * D + o32 + bj * 128) = (u32x4){pk2(y0[0], y0[1]), pk2(y0[2], y0[3]), pk2(y1[0], y1[1]), pk2(y1[2], y1[3])};
                        }
                    asm volatile("" ::: "memory");
                }
            }
        } else {
            float* xo = part + ((size_t)(u.kofs >> 8) * MCTX + (size_t)(rbase - MLAT)) * D + cbase; const float* gp = gate + 2 * NMODV + cbase;
#pragma unroll
            for (int ai = 0; ai < 2; ++ai)
#pragma unroll
                for (int m = 0; m < 4; ++m) {
                    float* xw = xo + (size_t)(ai * 128 + m * 16) * D;
#pragma unroll
                    for (int bj = 0; bj < 2; ++bj)
#pragma unroll
                        for (int n = 0; n < 2; ++n) {
                            const f32x4 gv = *(const f32x4*)(gp + c32 + bj * 128 + 4 * n);
                            *(f32x4*)(xw + o32 + bj * 128 + 4 * n) = gv * acc[ai][bj][m][n];
                        }
                    asm volatile("" ::: "memory");
                }
        }
    }
};

__device__ __forceinline__ void transpose_item(const float* W, int N, bf16_t* WT, int ldt, LAS float* scr, int item, int lane) {
    const int nblk = N / 32, kb = item / nblk, nb = item % nblk, k0 = 64 * kb, n0 = 32 * nb;
#pragma unroll 8
    for (int i = 0; i < 32; ++i) { const int kk = 2 * i + (lane >> 5); scr[kk * 33 + (lane & 31)] = W[(size_t)(k0 + kk) * N + n0 + (lane & 31)]; }
    asm volatile("s_waitcnt lgkmcnt(0)" ::: "memory");
    const int c = lane & 7;
#pragma unroll
    for (int j = 0; j < 4; ++j) { const int n = (lane >> 3) + 8 * j; const LAS float* s = scr + (8 * c) * 33 + n;
        u32x4 o; o.x = pk2(s[0 * 33], s[1 * 33]); o.y = pk2(s[2 * 33], s[3 * 33]); o.z = pk2(s[4 * 33], s[5 * 33]); o.w = pk2(s[6 * 33], s[7 * 33]);
        *(u32x4*)(WT + (size_t)(n0 + n) * ldt + k0 + 8 * c) = o; }
    asm volatile("s_waitcnt lgkmcnt(0)" ::: "memory");
}

__device__ __forceinline__ void phase_prep(const Args& a, LAS unsigned char* lds) {
    const int tid = tid_opaque(), lane = tid & 63, wave = tid >> 6, G = gridDim.x;
    unsigned char* ws = a.ws;
    {
        LAS float* sc = (LAS float*)lds;
        LAS float* part = (LAS float*)(lds + 12288);
        bool have = false;
        for (int it = bid_opaque(); it < 192; it += G) {
            if (!have) {
                for (int i = tid; i < 3072; i += NTHREADS) { const int v = i >> 10, k = i & 1023; const float cv = v < 2 ? a.in[1][v * D + k] : a.in[3][k]; sc[i] = siluf(cv); }
                have = true; __syncthreads();
            }
            const int l = it / 96, cgp = it % 96, col = tid & 63, ks = tid >> 6;
            const float* W = a.in[4] + (size_t)l * D * NMODV + cgp * 64 + col;
            float a0 = 0.f, a1 = 0.f, a2 = 0.f;
#pragma unroll 32
            for (int k = ks * 128; k < ks * 128 + 128; ++k) { const float w = W[(size_t)k * NMODV]; a0 += sc[k] * w; a1 += sc[1024 + k] * w; a2 += sc[2048 + k] * w; }
            part[(ks * 3 + 0) * 64 + col] = a0; part[(ks * 3 + 1) * 64 + col] = a1; part[(ks * 3 + 2) * 64 + col] = a2;
            __syncthreads();
            if (tid < 192) { const int v = tid >> 6, c2 = tid & 63; float s = a.in[5][l * NMODV + cgp * 64 + c2];
#pragma unroll
                for (int q = 0; q < 8; ++q) s += part[(q * 3 + v) * 64 + c2];
                ((float*)(ws + WS_MOD))[(l * 3 + v) * NMODV + cgp * 64 + c2] = s; }
            __syncthreads();
        }
        __syncthreads();
    }
    {
        LAS float* scr = (LAS float*)(lds + wave * 16384);
        const int gw = bid_opaque() * NWAVES + wave, NGW = G * NWAVES;
        constexpr int I_IN = 16 * 81, I_OUT = 12 * 32, I_1 = 16 * 128, I_2 = 64 * 32, I_L = I_IN + I_OUT + I_1 + I_2;
        for (int it = gw; it < 2 * I_L; it += NGW) {
            const int l = it / I_L; int r = it % I_L;
            if (r < I_IN) { transpose_item(a.in[8] + (size_t)l * D * INC, INC, (bf16_t*)(ws + WS_WIN) + (size_t)l * INP * D, D, scr, r, lane); continue; } r -= I_IN;
            if (r < I_OUT) { transpose_item(a.in[15] + (size_t)l * D * D, D, (bf16_t*)(ws + WS_WOUT) + (size_t)l * D * D, D, scr, r, lane); continue; } r -= I_OUT;
            if (r < I_1) { transpose_item(a.in[16] + (size_t)l * D * FF, FF, (bf16_t*)(ws + WS_W1) + (size_t)l * FF * D, D, scr, r, lane); continue; } r -= I_1;
            transpose_item(a.in[17] + (size_t)l * FF * D, D, (bf16_t*)(ws + WS_W2) + (size_t)l * D * FF, FF, scr, r, lane);
        }
        for (int i = bid_opaque() * NTHREADS + tid; i < 2 * 224 * 128; i += G * NTHREADS) {
            const int l = i / (224 * 128), r = i % (224 * 128);
            *(u32x4*)((bf16_t*)(ws + WS_WIN) + (size_t)l * INP * D + (size_t)INC * D + (size_t)r * 8) = (u32x4){0u, 0u, 0u, 0u};
        }
    }
    {
        for (int i = bid_opaque() * NTHREADS + tid; i < 2 * 32 * 1024; i += G * NTHREADS) {
            const int l = i >> 15, r = i & 32767, n = r & 1023, kc8 = (r >> 10) * 8, g = kc8 >> 6, c0 = kc8 & 63;
            const float* pw = a.in[13] + ((size_t)(l * 4 + g) * 64 + c0) * 64;
            const float* sc = a.in[14] + l * 256 + g * 64;
            const float* wo = a.in[15] + (size_t)l * D * D + (size_t)(768 + g * 64) * D + n;
            float acc[8];
#pragma unroll
            for (int j = 0; j < 8; ++j) acc[j] = 0.f;
            for (int d = 0; d < 64; ++d) { const float w = wo[(size_t)d * D] * sc[d];
#pragma unroll
                for (int j = 0; j < 8; ++j) acc[j] += pw[j * 64 + d] * w; }
            u32x4 o; o.x = pk2(acc[0], acc[1]); o.y = pk2(acc[2], acc[3]); o.z = pk2(acc[4], acc[5]); o.w = pk2(acc[6], acc[7]);
            *(u32x4*)((bf16_t*)(ws + WS_WOUT) + (size_t)l * D * D + (size_t)n * D + 768 + kc8) = o;
        }
    }
}

__device__ __forceinline__ void load_row_f32(f32x4 (&v)[4], const float* p, int lane) {
#pragma unroll
    for (int j = 0; j < 2; ++j) { v[2 * j] = *(const f32x4*)(p + 8 * lane + 512 * j); v[2 * j + 1] = *(const f32x4*)(p + 8 * lane + 512 * j + 4); }
}
__device__ __forceinline__ void load_row_bf16(f32x4 (&v)[4], const bf16_t* p, int lane) {
#pragma unroll
    for (int j = 0; j < 2; ++j) { const u32x4 w = *(const u32x4*)(p + 8 * lane + 512 * j);
        v[2 * j] = (f32x4){bflo(w.x), bfhi(w.x), bflo(w.y), bfhi(w.y)}; v[2 * j + 1] = (f32x4){bflo(w.z), bfhi(w.z), bflo(w.w), bfhi(w.w)}; }
}
__device__ __forceinline__ float row_sumsq(const f32x4 (&v)[4]) {
    float s = 0.f;
#pragma unroll
    for (int j = 0; j < 4; ++j) s += (v[j].x * v[j].x + v[j].y * v[j].y) + (v[j].z * v[j].z + v[j].w * v[j].w);
    return s;
}
__device__ __forceinline__ void phase_norm(const float* xlat32, const bf16_t* X, const float* xctx, int nrows, const float* nw, const float* mod, int sh_off, int sc_off, bf16_t* H,
                                           const float* part, int npart, float* xc_store) {
    const int tid = tid_opaque(), lane = tid & 63, wave = tid >> 6;
    const int gw = bid_opaque() * NWAVES + wave, NGW = gridDim.x * NWAVES;
    int cur_v = -1; f32x4 aw[4], shv[4];
#pragma unroll
    for (int j = 0; j < 4; ++j) { aw[j] = (f32x4){0.f, 0.f, 0.f, 0.f}; shv[j] = aw[j]; }
    for (int r = gw; r < nrows; r += 2 * NGW) {
        const int rowA = nrows - 1 - r, rowB0 = rowA - NGW;
        const bool hasB = rowB0 >= 0; const int rowB = hasB ? rowB0 : rowA;
        f32x4 va[4], vb[4];
        if (rowA >= MLAT) load_row_f32(va, xctx + (size_t)(rowA - MLAT) * D, lane);
        else if (xlat32) load_row_f32(va, xlat32 + (size_t)rowA * D, lane);
        else load_row_bf16(va, X + (size_t)rowA * D, lane);
        if (rowB >= MLAT) load_row_f32(vb, xctx + (size_t)(rowB - MLAT) * D, lane);
        else if (xlat32) load_row_f32(vb, xlat32 + (size_t)rowB * D, lane);
        else load_row_bf16(vb, X + (size_t)rowB * D, lane);
        if (rowA >= MLAT && npart > 0) {
            const float* pr = part + (size_t)(rowA - MLAT) * D;
            for (int k = 0; k < npart; k += 2) {
                f32x4 t0[4], t1[4];
                load_row_f32(t0, pr + (size_t)k * MCTX * D, lane); load_row_f32(t1, pr + (size_t)(k + 1) * MCTX * D, lane);
#pragma unroll
                for (int j = 0; j < 4; ++j) va[j] += t0[j] + t1[j];
            }
            float* xs = xc_store + (size_t)(rowA - MLAT) * D;
#pragma unroll
            for (int j = 0; j < 2; ++j) { *(f32x4*)(xs + 8 * lane + 512 * j) = va[2 * j]; *(f32x4*)(xs + 8 * lane + 512 * j + 4) = va[2 * j + 1]; }
        }
        float sa = row_sumsq(va), sb = row_sumsq(vb);
#pragma unroll
        for (int o = 1; o < 64; o <<= 1) { sa += __shfl_xor(sa, o); sb += __shfl_xor(sb, o); }
        const float ra = rsqrtf(sa * (1.0f / D) + EPS), rb = rsqrtf(sb * (1.0f / D) + EPS);
#pragma unroll 1
        for (int which = 0; which < 2; ++which) {
            if (which == 1 && !hasB) break;
            const int row = which ? rowB : rowA; const float rstd = which ? rb : ra;
            const int v = modvec_of_row(row);
            if (v != cur_v) {
                const float* mv = mod + v * NMODV;
#pragma unroll
                for (int j = 0; j < 4; ++j) { const int c = 8 * lane + 512 * (j >> 1) + 4 * (j & 1); aw[j] = *(const f32x4*)(nw + c) * (*(const f32x4*)(mv + sc_off + c) + 1.0f); shv[j] = *(const f32x4*)(mv + sh_off + c); }
                cur_v = v;
            }
#pragma unroll
            for (int j = 0; j < 2; ++j) {
                const f32x4 y0 = ((which ? vb[2 * j] : va[2 * j]) * rstd) * aw[2 * j] + shv[2 * j], y1 = ((which ? vb[2 * j + 1] : va[2 * j + 1]) * rstd) * aw[2 * j + 1] + shv[2 * j + 1];
                *(u32x4*)(H + (size_t)row * D + 8 * lane + 512 * j) = (u32x4){pk2(y0.x, y0.y), pk2(y0.z, y0.w), pk2(y1.x, y1.y), pk2(y1.z, y1.w)};
            }
        }
    }
}
__device__ __forceinline__ void phase_final(const bf16_t* X, float* out, const float* nw) {
    const int tid = tid_opaque(), lane = tid & 63, wave = tid >> 6;
    const int gw = bid_opaque() * NWAVES + wave, NGW = gridDim.x * NWAVES;
    f32x4 w[4];
    load_row_f32(w, nw, lane);
    for (int row = gw; row < MLAT; row += 2 * NGW) {
        const bool hasB = row + NGW < MLAT; const int rowB = hasB ? row + NGW : row;
        f32x4 va[4], vb[4];
        load_row_bf16(va, X + (size_t)row * D, lane); load_row_bf16(vb, X + (size_t)rowB * D, lane);
        float sa = row_sumsq(va), sb = row_sumsq(vb);
#pragma unroll
        for (int o = 1; o < 64; o <<= 1) { sa += __shfl_xor(sa, o); sb += __shfl_xor(sb, o); }
        const float ra = rsqrtf(sa * (1.0f / D) + EPS), rb = rsqrtf(sb * (1.0f / D) + EPS);
        float* oa = out + (size_t)row * D; float* ob = out + (size_t)rowB * D;
#pragma unroll
        for (int j = 0; j < 2; ++j) { *(f32x4*)(oa + 8 * lane + 512 * j) = (va[2 * j] * ra) * w[2 * j]; *(f32x4*)(oa + 8 * lane + 512 * j + 4) = (va[2 * j + 1] * ra) * w[2 * j + 1]; }
        if (hasB) {
#pragma unroll
            for (int j = 0; j < 2; ++j) { *(f32x4*)(ob + 8 * lane + 512 * j) = (vb[2 * j] * rb) * w[2 * j]; *(f32x4*)(ob + 8 * lane + 512 * j + 4) = (vb[2 * j + 1] * rb) * w[2 * j + 1]; }
        }
    }
}

constexpr int L_ZS = 0, L_GW = 8192, L_GB = 16384, L_SEG = 16896;
constexpr int BPITCH = 68;
constexpr int L_BF = 21504, L_BB = L_BF + 64 * BPITCH * 4;
constexpr int L_QEF = 56320, L_QEB = L_QEF + 9216, L_KIF = L_QEB + 9216, L_KIB = L_KIF + 9216, L_VT = L_KIB + 9216, L_PF = L_VT + 18432, L_PB = L_PF + 9216;
constexpr int PITCH = 72;
static_assert(L_PB + 9216 <= 131072, "GLA LDS map");

struct ChunkInfo { int r0, b, posf, posb, seg_lo, seg_hi; };
__device__ __forceinline__ ChunkInfo chunk_info(int cidx) {
    ChunkInfo ci;
    if (cidx < 256) { ci.b = cidx >> 7; const int c = cidx & 127; ci.r0 = cidx * 64; ci.posf = 4 + c; ci.posb = 4 + (127 - c); ci.seg_lo = ci.r0; ci.seg_hi = ci.r0 + 64; }
    else { const int cc = cidx - 256; ci.b = cc >> 2; const int j = cc & 3; ci.r0 = MLAT + cc * 64; ci.posf = j; ci.posb = 3 - j; ci.seg_lo = MLAT + ci.b * 256; ci.seg_hi = ci.seg_lo + 256; }
    return ci;
}
__device__ __forceinline__ float pick8(const f32x4& a, const f32x4& b, int i) { return i < 4 ? a[i & 3] : b[i & 3]; }
__device__ __forceinline__ float logsigmoidf(float x) { return fminf(x, 0.f) - 0.6931471806f * __builtin_amdgcn_logf(1.0f + __builtin_amdgcn_exp2f(-1.4426950409f * fabsf(x))); }

struct GFirst { u32x4 zf[4]; u32x4 k, q, v0, v1; };
__device__ __forceinline__ void gla_load_a(GFirst& R, const bf16_t* proj, int r0, int tid) {
    const int fr = tid & 15, fq = (tid >> 4) & 3;
#pragma unroll
    for (int tt = 0; tt < 4; ++tt) R.zf[tt] = *(const u32x4*)(proj + PZ + (size_t)(r0 + 16 * tt + fr) * 32 + 8 * fq);
}
struct GateConst { bf16x8 bfrag; float gbias; int h; };
__device__ __forceinline__ void gate_const(GateConst& gc, const float* gate_w, const float* gate_b, int h, int tid) {
    const int fr = tid & 15, fq = (tid >> 4) & 3, w = tid >> 6, d = w >> 2, n = h * 64 + (w & 3) * 16 + fr;
    float v[8];
#pragma unroll
    for (int j = 0; j < 8; ++j) v[j] = 0.f;
    if ((fq >> 1) == d) {
        const unsigned o = (unsigned)((d * 16 + 8 * (fq & 1)) * 256 + n);
#pragma unroll
        for (int j = 0; j < 8; ++j) v[j] = gate_w[o + (unsigned)(j * 256)];
    }
    const u32x4 p = (u32x4){pk2(v[0], v[1]), pk2(v[2], v[3]), pk2(v[4], v[5]), pk2(v[6], v[7])};
    gc.bfrag = __builtin_bit_cast(bf16x8, p);
    gc.gbias = gate_b[d * 256 + n]; gc.h = h;
}
template <bool WITH_Q>
__device__ __forceinline__ void gla_load_b(GFirst& R, const bf16_t* proj, int r0, int h, int tid) {
    const int t = tid & 63, cg = tid >> 6;
    const size_t hr = (size_t)h * MALL + (size_t)(r0 + t);
    R.k = *(const u32x4*)(proj + PK + hr * 64 + cg * 8);
    if (WITH_Q) R.q = *(const u32x4*)(proj + PQ + hr * 64 + cg * 8);
    R.v0 = *(const u32x4*)(proj + PV + hr * 128 + cg * 8);
    R.v1 = *(const u32x4*)(proj + PV + hr * 128 + 64 + cg * 8);
}
template <bool WITH_Q>
__device__ __forceinline__ void gla_load_first(GFirst& R, const bf16_t* proj, int r0, int h, int tid) {
    gla_load_a(R, proj, r0, tid); gla_load_b<WITH_Q>(R, proj, r0, h, tid);
}

__device__ __forceinline__ void gla_gates(const GFirst& R, const GateConst& gc, LAS unsigned char* lds, int tid) {
    const int lane = tid & 63, fr = lane & 15, fq = lane >> 4, w = tid >> 6, d = w >> 2, j = (w & 3) * 16 + fr;
    LAS float* BX = (LAS float*)(lds + (d ? L_BB : L_BF));
    float g[4][4];
#pragma unroll
    for (int tt = 0; tt < 4; ++tt) {
        const f32x4 acc = __builtin_amdgcn_mfma_f32_16x16x32_bf16(__builtin_bit_cast(bf16x8, R.zf[tt]), gc.bfrag, (f32x4){0.f, 0.f, 0.f, 0.f}, 0, 0, 0);
#pragma unroll
        for (int r = 0; r < 4; ++r) g[tt][r] = logsigmoidf(acc[r] + gc.gbias) * (1.0f / 16.0f);
    }
    if (d == 0) {
        float off = 0.f;
#pragma unroll
        for (int tt = 0; tt < 4; ++tt) {
            const float p0 = g[tt][0], p1 = p0 + g[tt][1], p2 = p1 + g[tt][2], p3 = p2 + g[tt][3];
            float s = p3; float v = __shfl(s, (lane - 16) & 63); s += fq >= 1 ? v : 0.f; v = __shfl(s, (lane - 32) & 63); s += fq >= 2 ? v : 0.f;
            const float e = off + (s - p3), tot = __shfl(s, 48 + fr);
            LAS float* bp = BX + (16 * tt + 4 * fq) * BPITCH + j;
            bp[0] = e + p0; bp[BPITCH] = e + p1; bp[2 * BPITCH] = e + p2; bp[3 * BPITCH] = e + p3;
            off += tot;
        }
    } else {
        float off = 0.f;
#pragma unroll
        for (int tt = 3; tt >= 0; --tt) {
            const float s3 = g[tt][3], s2 = s3 + g[tt][2], s1 = s2 + g[tt][1], s0 = s1 + g[tt][0];
            float s = s0; float v = __shfl(s, (lane + 16) & 63); s += fq <= 2 ? v : 0.f; v = __shfl(s, (lane + 32) & 63); s += fq <= 1 ? v : 0.f;
            const float e = off + (s - s0), tot = __shfl(s, fr);
            LAS float* bp = BX + (16 * tt + 4 * fq) * BPITCH + j;
            bp[0] = e + s0; bp[BPITCH] = e + s1; bp[2 * BPITCH] = e + s2; bp[3 * BPITCH] = e + s3;
            off += tot;
        }
    }
    __syncthreads();
}
__device__ __forceinline__ void gla_write_vt(const GFirst& R, LAS unsigned char* lds, int tid) {
    LAS bf16_t* VT = (LAS bf16_t*)(lds + L_VT); const int t = tid & 63, cg = tid >> 6;
    const unsigned a[4] = {R.v0.x, R.v0.y, R.v0.z, R.v0.w}, b[4] = {R.v1.x, R.v1.y, R.v1.z, R.v1.w};
#pragma unroll
    for (int i = 0; i < 4; ++i) {
        VT[(cg * 8 + 2 * i) * PITCH + t] = (bf16_t)(a[i] & 0xffffu); VT[(cg * 8 + 2 * i + 1) * PITCH + t] = (bf16_t)(a[i] >> 16);
        VT[(64 + cg * 8 + 2 * i) * PITCH + t] = (bf16_t)(b[i] & 0xffffu); VT[(64 + cg * 8 + 2 * i + 1) * PITCH + t] = (bf16_t)(b[i] >> 16);
    }
}

__device__ __forceinline__ void phase_gla_u(const Args& a, int l, LAS unsigned char* lds) {
    const int tid = tid_opaque(), lane = tid & 63, wave = tid >> 6;
    const bf16_t* proj = (const bf16_t*)(a.ws + WS_PROJ);
    bf16_t* U = (bf16_t*)a.out; float* DEC = (float*)(a.ws + WS_DEC);
    const float* gate_w = a.in[9] + (size_t)l * 2 * 16 * 256; const float* gate_b = a.in[10] + (size_t)l * 2 * 256;
    LAS float* BF = (LAS float*)(lds + L_BF); LAS float* BB = (LAS float*)(lds + L_BB);
    LAS bf16_t* KTF = (LAS bf16_t*)(lds + L_QEF); LAS bf16_t* KTB = (LAS bf16_t*)(lds + L_QEB); LAS bf16_t* VT = (LAS bf16_t*)(lds + L_VT);
    constexpr int NIT = 264 * 4;
    GFirst R; GateConst gc; gc.h = -1;
    if (bid_opaque() < NIT) { const ChunkInfo c0 = chunk_info(bid_opaque() >> 2); gla_load_first<false>(R, proj, c0.r0, bid_opaque() & 3, tid); }
#pragma unroll 1
    for (int it = bid_opaque(); it < NIT; it += gridDim.x) {
        const int cidx = it >> 2, h = it & 3; const ChunkInfo ci = chunk_info(cidx);
        const int itn = it + gridDim.x; const ChunkInfo cn = chunk_info((itn < NIT ? itn : it) >> 2);
        if (gc.h != h) gate_const(gc, gate_w, gate_b, h, tid);
        GFirst Rn;
#pragma unroll
        for (int tt = 0; tt < 4; ++tt) Rn.zf[tt] = R.zf[tt];
        if (itn < NIT) gla_load_a(Rn, proj, cn.r0, tid);
        gla_gates(R, gc, lds, tid);
        { const int t = tid & 63, cg = tid >> 6;
          const unsigned ww[4] = {R.k.x, R.k.y, R.k.z, R.k.w};
          const f32x4 bfa = *(const LAS f32x4*)(BF + t * BPITCH + cg * 8), bfb = *(const LAS f32x4*)(BF + t * BPITCH + cg * 8 + 4);
          const f32x4 bba = *(const LAS f32x4*)(BB + t * BPITCH + cg * 8), bbb = *(const LAS f32x4*)(BB + t * BPITCH + cg * 8 + 4);
          const f32x4 fla = *(const LAS f32x4*)(BF + 63 * BPITCH + cg * 8), flb = *(const LAS f32x4*)(BF + 63 * BPITCH + cg * 8 + 4);
          const f32x4 b0a = *(const LAS f32x4*)(BB + cg * 8), b0b = *(const LAS f32x4*)(BB + cg * 8 + 4);
#pragma unroll
          for (int i = 0; i < 8; ++i) { const int dk = cg * 8 + i; const float kf = (i & 1) ? bfhi(ww[i >> 1]) : bflo(ww[i >> 1]);
              KTF[dk * PITCH + t] = f2bf(kf * __expf(pick8(fla, flb, i) - pick8(bfa, bfb, i)));
              KTB[dk * PITCH + t] = f2bf(kf * __expf(pick8(b0a, b0b, i) - pick8(bba, bbb, i))); } }
        gla_write_vt(R, lds, tid);
        if (tid < 128) { const int d = tid >> 6, j = tid & 63;
            DEC[((size_t)((ci.b * 4 + h) * 2 + d) * NPOS + (d ? ci.posb : ci.posf)) * 64 + j] = __expf(d ? BB[j] : BF[63 * BPITCH + j]); }
        if (itn < NIT) gla_load_b<false>(R, proj, cn.r0, itn & 3, tid);
        __syncthreads();
        {
            const int dir = wave >> 2, jv = (wave & 3) * 32, fr = lane & 15, fq = lane >> 4;
            const LAS bf16_t* KT = dir ? KTB : KTF;
            bf16x8 af[4][2], bfr[2][2];
#pragma unroll
            for (int i = 0; i < 4; ++i)
#pragma unroll
                for (int ks = 0; ks < 2; ++ks) af[i][ks] = *(const LAS bf16x8*)(KT + (i * 16 + fr) * PITCH + ks * 32 + 8 * fq);
#pragma unroll
            for (int jt = 0; jt < 2; ++jt)
#pragma unroll
                for (int ks = 0; ks < 2; ++ks) bfr[jt][ks] = *(const LAS bf16x8*)(VT + (jv + jt * 16 + fr) * PITCH + ks * 32 + 8 * fq);
            bf16_t* Ub = U + ((size_t)((ci.b * 4 + h) * 2 + dir) * NPOS + (dir ? ci.posb : ci.posf)) * 8192;
#pragma unroll
            for (int i = 0; i < 4; ++i)
#pragma unroll
                for (int jt = 0; jt < 2; ++jt) {
                    f32x4 acc = (f32x4){0.f, 0.f, 0.f, 0.f};
#pragma unroll
                    for (int ks = 0; ks < 2; ++ks) acc = __builtin_amdgcn_mfma_f32_16x16x32_bf16(af[i][ks], bfr[jt][ks], acc, 0, 0, 0);
                    u32x2 o; o.x = pk2(acc[0], acc[1]); o.y = pk2(acc[2], acc[3]);
                    *(u32x2*)(Ub + (size_t)(jv + jt * 16 + fr) * 64 + i * 16 + 4 * fq) = o;
                }
        }
#pragma unroll
        for (int tt = 0; tt < 4; ++tt) R.zf[tt] = Rn.zf[tt];
    }
}

__device__ __forceinline__ void phase_gla_scan(const Args& a, LAS unsigned char* lds) {
    const unsigned* U = (const unsigned*)a.out; unsigned* S = (unsigned*)(a.ws + WS_S); const float* DEC = (const float*)(a.ws + WS_DEC);
    constexpr int SEGL = NPOS / 4;
    const int tid = tid_opaque(), lane = tid & 63, wave = tid >> 6, seg = wave & 3, grp = wave >> 2;
    LAS float* X = (LAS float*)lds;
    for (int bi = bid_opaque(); bi < 16 * 4096 / 128; bi += gridDim.x) {
        const int pidx = bi * 128 + grp * 64 + lane, seq = pidx >> 12, e2 = pidx & 4095, dk = (e2 * 2) & 63, pl = grp * 64 + lane;
        const unsigned* up = U + ((size_t)seq * NPOS + seg * SEGL) * 4096 + e2; unsigned* sp = S + ((size_t)seq * NPOS + seg * SEGL) * 4096 + e2;
        const float* dp = DEC + ((size_t)seq * NPOS + seg * SEGL) * 64 + dk;
        unsigned u[SEGL]; float d0[SEGL], d1[SEGL];
#pragma unroll
        for (int i = 0; i < SEGL; ++i) { u[i] = up[(size_t)i * 4096]; const float2 dd = *(const float2*)(dp + i * 64); d0[i] = dd.x; d1[i] = dd.y; }
        float s0 = 0.f, s1 = 0.f, c0 = 1.f, c1 = 1.f;
#pragma unroll
        for (int i = 0; i < SEGL; ++i) { s0 = d0[i] * s0 + bflo(u[i]); s1 = d1[i] * s1 + bfhi(u[i]); c0 *= d0[i]; c1 *= d1[i]; }
        X[(0 * 4 + seg) * 128 + pl] = s0; X[(1 * 4 + seg) * 128 + pl] = s1; X[(2 * 4 + seg) * 128 + pl] = c0; X[(3 * 4 + seg) * 128 + pl] = c1;
        __syncthreads();
        float k0 = 0.f, k1 = 0.f;
#pragma unroll
        for (int k = 0; k < 3; ++k) {
            if (k < seg) { k0 = X[(2 * 4 + k) * 128 + pl] * k0 + X[(0 * 4 + k) * 128 + pl]; k1 = X[(3 * 4 + k) * 128 + pl] * k1 + X[(1 * 4 + k) * 128 + pl]; }
        }
        s0 = k0; s1 = k1;
#pragma unroll
        for (int i = 0; i < SEGL; ++i) { sp[(size_t)i * 4096] = pk2(s0, s1); s0 = d0[i] * s0 + bflo(u[i]); s1 = d1[i] * s1 + bfhi(u[i]); }
        __syncthreads();
    }
}

template <int HALF>
__device__ __forceinline__ void pool_rows(const bf16_t* proj, bf16_t* Y, int c0, int t0, int seg_lo, int seg_hi) {
    constexpr int NR = 2 * HALF + 3;
    u32x4 uw[NR];
#pragma unroll
    for (int j = 0; j < NR; ++j) { const int rc = min(max(t0 - HALF + j, seg_lo), seg_hi - 1); uw[j] = *(const u32x4*)(proj + PP + (size_t)rc * 256 + c0); }
    float sm[8];
#pragma unroll
    for (int i = 0; i < 8; ++i) sm[i] = 0.f;
#pragma unroll
    for (int j = 0; j < NR; ++j) {
        const int rr = t0 - HALF + j; const bool inseg = rr >= seg_lo && rr < seg_hi;
        const unsigned uu[4] = {uw[j].x, uw[j].y, uw[j].z, uw[j].w};
        float uv[8];
#pragma unroll
        for (int i = 0; i < 4; ++i) { uv[2 * i] = inseg ? bflo(uu[i]) : 0.f; uv[2 * i + 1] = inseg ? bfhi(uu[i]) : 0.f; }
#pragma unroll
        for (int i = 0; i < 8; ++i) sm[i] += uv[i];
        if (j >= 2 * HALF - 1) {
            const int tt = j - (2 * HALF - 1), tk = t0 + tt, lo = max(tk - HALF, seg_lo), hi = min(tk + HALF, seg_hi);
            const float inv = 1.0f / (float)(hi - lo);
            const unsigned su[4] = {uw[HALF + tt].x, uw[HALF + tt].y, uw[HALF + tt].z, uw[HALF + tt].w};
            float pp[8];
#pragma unroll
            for (int i = 0; i < 8; ++i) pp[i] = sm[i] * inv - ((i & 1) ? bfhi(su[i >> 1]) : bflo(su[i >> 1]));
            *(u32x4*)(Y + (size_t)tk * D + 768 + c0) = (u32x4){pk2(pp[0], pp[1]), pk2(pp[2], pp[3]), pk2(pp[4], pp[5]), pk2(pp[6], pp[7])};
            const int jl = tt; const int rl = t0 - HALF + jl; const bool insl = rl >= seg_lo && rl < seg_hi;
            const unsigned ul[4] = {uw[jl].x, uw[jl].y, uw[jl].z, uw[jl].w};
#pragma unroll
            for (int i = 0; i < 4; ++i) { sm[2 * i] -= insl ? bflo(ul[i]) : 0.f; sm[2 * i + 1] -= insl ? bfhi(ul[i]) : 0.f; }
        }
    }
}

__device__ __forceinline__ void phase_gla_out(const Args& a, int l, int nchunks, LAS unsigned char* lds) {
    const int tid = tid_opaque(), lane = tid & 63, wave = tid >> 6, fr = lane & 15, fq = lane >> 4;
    const bf16_t* proj = (const bf16_t*)(a.ws + WS_PROJ);
    const bf16_t* S = (const bf16_t*)(a.ws + WS_S); bf16_t* Y = (bf16_t*)(a.ws + WS_Y);
    const float* gate_w = a.in[9] + (size_t)l * 2 * 16 * 256; const float* gate_b = a.in[10] + (size_t)l * 2 * 256;
    const float* gnw = a.in[11] + l * 128; const float* conv_w = a.in[12] + l * 3 * 256;
    LAS float* BF = (LAS float*)(lds + L_BF); LAS float* BB = (LAS float*)(lds + L_BB); LAS float* SSX = (LAS float*)(lds + L_SEG);
    LAS bf16_t* QEF = (LAS bf16_t*)(lds + L_QEF); LAS bf16_t* QEB = (LAS bf16_t*)(lds + L_QEB);
    LAS bf16_t* KIF = (LAS bf16_t*)(lds + L_KIF); LAS bf16_t* KIB = (LAS bf16_t*)(lds + L_KIB);
    LAS bf16_t* VT = (LAS bf16_t*)(lds + L_VT); LAS bf16_t* PF = (LAS bf16_t*)(lds + L_PF); LAS bf16_t* PB = (LAS bf16_t*)(lds + L_PB);
    const int n_gla = nchunks * 4;
    GFirst R; GateConst gc; gc.h = -1;
    if (bid_opaque() < n_gla) { const ChunkInfo c0 = chunk_info(bid_opaque() >> 2); gla_load_first<true>(R, proj, c0.r0, bid_opaque() & 3, tid); }
#pragma unroll 1
    for (int it = bid_opaque(); it < n_gla + nchunks; it += gridDim.x) {
        if (it < n_gla) {
            const int cidx = it >> 2, h = it & 3; const ChunkInfo ci = chunk_info(cidx);
            const int tt = wave & 3, trow = tt * 16 + fr;
            const int dvr = wave * 16 + fr;
            bf16x8 sfa[2], sba[2]; u32x2 rw[4];
            {
                const bf16_t* Sf = S + ((size_t)((ci.b * 4 + h) * 2 + 0) * NPOS + ci.posf) * 8192;
                const bf16_t* Sb = S + ((size_t)((ci.b * 4 + h) * 2 + 1) * NPOS + ci.posb) * 8192;
#pragma unroll
                for (int ks = 0; ks < 2; ++ks) { sfa[ks] = *(const bf16x8*)(Sf + (size_t)dvr * 64 + ks * 32 + 8 * fq); sba[ks] = *(const bf16x8*)(Sb + (size_t)dvr * 64 + ks * 32 + 8 * fq); }
#pragma unroll
                for (int t4 = 0; t4 < 4; ++t4) rw[t4] = *(const u32x2*)(proj + PR + ((size_t)h * MALL + (size_t)(ci.r0 + t4 * 16 + fr)) * 128 + wave * 16 + 4 * fq);
            }
            const int itn = it + gridDim.x; const ChunkInfo cn = chunk_info((itn < n_gla ? itn : it) >> 2);
            if (gc.h != h) gate_const(gc, gate_w, gate_b, h, tid);
            GFirst Rn;
#pragma unroll
            for (int tt = 0; tt < 4; ++tt) Rn.zf[tt] = R.zf[tt];
            if (itn < n_gla) gla_load_a(Rn, proj, cn.r0, tid);
            gla_gates(R, gc, lds, tid);
            { const int t = tid & 63, cg = tid >> 6;
              const unsigned qq[4] = {R.q.x, R.q.y, R.q.z, R.q.w}, kk[4] = {R.k.x, R.k.y, R.k.z, R.k.w};
              const f32x4 bfa = *(const LAS f32x4*)(BF + t * BPITCH + cg * 8), bfb = *(const LAS f32x4*)(BF + t * BPITCH + cg * 8 + 4);
              const f32x4 bba = *(const LAS f32x4*)(BB + t * BPITCH + cg * 8), bbb = *(const LAS f32x4*)(BB + t * BPITCH + cg * 8 + 4);
              unsigned oqf[4], oqb[4], okf[4], okb[4];
#pragma unroll
              for (int i = 0; i < 4; ++i) {
                  const float ef0 = __expf(pick8(bfa, bfb, 2 * i)), ef1 = __expf(pick8(bfa, bfb, 2 * i + 1)), eb0 = __expf(pick8(bba, bbb, 2 * i)), eb1 = __expf(pick8(bba, bbb, 2 * i + 1));
                  const float q0 = bflo(qq[i]) * 0.125f, q1 = bfhi(qq[i]) * 0.125f, k0 = bflo(kk[i]), k1 = bfhi(kk[i]);
                  oqf[i] = pk2(q0 * ef0, q1 * ef1); oqb[i] = pk2(q0 * eb0, q1 * eb1);
                  okf[i] = pk2(k0 * __builtin_amdgcn_rcpf(ef0), k1 * __builtin_amdgcn_rcpf(ef1)); okb[i] = pk2(k0 * __builtin_amdgcn_rcpf(eb0), k1 * __builtin_amdgcn_rcpf(eb1));
              }
              *(LAS u32x4*)(QEF + t * PITCH + cg * 8) = (u32x4){oqf[0], oqf[1], oqf[2], oqf[3]};
              *(LAS u32x4*)(QEB + t * PITCH + cg * 8) = (u32x4){oqb[0], oqb[1], oqb[2], oqb[3]};
              *(LAS u32x4*)(KIF + t * PITCH + cg * 8) = (u32x4){okf[0], okf[1], okf[2], okf[3]};
              *(LAS u32x4*)(KIB + t * PITCH + cg * 8) = (u32x4){okb[0], okb[1], okb[2], okb[3]}; }
            gla_write_vt(R, lds, tid);
            if (itn < n_gla) gla_load_b<true>(R, proj, cn.r0, itn & 3, tid);
            __syncthreads();
            {
                const int dir = wave >> 2;
                const LAS bf16_t* KI = dir ? KIB : KIF; const LAS bf16_t* QE = dir ? QEB : QEF; LAS bf16_t* P = dir ? PB : PF;
                bf16x8 qb[2];
#pragma unroll
                for (int ks = 0; ks < 2; ++ks) qb[ks] = *(const LAS bf16x8*)(QE + trow * PITCH + ks * 32 + 8 * fq);
#pragma unroll
                for (int st = 0; st < 4; ++st) {
                    f32x4 acc = (f32x4){0.f, 0.f, 0.f, 0.f};
#pragma unroll
                    for (int ks = 0; ks < 2; ++ks) { const bf16x8 ka = *(const LAS bf16x8*)(KI + (st * 16 + fr) * PITCH + ks * 32 + 8 * fq);
                        acc = __builtin_amdgcn_mfma_f32_16x16x32_bf16(ka, qb[ks], acc, 0, 0, 0); }
                    const int s0 = st * 16 + 4 * fq;
#pragma unroll
                    for (int r = 0; r < 4; ++r) { const int s = s0 + r; const bool keep = dir ? (s >= trow) : (s <= trow); acc[r] = keep ? acc[r] : 0.f; }
                    u32x2 o; o.x = pk2(acc[0], acc[1]); o.y = pk2(acc[2], acc[3]);
                    *(LAS u32x2*)(P + trow * PITCH + s0) = o;
                }
            }
            __syncthreads();
            {
                f32x4 acc[4];
#pragma unroll
                for (int t4 = 0; t4 < 4; ++t4) acc[t4] = (f32x4){0.f, 0.f, 0.f, 0.f};
#pragma unroll
                for (int ks = 0; ks < 2; ++ks) {
                    const bf16x8 va = *(const LAS bf16x8*)(VT + dvr * PITCH + ks * 32 + 8 * fq);
#pragma unroll
                    for (int t4 = 0; t4 < 4; ++t4) {
                        const int tr = t4 * 16 + fr;
                        const bf16x8 pf = *(const LAS bf16x8*)(PF + tr * PITCH + ks * 32 + 8 * fq), pb = *(const LAS bf16x8*)(PB + tr * PITCH + ks * 32 + 8 * fq);
                        const bf16x8 qf = *(const LAS bf16x8*)(QEF + tr * PITCH + ks * 32 + 8 * fq), qb = *(const LAS bf16x8*)(QEB + tr * PITCH + ks * 32 + 8 * fq);
                        acc[t4] = __builtin_amdgcn_mfma_f32_16x16x32_bf16(va, pf, acc[t4], 0, 0, 0);
                        acc[t4] = __builtin_amdgcn_mfma_f32_16x16x32_bf16(va, pb, acc[t4], 0, 0, 0);
                        acc[t4] = __builtin_amdgcn_mfma_f32_16x16x32_bf16(sfa[ks], qf, acc[t4], 0, 0, 0);
                        acc[t4] = __builtin_amdgcn_mfma_f32_16x16x32_bf16(sba[ks], qb, acc[t4], 0, 0, 0);
                    }
                }
#pragma unroll
                for (int t4 = 0; t4 < 4; ++t4) {
                    float ss = (acc[t4][0] * acc[t4][0] + acc[t4][1] * acc[t4][1]) + (acc[t4][2] * acc[t4][2] + acc[t4][3] * acc[t4][3]);
                    ss += __shfl_xor(ss, 16); ss += __shfl_xor(ss, 32);
                    if (fq == 0) SSX[wave * 64 + t4 * 16 + fr] = ss;
                }
                __syncthreads();
                const f32x4 nw = *(const f32x4*)(gnw + wave * 16 + 4 * fq);
#pragma unroll
                for (int t4 = 0; t4 < 4; ++t4) {
                    const int tr = t4 * 16 + fr;
                    float tot = 0.f;
#pragma unroll
                    for (int w8 = 0; w8 < 8; ++w8) tot += SSX[w8 * 64 + tr];
                    const float rs = rsqrtf(tot * (1.0f / 128.0f) + EPS);
                    const float y0 = acc[t4][0] * rs * nw.x * siluf(bflo(rw[t4].x)), y1 = acc[t4][1] * rs * nw.y * siluf(bfhi(rw[t4].x));
                    const float y2 = acc[t4][2] * rs * nw.z * siluf(bflo(rw[t4].y)), y3 = acc[t4][3] * rs * nw.w * siluf(bfhi(rw[t4].y));
                    u32x2 o; o.x = pk2(y0, y1); o.y = pk2(y2, y3);
                    *(u32x2*)(Y + (size_t)(ci.r0 + tr) * D + h * 128 + wave * 16 + 4 * fq) = o;
                }
            }
#pragma unroll
            for (int t4 = 0; t4 < 4; ++t4) R.zf[t4] = Rn.zf[t4];
        } else {
            const ChunkInfo ci = chunk_info(it - n_gla);
            const int c0 = (tid & 31) * 8, t0 = ci.r0 + (tid >> 5) * 4;
            {
                float z[6][8];
#pragma unroll
                for (int j = 0; j < 6; ++j) {
                    const int rr = t0 + j - 1; const bool ok = rr >= ci.seg_lo && rr < ci.seg_hi; const int rc = min(max(rr, ci.seg_lo), ci.seg_hi - 1);
                    const u32x4 cw = *(const u32x4*)(proj + PC + (size_t)rc * 768 + 256 + c0), hw = *(const u32x4*)(proj + PC + (size_t)rc * 768 + 512 + c0);
                    const unsigned cc[4] = {cw.x, cw.y, cw.z, cw.w}, hh[4] = {hw.x, hw.y, hw.z, hw.w};
#pragma unroll
                    for (int i = 0; i < 4; ++i) { z[j][2 * i] = ok ? bflo(cc[i]) * bflo(hh[i]) : 0.f; z[j][2 * i + 1] = ok ? bfhi(cc[i]) * bfhi(hh[i]) : 0.f; }
                }
                float w0[8], w1[8], w2[8];
#pragma unroll
                for (int i = 0; i < 8; ++i) { w0[i] = conv_w[c0 + i]; w1[i] = conv_w[256 + c0 + i]; w2[i] = conv_w[512 + c0 + i]; }
#pragma unroll
                for (int tt = 0; tt < 4; ++tt) {
                    const u32x4 bw = *(const u32x4*)(proj + PC + (size_t)(t0 + tt) * 768 + c0);
                    const unsigned bbv[4] = {bw.x, bw.y, bw.z, bw.w};
                    float yc[8];
#pragma unroll
                    for (int i = 0; i < 8; ++i) { const float bgv = (i & 1) ? bfhi(bbv[i >> 1]) : bflo(bbv[i >> 1]); yc[i] = bgv * (w0[i] * z[tt][i] + w1[i] * z[tt + 1][i] + w2[i] * z[tt + 2][i]); }
                    *(u32x4*)(Y + (size_t)(t0 + tt) * D + 512 + c0) = (u32x4){pk2(yc[0], yc[1]), pk2(yc[2], yc[3]), pk2(yc[4], yc[5]), pk2(yc[6], yc[7])};
                }
            }
            {
                const int pg = __builtin_amdgcn_readfirstlane(wave & 3);
                const int pc0 = pg * 64 + (lane & 7) * 8, pt0 = ci.r0 + ((wave >> 2) * 8 + (lane >> 3)) * 4;
                if (pg == 0) pool_rows<1>(proj, Y, pc0, pt0, ci.seg_lo, ci.seg_hi);
                else if (pg == 1) pool_rows<2>(proj, Y, pc0, pt0, ci.seg_lo, ci.seg_hi);
                else if (pg == 2) pool_rows<4>(proj, Y, pc0, pt0, ci.seg_lo, ci.seg_hi);
                else pool_rows<8>(proj, Y, pc0, pt0, ci.seg_lo, ci.seg_hi);
            }
        }
    }
}

#define XB_TMO      128
#define XB_XCNT(j)  (256  + 64 * (j))
#define XB_XSUB(j)  (1280 + 64 * (j))
#define XB_XGEN(j)  (2304 + 64 * (j))
#define XB_TOP      3328
#define XB_TOPGEN   3392
#define XCD_BAR_WORDS 3456
#define XB_SPIN_CAP (1u << 18)

__device__ __forceinline__ unsigned xb_ld(unsigned* p)              { return __hip_atomic_load(p, __ATOMIC_RELAXED, __HIP_MEMORY_SCOPE_AGENT); }
__device__ __forceinline__ unsigned xb_add(unsigned* p, unsigned v) { return __hip_atomic_fetch_add(p, v, __ATOMIC_RELAXED, __HIP_MEMORY_SCOPE_AGENT); }
__device__ __forceinline__ unsigned xb_xcc_id() { return (unsigned)__builtin_amdgcn_s_getreg((3 << 11) | 20) & 0xFu; }
#define XB_SPIN(cond, bar) do { unsigned _sp = 0; while (cond) { __builtin_amdgcn_s_sleep(1); \
    if ((++_sp & 255u) == 0u) { if (xb_ld(&(bar)[XB_TMO])) break; if (_sp > XB_SPIN_CAP) { atomicAdd(&(bar)[XB_TMO], 1u); break; } } } } while (0)

struct XcdBarrier {
    unsigned* bar; unsigned x;
    volatile LAS unsigned* st;
};

__device__ __forceinline__ XcdBarrier xcd_barrier_post(unsigned* bar, volatile LAS unsigned* st) {
    XcdBarrier b; b.bar = bar; b.x = xb_xcc_id(); b.st = st;
    if (threadIdx.x == 0) (void)xb_add(&bar[XB_XCNT(b.x)], 1u);
    return b;
}
__device__ __forceinline__ void xcd_barrier_complete(unsigned* bar, unsigned x, unsigned& nloc, unsigned& nx) {
    const unsigned G = gridDim.x * gridDim.y * gridDim.z;
    unsigned sum, cnt, mine, sp = 0u;
    for (;;) {
        sum = 0u; cnt = 0u; mine = 0u;
#pragma unroll
        for (unsigned j = 0; j < 16; ++j) { const unsigned c = xb_ld(&bar[XB_XCNT(j)]); sum += c; cnt += (c > 0u) ? 1u : 0u; mine = (j == x) ? c : mine; }
        if (sum == G) break;
        __builtin_amdgcn_s_sleep(1);
        if ((++sp & 255u) == 0u) { if (xb_ld(&bar[XB_TMO])) break; if (sp > XB_SPIN_CAP) { atomicAdd(&bar[XB_TMO], 1u); break; } }
    }
    nloc = mine > 0u ? mine : 1u; nx = cnt > 0u ? cnt : 1u;
}

__device__ __forceinline__ void xcd_barrier(const XcdBarrier& b) {
    asm volatile("s_waitcnt vmcnt(0)" ::: "memory");
    __syncthreads();
    if (threadIdx.x == 0) {
        unsigned* bar = b.bar; asm volatile("" : "+s"(bar));
        __builtin_amdgcn_s_waitcnt(0);
        unsigned nloc = b.st[0], nx = b.st[1];
        if (nloc == 0u) { xcd_barrier_complete(bar, b.x, nloc, nx); b.st[0] = nloc; b.st[1] = nx; }
        const unsigned old = xb_add(&bar[XB_XSUB(b.x)], 1u);
        const unsigned gen = old / nloc;
        if (old + 1u == (gen + 1u) * nloc) {
            __builtin_amdgcn_fence(__ATOMIC_RELEASE, "agent");
            asm volatile("s_waitcnt vmcnt(0)" ::: "memory");
            const unsigned og = xb_add(&bar[XB_TOP], 1u);
            const unsigned tg = og / nx;
            if (og + 1u == (tg + 1u) * nx) xb_add(&bar[XB_TOPGEN], 1u);
            else XB_SPIN(xb_ld(&bar[XB_TOPGEN]) == tg, bar);
            __builtin_amdgcn_fence(__ATOMIC_ACQUIRE, "agent");
            xb_add(&bar[XB_XGEN(b.x)], 1u);
            asm volatile("s_waitcnt vmcnt(0)" ::: "memory");
        } else {
            XB_SPIN(xb_ld(&bar[XB_XGEN(b.x)]) == gen, bar);
            __builtin_amdgcn_fence(__ATOMIC_ACQUIRE, "agent");
            asm volatile("s_waitcnt vmcnt(0)" ::: "memory");
        }
    }
    __syncthreads();
}


__global__ void __launch_bounds__(NTHREADS, 2) hybrid_fwd(Args a) {
    extern __shared__ __attribute__((aligned(16))) unsigned char smem[];
    LAS unsigned char* lds = (LAS unsigned char*)smem;
    cg::grid_group grid = cg::this_grid();
    const int G = gridDim.x;
    volatile LAS unsigned* bst = (volatile LAS unsigned*)(lds + 131072 + 64);
    if (tid_opaque() < 2) bst[tid_opaque()] = 0u;
    __syncthreads();
    const XcdBarrier bar = xcd_barrier_post((unsigned*)(a.ws + WS_BAR), bst);
#pragma unroll 1
    for (int ph = a.ph_lo; ph < a.ph_hi; ++ph) {
      {
        unsigned char* ws = a.ws; asm volatile("" : "+s"(ws));
        float* MOD = (float*)(ws + WS_MOD);
        bf16_t* H = (bf16_t*)a.out; bf16_t* X = (bf16_t*)(ws + WS_X); bf16_t* PROJ = (bf16_t*)(ws + WS_PROJ); bf16_t* Yb = (bf16_t*)(ws + WS_Y); bf16_t* ACT = (bf16_t*)(ws + WS_ACT);
        float* XC = (float*)(ws + WS_XC);
        if (ph == 0) { phase_prep(a, lds); }
        else if (ph == NPHASES - 1) { phase_final(X, a.out, a.in[18]); }
        else {
            const int l = (ph - 1) / 9, sp = (ph - 1) % 9;
            const float* xctx = l == 0 ? a.in[2] : XC;
            const float* mod = MOD + l * 3 * NMODV;
            const int mrows = l == 0 ? MALL : MLAT;
            if (sp == 0) phase_norm(l == 0 ? a.in[0] : nullptr, X, xctx, MALL, a.in[6] + l * D, mod, 0, 1024, H, (const float*)(ws + WS_PART), l == 0 ? 0 : FF / 256, XC);
            else if (sp == 1) {
                pg8::Gemm g{H, (const bf16_t*)(ws + WS_WIN) + (size_t)l * INP * D, MALL, INP, D, D}; pg8::StaticOrder S; S.init(MALL, INP, G, bid_opaque()); S.ntk = D / 64;
                EpiProj E{PROJ}; pg8::gemm_phase<EpiProj, pg8::StaticOrder, GEMM_ALIGN, GEMM_SP2>(lds, g, S, E);
            }
            else if (sp == 2) phase_gla_u(a, l, lds);
            else if (sp == 3) phase_gla_scan(a, lds);
            else if (sp == 4) phase_gla_out(a, l, mrows / 64, lds);
            else if (sp == 5 || sp == 8) {
                const bool mix = sp == 5; const int KK = mix ? D : FF;
                const bf16_t* Ap = mix ? Yb : ACT; const bf16_t* Bp = mix ? (const bf16_t*)(ws + WS_WOUT) + (size_t)l * D * D : (const bf16_t*)(ws + WS_W2) + (size_t)l * D * FF;
                const float* gate = mod + (mix ? 2048 : 5120);
                pg8::Gemm g{Ap, Bp, MALL, D, KK, KK};
                pg8::MixedOrder S; S.lat.init(MLAT, D, G, bid_opaque()); S.lat.ntk = KK / 64; S.nks = l == 0 ? KK / 256 : 0; S.kslice = 256;
                EpiRes E{(mix && l == 0) ? a.in[0] : nullptr, X, (float*)(ws + WS_PART), gate};
                pg8::gemm_phase<EpiRes, pg8::MixedOrder, GEMM_ALIGN, GEMM_SP2>(lds, g, S, E);
            }
            else if (sp == 6) phase_norm(nullptr, X, l == 0 ? a.in[2] : (const float*)XC, mrows, a.in[7] + l * D, mod, 3072, 4096, H, (const float*)(ws + WS_PART), l == 0 ? D / 256 : 0, XC);
            else {
                pg8::Gemm g{H, (const bf16_t*)(ws + WS_W1) + (size_t)l * FF * D, mrows, FF, D, D}; pg8::StaticOrder S; S.init(mrows, FF, G, bid_opaque()); S.ntk = D / 64;
                EpiAct E{ACT}; pg8::gemm_phase<EpiAct, pg8::StaticOrder, GEMM_ALIGN, GEMM_SP2>(lds, g, S, E);
            }
        }
      }
        if (ph + 1 < a.ph_hi) {
            if (a.ph_hi > NPHASES) {
                __builtin_amdgcn_fence(__ATOMIC_RELEASE, "agent"); asm volatile("s_waitcnt vmcnt(0)" ::: "memory");
                grid.sync();
                __builtin_amdgcn_fence(__ATOMIC_ACQUIRE, "agent"); asm volatile("s_waitcnt vmcnt(0)" ::: "memory");
            }
            xcd_barrier(bar);
        }
    }
}

extern "C" void kernel_launch(void* const* d_in, const int* in_sizes, int n_in, void* d_out, int out_size, void* d_ws, size_t ws_size, hipStream_t stream) {
    static int grid = 0;
    if (grid == 0) {
        int dev = 0, cus = 0, per_cu = 0;
        hipGetDevice(&dev);
        hipDeviceGetAttribute(&cus, hipDeviceAttributeMultiprocessorCount, dev);
        hipFuncSetAttribute((const void*)hybrid_fwd, hipFuncAttributeMaxDynamicSharedMemorySize, LDS_BYTES);
        hipOccupancyMaxActiveBlocksPerMultiprocessor(&per_cu, (const void*)hybrid_fwd, NTHREADS, LDS_BYTES);
        if (per_cu < 1) { fprintf(stderr, "kernel_launch: occupancy query reports %d blocks per CU\n", per_cu); per_cu = 1; }
        (void)hipGetLastError();
        grid = cus * per_cu;
        if (n_in != 19 || ws_size < WS_END) fprintf(stderr, "kernel_launch: unexpected n_in %d / ws_size %zu\n", n_in, ws_size);
    }
    (void)hipMemsetAsync((char*)d_ws + WS_BAR, 0, BAR_BYTES, stream);
    Args a{};
    for (int i = 0; i < 19; ++i) a.in[i] = (const float*)d_in[i];
    a.out = (float*)d_out; a.ws = (unsigned char*)d_ws;
    a.ph_lo = 0; a.ph_hi = NPHASES;
    void* args[] = {&a};
    hipError_t e = hipLaunchCooperativeKernel((const void*)hybrid_fwd, dim3(grid), dim3(NTHREADS), args, LDS_BYTES, stream);
    if (e != hipSuccess) fprintf(stderr, "cooperative launch failed: %s (grid %d)\n", hipGetErrorString(e), grid);
}
```

```cpp
#include <hip/hip_runtime.h>
#include <hip/hip_cooperative_groups.h>
#include <cstdio>
namespace cg = cooperative_groups;
__device__ __forceinline__ int tid_opaque() { int t = threadIdx.x; asm volatile("" : "+v"(t)); return t; }
__device__ __forceinline__ int bid_opaque() { int t = blockIdx.x; asm volatile("" : "+s"(t)); return t; }
namespace pg8 {
#define PG8_LAS __attribute__((address_space(3)))
typedef unsigned short bf16_t;
typedef short bf16x8 __attribute__((ext_vector_type(8)));
typedef float f32x4 __attribute__((ext_vector_type(4)));
typedef unsigned u32x4 __attribute__((ext_vector_type(4)));
constexpr int BM = 256, BK = 64, HALF = 128, HTB = HALF * BK * 2  , STAGE_BYTES = 8 * HTB, NXCD = 8, WGM = 8;

__host__ __device__ __forceinline__ int lds_byte(int r, int c) { const int st = (r >> 4) * 2 + (c >> 5), rr = r & 15, cc = c & 31, ob = rr * 64 + cc * 2; return st * 1024 + (ob ^ (((ob >> 9) & 1) << 5)); }
__host__ __device__ __forceinline__ void stage_rc(int b, int& R, int& C) { const int st = b / 1024, sb = b % 1024, swz = sb ^ (((sb >> 9) & 1) << 5); R = (st >> 1) * 16 + swz / 64; C = (st & 1) * 32 + (swz % 64) / 2; }
__host__ __device__ __forceinline__ int perm32(int rho) { const int n = rho >> 4, i = rho & 15; return 8 * (i >> 2) + 4 * n + (i & 3); }

struct Unit { int pm, pn, kofs, nt; };
struct Gemm { const bf16_t* A; const bf16_t* Bt; int M, N, K, ld; };

struct StaticOrder {
    int nM, nN, nwg, G, c, ntk;
    __host__ __device__ void init(int M, int N, int G_, int c_) { nM = M / BM; nN = N / BM; nwg = nM * nN; G = G_; c = c_; }
    __host__ __device__ bool next(int i, Unit& u) const {
        const long L = (long)i * G + c; if (L >= nwg) return false;
        int wgid = (int)L; { const int q = nwg / NXCD, r = nwg % NXCD, xcd = wgid % NXCD, off = wgid / NXCD; wgid = (xcd < r ? xcd * (q + 1) : r * (q + 1) + (xcd - r) * q) + off; }
        const int nig = WGM * nN, gid = wgid / nig, fm = gid * WGM, gsz = (nM - fm) < WGM ? (nM - fm) : WGM;
        u.pm = fm + ((wgid % nig) % gsz); u.pn = (wgid % nig) / gsz; u.kofs = 0; u.nt = ntk; return true;
    }
    __device__ __forceinline__ void a_ready(const Unit&) const {}
    __device__ __forceinline__ void done(const Unit&) const {}
};
struct MixedOrder {
    StaticOrder lat; int nks, kslice;
    __device__ __forceinline__ bool next(int i, Unit& u) const {
        const int L = i * lat.G + lat.c;
        if (L < lat.nwg) return lat.next(i, u);
        const int j = L - lat.nwg; if (j >= 8 * nks) return false;
        u.pm = 64 + (j & 1); u.pn = (j >> 1) & 3; u.kofs = (j >> 3) * kslice; u.nt = kslice / BK; return true;
    }
    __device__ __forceinline__ void a_ready(const Unit&) const {}
    __device__ __forceinline__ void done(const Unit&) const {}
};
__device__ __forceinline__ unsigned cvt_pk_bf16(float lo, float hi) { unsigned r; asm volatile("v_cvt_pk_bf16_f32 %0, %1, %2" : "=v"(r) : "v"(lo), "v"(hi)); return r; }
template <class Epi, class Sched, bool ALIGN_EPI = false, bool SP2 = false>
__device__ __forceinline__ void gemm_phase(PG8_LAS unsigned char* lds, const Gemm g, const Sched& S, const Epi& E) {
    const int tid = tid_opaque(), wid = __builtin_amdgcn_readfirstlane(tid >> 6), lane = tid & 63, wr = wid >> 2, wc = wid & 3, fr = lane & 15, fq = lane >> 4;
    const int LD = g.ld;
    unsigned voffA[2], voffB[2];
#pragma unroll
    for (int i = 0; i < 2; ++i) { int R, C; stage_rc(tid * 16 + i * 8192, R, C); const int Rb = Epi::PERM ? ((R & ~31) + perm32(R & 31)) : R;
        voffA[i] = (unsigned)(R * LD + C) * 2u; voffB[i] = (unsigned)(Rb * LD + C) * 2u; }
    const size_t kstep = (size_t)(BK * 2);
    const size_t hstep = (size_t)HALF * LD * 2;
    const size_t tstep = 2 * hstep;
    const unsigned ldsw = (unsigned)wid * 1024u;
    const int aoff = lds_byte(wr * 64 + fr, fq * 8), boff = lds_byte(wc * 32 + fr, fq * 8);
#define PG8_SA(b, h) (((b) * 2 + (h)) * HTB)
#define PG8_SB(b, h) ((4 + (b) * 2 + (h)) * HTB)
#define PG8_STAGE(bufoff, gbase, voff) do { _Pragma("unroll") for (int _i = 0; _i < 2; ++_i) \
        __builtin_amdgcn_global_load_lds((const unsigned*)((const char*)(gbase) + (voff)[_i]), (PG8_LAS unsigned*)(lds + (bufoff) + ldsw + _i * 8192), 16, 0, 0); } while (0)
#define PG8_LDA(dst, b, h) do { _Pragma("unroll") for (int m = 0; m < 4; ++m) _Pragma("unroll") for (int k = 0; k < 2; ++k) dst[m][k] = *(const PG8_LAS bf16x8*)(lds + PG8_SA(b, h) + aoff + m * 2048 + k * 1024); } while (0)
#define PG8_LDB(dst, b, h) do { _Pragma("unroll") for (int n = 0; n < 2; ++n) _Pragma("unroll") for (int k = 0; k < 2; ++k) dst[n][k] = *(const PG8_LAS bf16x8*)(lds + PG8_SB(b, h) + boff + n * 2048 + k * 1024); } while (0)
#define PG8_MMA(ai, bj, At, Bt) do { __builtin_amdgcn_s_setprio(1); _Pragma("unroll") for (int m = 0; m < 4; ++m) _Pragma("unroll") for (int n = 0; n < 2; ++n) _Pragma("unroll") for (int k = 0; k < 2; ++k) \
        acc[ai][bj][m][n] = __builtin_amdgcn_mfma_f32_16x16x32_bf16(Bt[n][k], At[m][k], acc[ai][bj][m][n], 0, 0, 0); __builtin_amdgcn_s_setprio(0); } while (0)
#define PG8_WAIT_V(n) asm volatile("s_waitcnt vmcnt(" #n ")" ::: "memory")
#define PG8_WAIT_L(n) asm volatile("s_waitcnt lgkmcnt(" #n ")" ::: "memory")
#define PG8_BAR __builtin_amdgcn_s_barrier()
#define PG8_SCHED __builtin_amdgcn_sched_barrier(0)
    Unit cur, nxt; int ui = 0;
    if (!S.next(0, cur)) return;
    f32x4 acc[2][2][4][2];
#pragma unroll
    for (int a = 0; a < 2; ++a)
#pragma unroll
        for (int b = 0; b < 2; ++b)
#pragma unroll
            for (int m = 0; m < 4; ++m)
#pragma unroll
                for (int n = 0; n < 2; ++n) acc[a][b][m][n] = (f32x4){0.f, 0.f, 0.f, 0.f};
    bf16x8 At[4][2], B0[2][2], B1[2][2];
    const char* cA = (const char*)g.A + (size_t)cur.pm * tstep + (size_t)cur.kofs * 2; const char* cB = (const char*)g.Bt + (size_t)cur.pn * tstep + (size_t)cur.kofs * 2;
    S.a_ready(cur);
    if constexpr (SP2) {
        PG8_STAGE(PG8_SB(0, 0), cB, voffB); PG8_STAGE(PG8_SB(0, 1), cB + hstep, voffB); PG8_STAGE(PG8_SA(0, 0), cA, voffA); PG8_STAGE(PG8_SA(0, 1), cA + hstep, voffA);
        if (wr == 1) PG8_BAR;
        PG8_WAIT_V(2); PG8_BAR;
        PG8_STAGE(PG8_SB(1, 0), cB + kstep, voffB); PG8_STAGE(PG8_SA(1, 0), cA + kstep, voffA); PG8_STAGE(PG8_SB(1, 1), cB + hstep + kstep, voffB);
        PG8_WAIT_V(6); PG8_BAR;
    } else {
        PG8_STAGE(PG8_SB(0, 0), cB, voffB); PG8_STAGE(PG8_SA(0, 0), cA, voffA); PG8_STAGE(PG8_SB(0, 1), cB + hstep, voffB); PG8_STAGE(PG8_SA(0, 1), cA + hstep, voffA);
        if (wr == 1) PG8_BAR;
        PG8_WAIT_V(4); PG8_BAR;
        PG8_STAGE(PG8_SB(1, 0), cB + kstep, voffB); PG8_STAGE(PG8_SA(1, 0), cA + kstep, voffA); PG8_STAGE(PG8_SB(1, 1), cB + hstep + kstep, voffB);
        PG8_WAIT_V(6); PG8_BAR;
    }
    for (;;) {
        const bool has_next = S.next(ui + 1, nxt);
        const char* nA = has_next ? (const char*)g.A + (size_t)nxt.pm * tstep + (size_t)nxt.kofs * 2 : cA; const char* nB = has_next ? (const char*)g.Bt + (size_t)nxt.pn * tstep + (size_t)nxt.kofs * 2 : cB;
        const int nt = cur.nt;
        for (int t = 0; t < nt; t += 2) {
            const bool last = (t == nt - 2);
            const char* a1 = cA + (size_t)(t + 1) * kstep;
            const char* a2 = last ? nA : cA + (size_t)(t + 2) * kstep; const char* b2 = last ? nB : cB + (size_t)(t + 2) * kstep;
            const char* a3 = a2 + kstep; const char* b3 = b2 + kstep;
            if (last && has_next) S.a_ready(nxt);
            if constexpr (SP2) {
            PG8_LDB(B0, 0, 0); PG8_LDB(B1, 0, 1); PG8_SCHED; PG8_LDA(At, 0, 0); PG8_STAGE(PG8_SA(1, 1), a1 + hstep, voffA);
            PG8_WAIT_V(8); PG8_WAIT_L(0); PG8_BAR; PG8_MMA(0, 0, At, B0); PG8_MMA(0, 1, At, B1); PG8_BAR; PG8_SCHED;
            PG8_LDA(At, 0, 1); PG8_STAGE(PG8_SB(0, 0), b2, voffB); PG8_STAGE(PG8_SB(0, 1), b2 + hstep, voffB); PG8_STAGE(PG8_SA(0, 0), a2, voffA);
            PG8_WAIT_V(8); PG8_WAIT_L(0); PG8_BAR; PG8_MMA(1, 0, At, B0); PG8_MMA(1, 1, At, B1); PG8_BAR; PG8_SCHED;
            PG8_LDB(B0, 1, 0); PG8_LDB(B1, 1, 1); PG8_SCHED; PG8_LDA(At, 1, 0); PG8_STAGE(PG8_SA(0, 1), a2 + hstep, voffA);
            PG8_WAIT_V(8); PG8_WAIT_L(0); PG8_BAR; PG8_MMA(0, 0, At, B0); PG8_MMA(0, 1, At, B1); PG8_BAR; PG8_SCHED;
            PG8_LDA(At, 1, 1); PG8_STAGE(PG8_SB(1, 0), b3, voffB); PG8_STAGE(PG8_SB(1, 1), b3 + hstep, voffB); PG8_STAGE(PG8_SA(1, 0), a3, voffA);
            PG8_WAIT_V(8); PG8_WAIT_L(0); PG8_BAR; PG8_MMA(1, 0, At, B0); PG8_MMA(1, 1, At, B1); PG8_BAR; PG8_SCHED;
            } else {
            PG8_LDB(B0, 0, 0); PG8_SCHED; PG8_LDA(At, 0, 0); PG8_STAGE(PG8_SA(1, 1), a1 + hstep, voffA);
            PG8_WAIT_L(8); PG8_BAR; PG8_WAIT_L(0); PG8_MMA(0, 0, At, B0); PG8_BAR; PG8_SCHED;
            PG8_LDB(B1, 0, 1); PG8_STAGE(PG8_SB(0, 0), b2, voffB);
            PG8_BAR; PG8_WAIT_L(0); PG8_MMA(0, 1, At, B1); PG8_BAR;
            PG8_LDA(At, 0, 1); PG8_STAGE(PG8_SA(0, 0), a2, voffA);
            PG8_BAR; PG8_WAIT_L(0); PG8_MMA(1, 0, At, B0); PG8_BAR; PG8_SCHED;
            PG8_STAGE(PG8_SB(0, 1), b2 + hstep, voffB);
            PG8_WAIT_V(6); PG8_BAR; PG8_MMA(1, 1, At, B1); PG8_BAR;
            PG8_LDB(B0, 1, 0); PG8_SCHED; PG8_LDA(At, 1, 0); PG8_STAGE(PG8_SA(0, 1), a2 + hstep, voffA);
            PG8_WAIT_L(8); PG8_BAR; PG8_WAIT_L(0); PG8_MMA(0, 0, At, B0); PG8_BAR; PG8_SCHED;
            PG8_LDB(B1, 1, 1); PG8_STAGE(PG8_SB(1, 0), b3, voffB);
            PG8_BAR; PG8_WAIT_L(0); PG8_MMA(0, 1, At, B1); PG8_BAR;
            PG8_LDA(At, 1, 1); PG8_STAGE(PG8_SA(1, 0), a3, voffA);
            PG8_BAR; PG8_WAIT_L(0); PG8_MMA(1, 0, At, B0); PG8_BAR; PG8_SCHED;
            PG8_STAGE(PG8_SB(1, 1), b3 + hstep, voffB);
            PG8_WAIT_V(6); PG8_BAR; PG8_MMA(1, 1, At, B1); PG8_BAR;
            }
        }
        if constexpr (ALIGN_EPI) { if (wr == 0) PG8_BAR; }
        if constexpr (!Epi::AFTER_DRAIN) { E(acc, cur, wr, wc, fr, fq); S.done(cur); }
        if (!has_next) break;
#pragma unroll
        for (int a = 0; a < 2; ++a)
#pragma unroll
            for (int b = 0; b < 2; ++b)
#pragma unroll
                for (int m = 0; m < 4; ++m)
#pragma unroll
                    for (int n = 0; n < 2; ++n) acc[a][b][m][n] = (f32x4){0.f, 0.f, 0.f, 0.f};
        cur = nxt; cA = nA; cB = nB; ++ui;
        if constexpr (ALIGN_EPI) { if (wr == 1) PG8_BAR; }
    }
    PG8_WAIT_V(0);
    if constexpr (!ALIGN_EPI) { if (wr == 0) PG8_BAR; }
    PG8_BAR;
    if constexpr (Epi::AFTER_DRAIN) { E.fused(acc, cur, wr, wc, fr, fq, lds, wid, lane); S.done(cur); }
#undef PG8_SA
#undef PG8_SB
#undef PG8_STAGE
#undef PG8_LDA
#undef PG8_LDB
#undef PG8_MMA
#undef PG8_WAIT_V
#undef PG8_WAIT_L
#undef PG8_BAR
#undef PG8_SCHED
}
}

#define LAS __attribute__((address_space(3)))
typedef unsigned short bf16_t;
typedef short bf16x8 __attribute__((ext_vector_type(8)));
typedef float f32x4 __attribute__((ext_vector_type(4)));
typedef unsigned u32x4 __attribute__((ext_vector_type(4)));
typedef unsigned u32x2 __attribute__((ext_vector_type(2)));

#ifndef GEMM_SP2
#define GEMM_SP2 true
#endif
#ifndef GEMM_ALIGN
#define GEMM_ALIGN true
#endif

constexpr int D = 1024, MLAT = 16384, MCTX = 512, MALL = 16896, HALFLAT = 8192;
constexpr int INC = 2592, INP = 2816, FF = 4096;
constexpr int K_OFF = 256, V_OFF = 512, G_OFF = 1024, R_OFF = 1056, CB_OFF = 1568, CC_OFF = 1824, CH_OFF = 2080, P_OFF = 2336;
constexpr int NPOS = 132, NMODV = 6144;
constexpr size_t PQ = 0, PK = PQ + (size_t)4 * MALL * 64, PV = PK + (size_t)4 * MALL * 64, PZ = PV + (size_t)4 * MALL * 128, PR = PZ + (size_t)MALL * 32,
                 PC = PR + (size_t)4 * MALL * 128, PP = PC + (size_t)MALL * 768;
static_assert(PP + (size_t)MALL * 256 == (size_t)MALL * INC, "PROJ segments");
constexpr float EPS = 1e-6f;
constexpr int NTHREADS = 512, NWAVES = 8;
constexpr int LDS_BYTES = 147456;
constexpr int NPHASES = 20;

constexpr size_t MiB = 1u << 20;
constexpr size_t WS_MOD = 0;
constexpr size_t WS_WIN = 1 * MiB;
constexpr size_t WS_WOUT = 12 * MiB;
constexpr size_t WS_W1 = 16 * MiB;
constexpr size_t WS_W2 = 32 * MiB;
constexpr size_t WS_XC = 48 * MiB;
constexpr size_t WS_X = 50 * MiB;
constexpr size_t WS_PROJ = 83 * MiB;
constexpr size_t WS_Y = 167 * MiB;
constexpr size_t WS_ACT = 83 * MiB;
constexpr size_t WS_S = 215 * MiB;
constexpr size_t WS_PART = 215 * MiB;
constexpr size_t WS_DEC = 248 * MiB;
constexpr size_t WS_BAR = 250 * MiB;
constexpr size_t BAR_BYTES = 16384;
constexpr size_t WS_END = 251 * MiB;

struct Args {
    const float* in[19];
    float* out;
    unsigned char* ws;
    int ph_lo, ph_hi;
};

__device__ __forceinline__ float bf2f(unsigned h) { return __uint_as_float(h << 16); }
__device__ __forceinline__ float bflo(unsigned w) { return __uint_as_float(w << 16); }
__device__ __forceinline__ float bfhi(unsigned w) { return __uint_as_float(w & 0xffff0000u); }
typedef __bf16 bf16v2_t __attribute__((ext_vector_type(2)));
typedef float f32v2_t __attribute__((ext_vector_type(2)));
__device__ __forceinline__ unsigned pk2(float lo, float hi) { const f32v2_t v = {lo, hi}; const bf16v2_t b = __builtin_convertvector(v, bf16v2_t); return __builtin_bit_cast(unsigned, b); }
__device__ __forceinline__ bf16_t f2bf(float f) { return (bf16_t)(pk2(f, 0.f) & 0xffffu); }
__device__ __forceinline__ float wave_sum(float v) {
#pragma unroll
    for (int o = 1; o < 64; o <<= 1) v += __shfl_xor(v, o);
    return v;
}
__device__ __forceinline__ float siluf(float x) { return x * __builtin_amdgcn_rcpf(1.0f + __builtin_amdgcn_exp2f(-1.4426950409f * x)); }
__device__ __forceinline__ int modvec_of_row(int row) { return row < HALFLAT ? 0 : (row < MLAT ? 1 : 2); }

struct EpiProj {
    static constexpr bool PERM = true, AFTER_DRAIN = false;
    bf16_t* O;
    __device__ __forceinline__ void operator()(const f32x4 (&acc)[2][2][4][2], const pg8::Unit& u, int wr, int wc, int fr, int fq) const {
        const int row0 = u.pm * 256 + wr * 64 + fr, colt = u.pn * 256;
#pragma unroll
        for (int bj = 0; bj < 2; ++bj) {
            const int cb = colt + bj * 128 + wc * 32;
            if (cb >= INC) continue;
            size_t off0; int pitch;
            if (cb < K_OFF)       { off0 = PQ + (size_t)(cb >> 6) * MALL * 64 + (cb & 63); pitch = 64; }
            else if (cb < V_OFF)  { const int c = cb - K_OFF;  off0 = PK + (size_t)(c >> 6) * MALL * 64 + (c & 63); pitch = 64; }
            else if (cb < G_OFF)  { const int c = cb - V_OFF;  off0 = PV + (size_t)(c >> 7) * MALL * 128 + (c & 127); pitch = 128; }
            else if (cb < R_OFF)  { off0 = PZ; pitch = 32; }
            else if (cb < CB_OFF) { const int c = cb - R_OFF;  off0 = PR + (size_t)(c >> 7) * MALL * 128 + (c & 127); pitch = 128; }
            else if (cb < P_OFF)  { off0 = PC + (cb - CB_OFF); pitch = 768; }
            else                  { off0 = PP + (cb - P_OFF); pitch = 256; }
            bf16_t* base = O + off0 + 8 * fq;
#pragma unroll
            for (int ai = 0; ai < 2; ++ai)
#pragma unroll
                for (int m = 0; m < 4; ++m) {
                    const f32x4 v0 = acc[ai][bj][m][0], v1 = acc[ai][bj][m][1];
                    u32x4 w; w.x = pk2(v0[0], v0[1]); w.y = pk2(v0[2], v0[3]); w.z = pk2(v1[0], v1[1]); w.w = pk2(v1[2], v1[3]);
                    *(u32x4*)(base + (size_t)(row0 + ai * 128 + m * 16) * pitch) = w;
                }
        }
    }
};
struct EpiAct {
    static constexpr bool PERM = true, AFTER_DRAIN = false;
    bf16_t* O;
    __device__ __forceinline__ void operator()(const f32x4 (&acc)[2][2][4][2], const pg8::Unit& u, int wr, int wc, int fr, int fq) const {
        const int row0 = u.pm * 256 + wr * 64 + fr, colt = u.pn * 256;
#pragma unroll
        for (int ai = 0; ai < 2; ++ai)
#pragma unroll
            for (int m = 0; m < 4; ++m) {
                bf16_t* rowp = O + (size_t)(row0 + ai * 128 + m * 16) * FF + colt + wc * 32 + 8 * fq;
#pragma unroll
                for (int bj = 0; bj < 2; ++bj) {
                    f32x4 v0 = acc[ai][bj][m][0], v1 = acc[ai][bj][m][1];
#pragma unroll
                    for (int j = 0; j < 4; ++j) { const float a = fmaxf(v0[j], 0.f), b = fmaxf(v1[j], 0.f); v0[j] = a * a; v1[j] = b * b; }
                    u32x4 w; w.x = pk2(v0[0], v0[1]); w.y = pk2(v0[2], v0[3]); w.z = pk2(v1[0], v1[1]); w.w = pk2(v1[2], v1[3]);
                    *(u32x4*)(rowp + bj * 128) = w;
                }
            }
    }
};
struct EpiRes {
    static constexpr bool PERM = true, AFTER_DRAIN = false;
    const float* xin_f32; bf16_t* X; float* part; const float* gate;
    __device__ __forceinline__ void operator()(const f32x4 (&acc)[2][2][4][2], const pg8::Unit& u, int wr, int wc, int fr, int fq) const {
        asm volatile("" ::: "memory");
        const int rbase = __builtin_amdgcn_readfirstlane(u.pm * 256), cbase = __builtin_amdgcn_readfirstlane(u.pn * 256);
        const unsigned c32 = (unsigned)(wc * 32 + 8 * fq), o32 = (unsigned)((wr * 64 + fr) * D) + c32;
        if (rbase < MLAT) {
            const float* gp = gate + (rbase < HALFLAT ? 0 : NMODV) + cbase;
            f32x4 gv[2][2];
#pragma unroll
            for (int bj = 0; bj < 2; ++bj)
#pragma unroll
                for (int n = 0; n < 2; ++n) gv[bj][n] = *(const f32x4*)(gp + c32 + bj * 128 + 4 * n);
            bf16_t* xo = X + (size_t)rbase * D + cbase;
            if (xin_f32) {
                const float* xi = xin_f32 + (size_t)rbase * D + cbase;
#pragma unroll
                for (int ai = 0; ai < 2; ++ai) {
                    f32x4 xv[4][2][2];
#pragma unroll
                    for (int m = 0; m < 4; ++m)
#pragma unroll
                        for (int bj = 0; bj < 2; ++bj)
#pragma unroll
                            for (int n = 0; n < 2; ++n) xv[m][bj][n] = *(const f32x4*)(xi + (size_t)(ai * 128 + m * 16) * D + o32 + bj * 128 + 4 * n);
#pragma unroll
                    for (int m = 0; m < 4; ++m)
#pragma unroll
                        for (int bj = 0; bj < 2; ++bj) {
                            const f32x4 y0 = xv[m][bj][0] + gv[bj][0] * acc[ai][bj][m][0], y1 = xv[m][bj][1] + gv[bj][1] * acc[ai][bj][m][1];
                            *(u32x4*)(xo + (size_t)(ai * 128 + m * 16) * D + o32 + bj * 128) = (u32x4){pk2(y0[0], y0[1]), pk2(y0[2], y0[3]), pk2(y1[0], y1[1]), pk2(y1[2], y1[3])};
                        }
                    asm volatile("" ::: "memory");
                }
            } else {
#pragma unroll
                for (int ai = 0; ai < 2; ++ai) {
                    u32x4 xb[4][2];
#pragma unroll
                    for (int m = 0; m < 4; ++m)
#pragma unroll
                        for (int bj = 0; bj < 2; ++bj) xb[m][bj] = *(const u32x4*)(xo + (size_t)(ai * 128 + m * 16) * D + o32 + bj * 128);
#pragma unroll
                    for (int m = 0; m < 4; ++m)
#pragma unroll
                        for (int bj = 0; bj < 2; ++bj) {
                            const u32x4 w = xb[m][bj];
                            const f32x4 x0 = (f32x4){bflo(w.x), bfhi(w.x), bflo(w.y), bfhi(w.y)}, x1 = (f32x4){bflo(w.z), bfhi(w.z), bflo(w.w), bfhi(w.w)};
                            const f32x4 y0 = x0 + gv[bj][0] * acc[ai][bj][m][0], y1 = x1 + gv[bj][1] * acc[ai][bj][m][1];
                            *(u32x4*)(xo + (size_t)(ai * 128 + m * 16) * D + o32 + bj * 128) = (u32x4){pk2(y0[0], y0[1]), pk2(y0[2], y0[3]), pk2(y1[0], y1[1]), pk2(y1[2], y1[3])};
                        }
                    asm volatile("" ::: "memory");
                }
            }
        } else {
            float* xo = part + ((size_t)(u.kofs >> 8) * MCTX + (size_t)(rbase - MLAT)) * D + cbase; const float* gp = gate + 2 * NMODV + cbase;
#pragma unroll
            for (int ai = 0; ai < 2; ++ai)
#pragma unroll
                for (int m = 0; m < 4; ++m) {
                    float* xw = xo + (size_t)(ai * 128 + m * 16) * D;
#pragma unroll
                    for (int bj = 0; bj < 2; ++bj)
#pragma unroll
                        for (int n = 0; n < 2; ++n) {
                            const f32x4 gv = *(const f32x4*)(gp + c32 + bj * 128 + 4 * n);
                            *(f32x4*)(xw + o32 + bj * 128 + 4 * n) = gv * acc[ai][bj][m][n];
                        }
                    asm volatile("" ::: "memory");
                }
        }
    }
};

__device__ __forceinline__ void transpose_item(const float* W, int N, bf16_t* WT, int ldt, LAS float* scr, int item, int lane) {
    const int nblk = N / 32, kb = item / nblk, nb = item % nblk, k0 = 64 * kb, n0 = 32 * nb;
#pragma unroll 8
    for (int i = 0; i < 32; ++i) { const int kk = 2 * i + (lane >> 5); scr[kk * 33 + (lane & 31)] = W[(size_t)(k0 + kk) * N + n0 + (lane & 31)]; }
    asm volatile("s_waitcnt lgkmcnt(0)" ::: "memory");
    const int c = lane & 7;
#pragma unroll
    for (int j = 0; j < 4; ++j) { const int n = (lane >> 3) + 8 * j; const LAS float* s = scr + (8 * c) * 33 + n;
        u32x4 o; o.x = pk2(s[0 * 33], s[1 * 33]); o.y = pk2(s[2 * 33], s[3 * 33]); o.z = pk2(s[4 * 33], s[5 * 33]); o.w = pk2(s[6 * 33], s[7 * 33]);
        *(u32x4*)(WT + (size_t)(n0 + n) * ldt + k0 + 8 * c) = o; }
    asm volatile("s_waitcnt lgkmcnt(0)" ::: "memory");
}

__device__ __forceinline__ void phase_prep(const Args& a, LAS unsigned char* lds) {
    const int tid = tid_opaque(), lane = tid & 63, wave = tid >> 6, G = gridDim.x;
    unsigned char* ws = a.ws;
    {
        LAS float* sc = (LAS float*)lds;
        LAS float* part = (LAS float*)(lds + 12288);
        bool have = false;
        for (int it = bid_opaque(); it < 192; it += G) {
            if (!have) {
                for (int i = tid; i < 3072; i += NTHREADS) { const int v = i >> 10, k = i & 1023; const float cv = v < 2 ? a.in[1][v * D + k] : a.in[3][k]; sc[i] = siluf(cv); }
                have = true; __syncthreads();
            }
            const int l = it / 96, cgp = it % 96, col = tid & 63, ks = tid >> 6;
            const float* W = a.in[4] + (size_t)l * D * NMODV + cgp * 64 + col;
            float a0 = 0.f, a1 = 0.f, a2 = 0.f;
#pragma unroll 32
            for (int k = ks * 128; k < ks * 128 + 128; ++k) { const float w = W[(size_t)k * NMODV]; a0 += sc[k] * w; a1 += sc[1024 + k] * w; a2 += sc[2048 + k] * w; }
            part[(ks * 3 + 0) * 64 + col] = a0; part[(ks * 3 + 1) * 64 + col] = a1; part[(ks * 3 + 2) * 64 + col] = a2;
            __syncthreads();
            if (tid < 192) { const int v = tid >> 6, c2 = tid & 63; float s = a.in[5][l * NMODV + cgp * 64 + c2];
#pragma unroll
                for (int q = 0; q < 8; ++q) s += part[(q * 3 + v) * 64 + c2];
                ((float*)(ws + WS_MOD))[(l * 3 + v) * NMODV + cgp * 64 + c2] = s; }
            __syncthreads();
        }
        __syncthreads();
    }
    {
        LAS float* scr = (LAS float*)(lds + wave * 16384);
        const int gw = bid_opaque() * NWAVES + wave, NGW = G * NWAVES;
        constexpr int I_IN = 16 * 81, I_OUT = 12 * 32, I_1 = 16 * 128, I_2 = 64 * 32, I_L = I_IN + I_OUT + I_1 + I_2;
        for (int it = gw; it < 2 * I_L; it += NGW) {
            const int l = it / I_L; int r = it % I_L;
            if (r < I_IN) { transpose_item(a.in[8] + (size_t)l * D * INC, INC, (bf16_t*)(ws + WS_WIN) + (size_t)l * INP * D, D, scr, r, lane); continue; } r -= I_IN;
            if (r < I_OUT) { transpose_item(a.in[15] + (size_t)l * D * D, D, (bf16_t*)(ws + WS_WOUT) + (size_t)l * D * D, D, scr, r, lane); continue; } r -= I_OUT;
            if (r < I_1) { transpose_item(a.in[16] + (size_t)l * D * FF, FF, (bf16_t*)(ws + WS_W1) + (size_t)l * FF * D, D, scr, r, lane); continue; } r -= I_1;
            transpose_item(a.in[17] + (size_t)l * FF * D, D, (bf16_t*)(ws + WS_W2) + (size_t)l * D * FF, FF, scr, r, lane);
        }
        for (int i = bid_opaque() * NTHREADS + tid; i < 2 * 224 * 128; i += G * NTHREADS) {
            const int l = i / (224 * 128), r = i % (224 * 128);
            *(u32x4*)((bf16_t*)(ws + WS_WIN) + (size_t)l * INP * D + (size_t)INC * D + (size_t)r * 8) = (u32x4){0u, 0u, 0u, 0u};
        }
    }
    {
        for (int i = bid_opaque() * NTHREADS + tid; i < 2 * 32 * 1024; i += G * NTHREADS) {
            const int l = i >> 15, r = i & 32767, n = r & 1023, kc8 = (r >> 10) * 8, g = kc8 >> 6, c0 = kc8 & 63;
            const float* pw = a.in[13] + ((size_t)(l * 4 + g) * 64 + c0) * 64;
            const float* sc = a.in[14] + l * 256 + g * 64;
            const float* wo = a.in[15] + (size_t)l * D * D + (size_t)(768 + g * 64) * D + n;
            float acc[8];
#pragma unroll
            for (int j = 0; j < 8; ++j) acc[j] = 0.f;
            for (int d = 0; d < 64; ++d) { const float w = wo[(size_t)d * D] * sc[d];
#pragma unroll
                for (int j = 0; j < 8; ++j) acc[j] += pw[j * 64 + d] * w; }
            u32x4 o; o.x = pk2(acc[0], acc[1]); o.y = pk2(acc[2], acc[3]); o.z = pk2(acc[4], acc[5]); o.w = pk2(acc[6], acc[7]);
            *(u32x4*)((bf16_t*)(ws + WS_WOUT) + (size_t)l * D * D + (size_t)n * D + 768 + kc8) = o;
        }
    }
}

__device__ __forceinline__ void load_row_f32(f32x4 (&v)[4], const float* p, int lane) {
#pragma unroll
    for (int j = 0; j < 2; ++j) { v[2 * j] = *(const f32x4*)(p + 8 * lane + 512 * j); v[2 * j + 1] = *(const f32x4*)(p + 8 * lane + 512 * j + 4); }
}
__device__ __forceinline__ void load_row_bf16(f32x4 (&v)[4], const bf16_t* p, int lane) {
#pragma unroll
    for (int j = 0; j < 2; ++j) { const u32x4 w = *(const u32x4*)(p + 8 * lane + 512 * j);
        v[2 * j] = (f32x4){bflo(w.x), bfhi(w.x), bflo(w.y), bfhi(w.y)}; v[2 * j + 1] = (f32x4){bflo(w.z), bfhi(w.z), bflo(w.w), bfhi(w.w)}; }
}
__device__ __forceinline__ float row_sumsq(const f32x4 (&v)[4]) {
    float s = 0.f;
#pragma unroll
    for (int j = 0; j < 4; ++j) s += (v[j].x * v[j].x + v[j].y * v[j].y) + (v[j].z * v[j].z + v[j].w * v[j].w);
    return s;
}
__device__ __forceinline__ void phase_norm(const float* xlat32, const bf16_t* X, const float* xctx, int nrows, const float* nw, const float* mod, int sh_off, int sc_off, bf16_t* H,
                                           const float* part, int npart, float* xc_store) {
    const int tid = tid_opaque(), lane = tid & 63, wave = tid >> 6;
    const int gw = bid_opaque() * NWAVES + wave, NGW = gridDim.x * NWAVES;
    int cur_v = -1; f32x4 aw[4], shv[4];
#pragma unroll
    for (int j = 0; j < 4; ++j) { aw[j] = (f32x4){0.f, 0.f, 0.f, 0.f}; shv[j] = aw[j]; }
    for (int r = gw; r < nrows; r += 2 * NGW) {
        const int rowA = nrows - 1 - r, rowB0 = rowA - NGW;
        const bool hasB = rowB0 >= 0; const int rowB = hasB ? rowB0 : rowA;
        f32x4 va[4], vb[4];
        if (rowA >= MLAT) load_row_f32(va, xctx + (size_t)(rowA - MLAT) * D, lane);
        else if (xlat32) load_row_f32(va, xlat32 + (size_t)rowA * D, lane);
        else load_row_bf16(va, X + (size_t)rowA * D, lane);
        if (rowB >= MLAT) load_row_f32(vb, xctx + (size_t)(rowB - MLAT) * D, lane);
        else if (xlat32) load_row_f32(vb, xlat32 + (size_t)rowB * D, lane);
        else load_row_bf16(vb, X + (size_t)rowB * D, lane);
        if (rowA >= MLAT && npart > 0) {
            const float* pr = part + (size_t)(rowA - MLAT) * D;
            for (int k = 0; k < npart; k += 2) {
                f32x4 t0[4], t1[4];
                load_row_f32(t0, pr + (size_t)k * MCTX * D, lane); load_row_f32(t1, pr + (size_t)(k + 1) * MCTX * D, lane);
#pragma unroll
                for (int j = 0; j < 4; ++j) va[j] += t0[j] + t1[j];
            }
            float* xs = xc_store + (size_t)(rowA - MLAT) * D;
#pragma unroll
            for (int j = 0; j < 2; ++j) { *(f32x4*)(xs + 8 * lane + 512 * j) = va[2 * j]; *(f32x4*)(xs + 8 * lane + 512 * j + 4) = va[2 * j + 1]; }
        }
        float sa = row_sumsq(va), sb = row_sumsq(vb);
#pragma unroll
        for (int o = 1; o < 64; o <<= 1) { sa += __shfl_xor(sa, o); sb += __shfl_xor(sb, o); }
        const float ra = rsqrtf(sa * (1.0f / D) + EPS), rb = rsqrtf(sb * (1.0f / D) + EPS);
#pragma unroll 1
        for (int which = 0; which < 2; ++which) {
            if (which == 1 && !hasB) break;
            const int row = which ? rowB : rowA; const float rstd = which ? rb : ra;
            const int v = modvec_of_row(row);
            if (v != cur_v) {
                const float* mv = mod + v * NMODV;
#pragma unroll
                for (int j = 0; j < 4; ++j) { const int c = 8 * lane + 512 * (j >> 1) + 4 * (j & 1); aw[j] = *(const f32x4*)(nw + c) * (*(const f32x4*)(mv + sc_off + c) + 1.0f); shv[j] = *(const f32x4*)(mv + sh_off + c); }
                cur_v = v;
            }
#pragma unroll
            for (int j = 0; j < 2; ++j) {
                const f32x4 y0 = ((which ? vb[2 * j] : va[2 * j]) * rstd) * aw[2 * j] + shv[2 * j], y1 = ((which ? vb[2 * j + 1] : va[2 * j + 1]) * rstd) * aw[2 * j + 1] + shv[2 * j + 1];
                *(u32x4*)(H + (size_t)row * D + 8 * lane + 512 * j) = (u32x4){pk2(y0.x, y0.y), pk2(y0.z, y0.w), pk2(y1.x, y1.y), pk2(y1.z, y1.w)};
            }
        }
    }
}
__device__ __forceinline__ void phase_final(const bf16_t* X, float* out, const float* nw) {
    const int tid = tid_opaque(), lane = tid & 63, wave = tid >> 6;
    const int gw = bid_opaque() * NWAVES + wave, NGW = gridDim.x * NWAVES;
    f32x4 w[4];
    load_row_f32(w, nw, lane);
    for (int row = gw; row < MLAT; row += 2 * NGW) {
        const bool hasB = row + NGW < MLAT; const int rowB = hasB ? row + NGW : row;
        f32x4 va[4], vb[4];
        load_row_bf16(va, X + (size_t)row * D, lane); load_row_bf16(vb, X + (size_t)rowB * D, lane);
        float sa = row_sumsq(va), sb = row_sumsq(vb);
#pragma unroll
        for (int o = 1; o < 64; o <<= 1) { sa += __shfl_xor(sa, o); sb += __shfl_xor(sb, o); }
        const float ra = rsqrtf(sa * (1.0f / D) + EPS), rb = rsqrtf(sb * (1.0f / D) + EPS);
        float* oa = out + (size_t)row * D; float* ob = out + (size_t)rowB * D;
#pragma unroll
        for (int j = 0; j < 2; ++j) { *(f32x4*)(oa + 8 * lane + 512 * j) = (va[2 * j] * ra) * w[2 * j]; *(f32x4*)(oa + 8 * lane + 512 * j + 4) = (va[2 * j + 1] * ra) * w[2 * j + 1]; }
        if (hasB) {
#pragma unroll
            for (int j = 0; j < 2; ++j) { *(f32x4*)(ob + 8 * lane + 512 * j) = (vb[2 * j] * rb) * w[2 * j]; *(f32x4*)(ob + 8 * lane + 512 * j + 4) = (vb[2 * j + 1] * rb) * w[2 * j + 1]; }
        }
    }
}

constexpr int L_ZS = 0, L_GW = 8192, L_GB = 16384, L_SEG = 16896;
constexpr int BPITCH = 68;
constexpr int L_BF = 21504, L_BB = L_BF + 64 * BPITCH * 4;
constexpr int L_QEF = 56320, L_QEB = L_QEF + 9216, L_KIF = L_QEB + 9216, L_KIB = L_KIF + 9216, L_VT = L_KIB + 9216, L_PF = L_VT + 18432, L_PB = L_PF + 9216;
constexpr int PITCH = 72;
static_assert(L_PB + 9216 <= 131072, "GLA LDS map");

struct ChunkInfo { int r0, b, posf, posb, seg_lo, seg_hi; };
__device__ __forceinline__ ChunkInfo chunk_info(int cidx) {
    ChunkInfo ci;
    if (cidx < 256) { ci.b = cidx >> 7; const int c = cidx & 127; ci.r0 = cidx * 64; ci.posf = 4 + c; ci.posb = 4 + (127 - c); ci.seg_lo = ci.r0; ci.seg_hi = ci.r0 + 64; }
    else { const int cc = cidx - 256; ci.b = cc >> 2; const int j = cc & 3; ci.r0 = MLAT + cc * 64; ci.posf = j; ci.posb = 3 - j; ci.seg_lo = MLAT + ci.b * 256; ci.seg_hi = ci.seg_lo + 256; }
    return ci;
}
__device__ __forceinline__ float pick8(const f32x4& a, const f32x4& b, int i) { return i < 4 ? a[i & 3] : b[i & 3]; }
__device__ __forceinline__ float logsigmoidf(float x) { return fminf(x, 0.f) - 0.6931471806f * __builtin_amdgcn_logf(1.0f + __builtin_amdgcn_exp2f(-1.4426950409f * fabsf(x))); }

struct GFirst { u32x4 zf[4]; u32x4 k, q, v0, v1; };
__device__ __forceinline__ void gla_load_a(GFirst& R, const bf16_t* proj, int r0, int tid) {
    const int fr = tid & 15, fq = (tid >> 4) & 3;
#pragma unroll
    for (int tt = 0; tt < 4; ++tt) R.zf[tt] = *(const u32x4*)(proj + PZ + (size_t)(r0 + 16 * tt + fr) * 32 + 8 * fq);
}
struct GateConst { bf16x8 bfrag; float gbias; int h; };
__device__ __forceinline__ void gate_const(GateConst& gc, const float* gate_w, const float* gate_b, int h, int tid) {
    const int fr = tid & 15, fq = (tid >> 4) & 3, w = tid >> 6, d = w >> 2, n = h * 64 + (w & 3) * 16 + fr;
    float v[8];
#pragma unroll
    for (int j = 0; j < 8; ++j) v[j] = 0.f;
    if ((fq >> 1) == d) {
        const unsigned o = (unsigned)((d * 16 + 8 * (fq & 1)) * 256 + n);
#pragma unroll
        for (int j = 0; j < 8; ++j) v[j] = gate_w[o + (unsigned)(j * 256)];
    }
    const u32x4 p = (u32x4){pk2(v[0], v[1]), pk2(v[2], v[3]), pk2(v[4], v[5]), pk2(v[6], v[7])};
    gc.bfrag = __builtin_bit_cast(bf16x8, p);
    gc.gbias = gate_b[d * 256 + n]; gc.h = h;
}
template <bool WITH_Q>
__device__ __forceinline__ void gla_load_b(GFirst& R, const bf16_t* proj, int r0, int h, int tid) {
    const int t = tid & 63, cg = tid >> 6;
    const size_t hr = (size_t)h * MALL + (size_t)(r0 + t);
    R.k = *(const u32x4*)(proj + PK + hr * 64 + cg * 8);
    if (WITH_Q) R.q = *(const u32x4*)(proj + PQ + hr * 64 + cg * 8);
    R.v0 = *(const u32x4*)(proj + PV + hr * 128 + cg * 8);
    R.v1 = *(const u32x4*)(proj + PV + hr * 128 + 64 + cg * 8);
}
template <bool WITH_Q>
__device__ __forceinline__ void gla_load_first(GFirst& R, const bf16_t* proj, int r0, int h, int tid) {
    gla_load_a(R, proj, r0, tid); gla_load_b<WITH_Q>(R, proj, r0, h, tid);
}

__device__ __forceinline__ void gla_gates(const GFirst& R, const GateConst& gc, LAS unsigned char* lds, int tid) {
    const int lane = tid & 63, fr = lane & 15, fq = lane >> 4, w = tid >> 6, d = w >> 2, j = (w & 3) * 16 + fr;
    LAS float* BX = (LAS float*)(lds + (d ? L_BB : L_BF));
    float g[4][4];
#pragma unroll
    for (int tt = 0; tt < 4; ++tt) {
        const f32x4 acc = __builtin_amdgcn_mfma_f32_16x16x32_bf16(__builtin_bit_cast(bf16x8, R.zf[tt]), gc.bfrag, (f32x4){0.f, 0.f, 0.f, 0.f}, 0, 0, 0);
#pragma unroll
        for (int r = 0; r < 4; ++r) g[tt][r] = logsigmoidf(acc[r] + gc.gbias) * (1.0f / 16.0f);
    }
    if (d == 0) {
        float off = 0.f;
#pragma unroll
        for (int tt = 0; tt < 4; ++tt) {
            const float p0 = g[tt][0], p1 = p0 + g[tt][1], p2 = p1 + g[tt][2], p3 = p2 + g[tt][3];
            float s = p3; float v = __shfl(s, (lane - 16) & 63); s += fq >= 1 ? v : 0.f; v = __shfl(s, (lane - 32) & 63); s += fq >= 2 ? v : 0.f;
            const float e = off + (s - p3), tot = __shfl(s, 48 + fr);
            LAS float* bp = BX + (16 * tt + 4 * fq) * BPITCH + j;
            bp[0] = e + p0; bp[BPITCH] = e + p1; bp[2 * BPITCH] = e + p2; bp[3 * BPITCH] = e + p3;
            off += tot;
        }
    } else {
        float off = 0.f;
#pragma unroll
        for (int tt = 3; tt >= 0; --tt) {
            const float s3 = g[tt][3], s2 = s3 + g[tt][2], s1 = s2 + g[tt][1], s0 = s1 + g[tt][0];
            float s = s0; float v = __shfl(s, (lane + 16) & 63); s += fq <= 2 ? v : 0.f; v = __shfl(s, (lane + 32) & 63); s += fq <= 1 ? v : 0.f;
            const float e = off + (s - s0), tot = __shfl(s, fr);
            LAS float* bp = BX + (16 * tt + 4 * fq) * BPITCH + j;
            bp[0] = e + s0; bp[BPITCH] = e + s1; bp[2 * BPITCH] = e + s2; bp[3 * BPITCH] = e + s3;
            off += tot;
        }
    }
    __syncthreads();
}
__device__ __forceinline__ void gla_write_vt(const GFirst& R, LAS unsigned char* lds, int tid) {
    LAS bf16_t* VT = (LAS bf16_t*)(lds + L_VT); const int t = tid & 63, cg = tid >> 6;
    const unsigned a[4] = {R.v0.x, R.v0.y, R.v0.z, R.v0.w}, b[4] = {R.v1.x, R.v1.y, R.v1.z, R.v1.w};
#pragma unroll
    for (int i = 0; i < 4; ++i) {
        VT[(cg * 8 + 2 * i) * PITCH + t] = (bf16_t)(a[i] & 0xffffu); VT[(cg * 8 + 2 * i + 1) * PITCH + t] = (bf16_t)(a[i] >> 16);
        VT[(64 + cg * 8 + 2 * i) * PITCH + t] = (bf16_t)(b[i] & 0xffffu); VT[(64 + cg * 8 + 2 * i + 1) * PITCH + t] = (bf16_t)(b[i] >> 16);
    }
}

__device__ __forceinline__ void phase_gla_u(const Args& a, int l, LAS unsigned char* lds) {
    const int tid = tid_opaque(), lane = tid & 63, wave = tid >> 6;
    const bf16_t* proj = (const bf16_t*)(a.ws + WS_PROJ);
    bf16_t* U = (bf16_t*)a.out; float* DEC = (float*)(a.ws + WS_DEC);
    const float* gate_w = a.in[9] + (size_t)l * 2 * 16 * 256; const float* gate_b = a.in[10] + (size_t)l * 2 * 256;
    LAS float* BF = (LAS float*)(lds + L_BF); LAS float* BB = (LAS float*)(lds + L_BB);
    LAS bf16_t* KTF = (LAS bf16_t*)(lds + L_QEF); LAS bf16_t* KTB = (LAS bf16_t*)(lds + L_QEB); LAS bf16_t* VT = (LAS bf16_t*)(lds + L_VT);
    constexpr int NIT = 264 * 4;
    GFirst R; GateConst gc; gc.h = -1;
    if (bid_opaque() < NIT) { const ChunkInfo c0 = chunk_info(bid_opaque() >> 2); gla_load_first<false>(R, proj, c0.r0, bid_opaque() & 3, tid); }
#pragma unroll 1
    for (int it = bid_opaque(); it < NIT; it += gridDim.x) {
        const int cidx = it >> 2, h = it & 3; const ChunkInfo ci = chunk_info(cidx);
        const int itn = it + gridDim.x; const ChunkInfo cn = chunk_info((itn < NIT ? itn : it) >> 2);
        if (gc.h != h) gate_const(gc, gate_w, gate_b, h, tid);
        GFirst Rn;
#pragma unroll
        for (int tt = 0; tt < 4; ++tt) Rn.zf[tt] = R.zf[tt];
        if (itn < NIT) gla_load_a(Rn, proj, cn.r0, tid);
        gla_gates(R, gc, lds, tid);
        { const int t = tid & 63, cg = tid >> 6;
          const unsigned ww[4] = {R.k.x, R.k.y, R.k.z, R.k.w};
          const f32x4 bfa = *(const LAS f32x4*)(BF + t * BPITCH + cg * 8), bfb = *(const LAS f32x4*)(BF + t * BPITCH + cg * 8 + 4);
          const f32x4 bba = *(const LAS f32x4*)(BB + t * BPITCH + cg * 8), bbb = *(const LAS f32x4*)(BB + t * BPITCH + cg * 8 + 4);
          const f32x4 fla = *(const LAS f32x4*)(BF + 63 * BPITCH + cg * 8), flb = *(const LAS f32x4*)(BF + 63 * BPITCH + cg * 8 + 4);
          const f32x4 b0a = *(const LAS f32x4*)(BB + cg * 8), b0b = *(const LAS f32x4*)(BB + cg * 8 + 4);
#pragma unroll
          for (int i = 0; i < 8; ++i) { const int dk = cg * 8 + i; const float kf = (i & 1) ? bfhi(ww[i >> 1]) : bflo(ww[i >> 1]);
              KTF[dk * PITCH + t] = f2bf(kf * __expf(pick8(fla, flb, i) - pick8(bfa, bfb, i)));
              KTB[dk * PITCH + t] = f2bf(kf * __expf(pick8(b0a, b0b, i) - pick8(bba, bbb, i))); } }
        gla_write_vt(R, lds, tid);
        if (tid < 128) { const int d = tid >> 6, j = tid & 63;
            DEC[((size_t)((ci.b * 4 + h) * 2 + d) * NPOS + (d ? ci.posb : ci.posf)) * 64 + j] = __expf(d ? BB[j] : BF[63 * BPITCH + j]); }
        if (itn < NIT) gla_load_b<false>(R, proj, cn.r0, itn & 3, tid);
        __syncthreads();
        {
            const int dir = wave >> 2, jv = (wave & 3) * 32, fr = lane & 15, fq = lane >> 4;
            const LAS bf16_t* KT = dir ? KTB : KTF;
            bf16x8 af[4][2], bfr[2][2];
#pragma unroll
            for (int i = 0; i < 4; ++i)
#pragma unroll
                for (int ks = 0; ks < 2; ++ks) af[i][ks] = *(const LAS bf16x8*)(KT + (i * 16 + fr) * PITCH + ks * 32 + 8 * fq);
#pragma unroll
            for (int jt = 0; jt < 2; ++jt)
#pragma unroll
                for (int ks = 0; ks < 2; ++ks) bfr[jt][ks] = *(const LAS bf16x8*)(VT + (jv + jt * 16 + fr) * PITCH + ks * 32 + 8 * fq);
            bf16_t* Ub = U + ((size_t)((ci.b * 4 + h) * 2 + dir) * NPOS + (dir ? ci.posb : ci.posf)) * 8192 + (size_t)jv * 64;
            LAS unsigned char* wst = lds + (wave < 4 ? wave * 4608 : L_KIF + (wave - 4) * 4608);
#pragma unroll
            for (int i = 0; i < 4; ++i)
#pragma unroll
                for (int jt = 0; jt < 2; ++jt) {
                    f32x4 acc = (f32x4){0.f, 0.f, 0.f, 0.f};
#pragma unroll
                    for (int ks = 0; ks < 2; ++ks) acc = __builtin_amdgcn_mfma_f32_16x16x32_bf16(af[i][ks], bfr[jt][ks], acc, 0, 0, 0);
                    u32x2 o; o.x = pk2(acc[0], acc[1]); o.y = pk2(acc[2], acc[3]);
                    *(LAS u32x2*)(wst + (jt * 16 + fr) * 144 + (i * 16 + 4 * fq) * 2) = o;
                }
#pragma unroll
            for (int c4 = 0; c4 < 4; ++c4) {
                const int c = c4 * 64 + lane, row = c >> 3, piece = c & 7;
                const u32x4 w = *(const LAS u32x4*)(wst + row * 144 + piece * 16);
                *(u32x4*)(Ub + (size_t)c * 8) = w;
            }
        }
#pragma unroll
        for (int tt = 0; tt < 4; ++tt) R.zf[tt] = Rn.zf[tt];
    }
}

__device__ __forceinline__ void phase_gla_scan(const Args& a, LAS unsigned char* lds) {
    const unsigned* U = (const unsigned*)a.out; unsigned* S = (unsigned*)(a.ws + WS_S); const float* DEC = (const float*)(a.ws + WS_DEC);
    constexpr int SEGL = NPOS / 4;
    const int tid = tid_opaque(), lane = tid & 63, wave = tid >> 6, seg = wave & 3, grp = wave >> 2;
    LAS float* X = (LAS float*)lds;
    for (int bi = bid_opaque(); bi < 16 * 4096 / 128; bi += gridDim.x) {
        const int pidx = bi * 128 + grp * 64 + lane, seq = pidx >> 12, e2 = pidx & 4095, dk = (e2 * 2) & 63, pl = grp * 64 + lane;
        const unsigned* up = U + ((size_t)seq * NPOS + seg * SEGL) * 4096 + e2; unsigned* sp = S + ((size_t)seq * NPOS + seg * SEGL) * 4096 + e2;
        const float* dp = DEC + ((size_t)seq * NPOS + seg * SEGL) * 64 + dk;
        unsigned u[SEGL]; float d0[SEGL], d1[SEGL];
#pragma unroll
        for (int i = 0; i < SEGL; ++i) { u[i] = up[(size_t)i * 4096]; const float2 dd = *(const float2*)(dp + i * 64); d0[i] = dd.x; d1[i] = dd.y; }
        float s0 = 0.f, s1 = 0.f, c0 = 1.f, c1 = 1.f;
#pragma unroll
        for (int i = 0; i < SEGL; ++i) { s0 = d0[i] * s0 + bflo(u[i]); s1 = d1[i] * s1 + bfhi(u[i]); c0 *= d0[i]; c1 *= d1[i]; }
        X[(0 * 4 + seg) * 128 + pl] = s0; X[(1 * 4 + seg) * 128 + pl] = s1; X[(2 * 4 + seg) * 128 + pl] = c0; X[(3 * 4 + seg) * 128 + pl] = c1;
        __syncthreads();
        float k0 = 0.f, k1 = 0.f;
#pragma unroll
        for (int k = 0; k < 3; ++k) {
            if (k < seg) { k0 = X[(2 * 4 + k) * 128 + pl] * k0 + X[(0 * 4 + k) * 128 + pl]; k1 = X[(3 * 4 + k) * 128 + pl] * k1 + X[(1 * 4 + k) * 128 + pl]; }
        }
        s0 = k0; s1 = k1;
#pragma unroll
        for (int i = 0; i < SEGL; ++i) { sp[(size_t)i * 4096] = pk2(s0, s1); s0 = d0[i] * s0 + bflo(u[i]); s1 = d1[i] * s1 + bfhi(u[i]); }
        __syncthreads();
    }
}

template <int HALF>
__device__ __forceinline__ void pool_rows(const bf16_t* proj, bf16_t* Y, int c0, int t0, int seg_lo, int seg_hi) {
    constexpr int NR = 2 * HALF + 3;
    u32x4 uw[NR];
#pragma unroll
    for (int j = 0; j < NR; ++j) { const int rc = min(max(t0 - HALF + j, seg_lo), seg_hi - 1); uw[j] = *(const u32x4*)(proj + PP + (size_t)rc * 256 + c0); }
    float sm[8];
#pragma unroll
    for (int i = 0; i < 8; ++i) sm[i] = 0.f;
#pragma unroll
    for (int j = 0; j < NR; ++j) {
        const int rr = t0 - HALF + j; const bool inseg = rr >= seg_lo && rr < seg_hi;
        const unsigned uu[4] = {uw[j].x, uw[j].y, uw[j].z, uw[j].w};
        float uv[8];
#pragma unroll
        for (int i = 0; i < 4; ++i) { uv[2 * i] = inseg ? bflo(uu[i]) : 0.f; uv[2 * i + 1] = inseg ? bfhi(uu[i]) : 0.f; }
#pragma unroll
        for (int i = 0; i < 8; ++i) sm[i] += uv[i];
        if (j >= 2 * HALF - 1) {
            const int tt = j - (2 * HALF - 1), tk = t0 + tt, lo = max(tk - HALF, seg_lo), hi = min(tk + HALF, seg_hi);
            const float inv = 1.0f / (float)(hi - lo);
            const unsigned su[4] = {uw[HALF + tt].x, uw[HALF + tt].y, uw[HALF + tt].z, uw[HALF + tt].w};
            float pp[8];
#pragma unroll
            for (int i = 0; i < 8; ++i) pp[i] = sm[i] * inv - ((i & 1) ? bfhi(su[i >> 1]) : bflo(su[i >> 1]));
            *(u32x4*)(Y + (size_t)tk * D + 768 + c0) = (u32x4){pk2(pp[0], pp[1]), pk2(pp[2], pp[3]), pk2(pp[4], pp[5]), pk2(pp[6], pp[7])};
            const int jl = tt; const int rl = t0 - HALF + jl; const bool insl = rl >= seg_lo && rl < seg_hi;
            const unsigned ul[4] = {uw[jl].x, uw[jl].y, uw[jl].z, uw[jl].w};
#pragma unroll
            for (int i = 0; i < 4; ++i) { sm[2 * i] -= insl ? bflo(ul[i]) : 0.f; sm[2 * i + 1] -= insl ? bfhi(ul[i]) : 0.f; }
        }
    }
}

__device__ __forceinline__ void phase_gla_out(const Args& a, int l, int nchunks, LAS unsigned char* lds) {
    const int tid = tid_opaque(), lane = tid & 63, wave = tid >> 6, fr = lane & 15, fq = lane >> 4;
    const bf16_t* proj = (const bf16_t*)(a.ws + WS_PROJ);
    const bf16_t* S = (const bf16_t*)(a.ws + WS_S); bf16_t* Y = (bf16_t*)(a.ws + WS_Y);
    const float* gate_w = a.in[9] + (size_t)l * 2 * 16 * 256; const float* gate_b = a.in[10] + (size_t)l * 2 * 256;
    const float* gnw = a.in[11] + l * 128; const float* conv_w = a.in[12] + l * 3 * 256;
    LAS float* BF = (LAS float*)(lds + L_BF); LAS float* BB = (LAS float*)(lds + L_BB); LAS float* SSX = (LAS float*)(lds + L_SEG);
    LAS bf16_t* QEF = (LAS bf16_t*)(lds + L_QEF); LAS bf16_t* QEB = (LAS bf16_t*)(lds + L_QEB);
    LAS bf16_t* KIF = (LAS bf16_t*)(lds + L_KIF); LAS bf16_t* KIB = (LAS bf16_t*)(lds + L_KIB);
    LAS bf16_t* VT = (LAS bf16_t*)(lds + L_VT); LAS bf16_t* PF = (LAS bf16_t*)(lds + L_PF); LAS bf16_t* PB = (LAS bf16_t*)(lds + L_PB);
    const int n_gla = nchunks * 4;
    GFirst R; GateConst gc; gc.h = -1;
    if (bid_opaque() < n_gla) { const ChunkInfo c0 = chunk_info(bid_opaque() >> 2); gla_load_first<true>(R, proj, c0.r0, bid_opaque() & 3, tid); }
#pragma unroll 1
    for (int it = bid_opaque(); it < n_gla + nchunks; it += gridDim.x) {
        if (it < n_gla) {
            const int cidx = it >> 2, h = it & 3; const ChunkInfo ci = chunk_info(cidx);
            const int tt = wave & 3, trow = tt * 16 + fr;
            const int dvr = wave * 16 + fr;
            bf16x8 sfa[2], sba[2]; u32x2 rw[4];
            {
                const bf16_t* Sf = S + ((size_t)((ci.b * 4 + h) * 2 + 0) * NPOS + ci.posf) * 8192;
                const bf16_t* Sb = S + ((size_t)((ci.b * 4 + h) * 2 + 1) * NPOS + ci.posb) * 8192;
#pragma unroll
                for (int ks = 0; ks < 2; ++ks) { sfa[ks] = *(const bf16x8*)(Sf + (size_t)dvr * 64 + ks * 32 + 8 * fq); sba[ks] = *(const bf16x8*)(Sb + (size_t)dvr * 64 + ks * 32 + 8 * fq); }
#pragma unroll
                for (int t4 = 0; t4 < 4; ++t4) rw[t4] = *(const u32x2*)(proj + PR + ((size_t)h * MALL + (size_t)(ci.r0 + t4 * 16 + fr)) * 128 + wave * 16 + 4 * fq);
            }
            const int itn = it + gridDim.x; const ChunkInfo cn = chunk_info((itn < n_gla ? itn : it) >> 2);
            if (gc.h != h) gate_const(gc, gate_w, gate_b, h, tid);
            GFirst Rn;
#pragma unroll
            for (int tt = 0; tt < 4; ++tt) Rn.zf[tt] = R.zf[tt];
            if (itn < n_gla) gla_load_a(Rn, proj, cn.r0, tid);
            gla_gates(R, gc, lds, tid);
            { const int t = tid & 63, cg = tid >> 6;
              const unsigned qq[4] = {R.q.x, R.q.y, R.q.z, R.q.w}, kk[4] = {R.k.x, R.k.y, R.k.z, R.k.w};
              const f32x4 bfa = *(const LAS f32x4*)(BF + t * BPITCH + cg * 8), bfb = *(const LAS f32x4*)(BF + t * BPITCH + cg * 8 + 4);
              const f32x4 bba = *(const LAS f32x4*)(BB + t * BPITCH + cg * 8), bbb = *(const LAS f32x4*)(BB + t * BPITCH + cg * 8 + 4);
              unsigned oqf[4], oqb[4], okf[4], okb[4];
#pragma unroll
              for (int i = 0; i < 4; ++i) {
                  const float ef0 = __expf(pick8(bfa, bfb, 2 * i)), ef1 = __expf(pick8(bfa, bfb, 2 * i + 1)), eb0 = __expf(pick8(bba, bbb, 2 * i)), eb1 = __expf(pick8(bba, bbb, 2 * i + 1));
                  const float q0 = bflo(qq[i]) * 0.125f, q1 = bfhi(qq[i]) * 0.125f, k0 = bflo(kk[i]), k1 = bfhi(kk[i]);
                  oqf[i] = pk2(q0 * ef0, q1 * ef1); oqb[i] = pk2(q0 * eb0, q1 * eb1);
                  okf[i] = pk2(k0 * __builtin_amdgcn_rcpf(ef0), k1 * __builtin_amdgcn_rcpf(ef1)); okb[i] = pk2(k0 * __builtin_amdgcn_rcpf(eb0), k1 * __builtin_amdgcn_rcpf(eb1));
              }
              *(LAS u32x4*)(QEF + t * PITCH + cg * 8) = (u32x4){oqf[0], oqf[1], oqf[2], oqf[3]};
              *(LAS u32x4*)(QEB + t * PITCH + cg * 8) = (u32x4){oqb[0], oqb[1], oqb[2], oqb[3]};
              *(LAS u32x4*)(KIF + t * PITCH + cg * 8) = (u32x4){okf[0], okf[1], okf[2], okf[3]};
              *(LAS u32x4*)(KIB + t * PITCH + cg * 8) = (u32x4){okb[0], okb[1], okb[2], okb[3]}; }
            gla_write_vt(R, lds, tid);
            if (itn < n_gla) gla_load_b<true>(R, proj, cn.r0, itn & 3, tid);
            __syncthreads();
            {
                const int dir = wave >> 2;
                const LAS bf16_t* KI = dir ? KIB : KIF; const LAS bf16_t* QE = dir ? QEB : QEF; LAS bf16_t* P = dir ? PB : PF;
                bf16x8 qb[2];
#pragma unroll
                for (int ks = 0; ks < 2; ++ks) qb[ks] = *(const LAS bf16x8*)(QE + trow * PITCH + ks * 32 + 8 * fq);
#pragma unroll
                for (int st = 0; st < 4; ++st) {
                    f32x4 acc = (f32x4){0.f, 0.f, 0.f, 0.f};
#pragma unroll
                    for (int ks = 0; ks < 2; ++ks) { const bf16x8 ka = *(const LAS bf16x8*)(KI + (st * 16 + fr) * PITCH + ks * 32 + 8 * fq);
                        acc = __builtin_amdgcn_mfma_f32_16x16x32_bf16(ka, qb[ks], acc, 0, 0, 0); }
                    const int s0 = st * 16 + 4 * fq;
#pragma unroll
                    for (int r = 0; r < 4; ++r) { const int s = s0 + r; const bool keep = dir ? (s >= trow) : (s <= trow); acc[r] = keep ? acc[r] : 0.f; }
                    u32x2 o; o.x = pk2(acc[0], acc[1]); o.y = pk2(acc[2], acc[3]);
                    *(LAS u32x2*)(P + trow * PITCH + s0) = o;
                }
            }
            __syncthreads();
            {
                f32x4 acc[4];
#pragma unroll
                for (int t4 = 0; t4 < 4; ++t4) acc[t4] = (f32x4){0.f, 0.f, 0.f, 0.f};
#pragma unroll
                for (int ks = 0; ks < 2; ++ks) {
                    const bf16x8 va = *(const LAS bf16x8*)(VT + dvr * PITCH + ks * 32 + 8 * fq);
#pragma unroll
                    for (int t4 = 0; t4 < 4; ++t4) {
                        const int tr = t4 * 16 + fr;
                        const bf16x8 pf = *(const LAS bf16x8*)(PF + tr * PITCH + ks * 32 + 8 * fq), pb = *(const LAS bf16x8*)(PB + tr * PITCH + ks * 32 + 8 * fq);
                        const bf16x8 qf = *(const LAS bf16x8*)(QEF + tr * PITCH + ks * 32 + 8 * fq), qb = *(const LAS bf16x8*)(QEB + tr * PITCH + ks * 32 + 8 * fq);
                        acc[t4] = __builtin_amdgcn_mfma_f32_16x16x32_bf16(va, pf, acc[t4], 0, 0, 0);
                        acc[t4] = __builtin_amdgcn_mfma_f32_16x16x32_bf16(va, pb, acc[t4], 0, 0, 0);
                        acc[t4] = __builtin_amdgcn_mfma_f32_16x16x32_bf16(sfa[ks], qf, acc[t4], 0, 0, 0);
                        acc[t4] = __builtin_amdgcn_mfma_f32_16x16x32_bf16(sba[ks], qb, acc[t4], 0, 0, 0);
                    }
                }
#pragma unroll
                for (int t4 = 0; t4 < 4; ++t4) {
                    float ss = (acc[t4][0] * acc[t4][0] + acc[t4][1] * acc[t4][1]) + (acc[t4][2] * acc[t4][2] + acc[t4][3] * acc[t4][3]);
                    ss += __shfl_xor(ss, 16); ss += __shfl_xor(ss, 32);
                    if (fq == 0) SSX[wave * 64 + t4 * 16 + fr] = ss;
                }
                __syncthreads();
                const f32x4 nw = *(const f32x4*)(gnw + wave * 16 + 4 * fq);
#pragma unroll
                for (int t4 = 0; t4 < 4; ++t4) {
                    const int tr = t4 * 16 + fr;
                    float tot = 0.f;
#pragma unroll
                    for (int w8 = 0; w8 < 8; ++w8) tot += SSX[w8 * 64 + tr];
                    const float rs = rsqrtf(tot * (1.0f / 128.0f) + EPS);
                    const float y0 = acc[t4][0] * rs * nw.x * siluf(bflo(rw[t4].x)), y1 = acc[t4][1] * rs * nw.y * siluf(bfhi(rw[t4].x));
                    const float y2 = acc[t4][2] * rs * nw.z * siluf(bflo(rw[t4].y)), y3 = acc[t4][3] * rs * nw.w * siluf(bfhi(rw[t4].y));
                    u32x2 o; o.x = pk2(y0, y1); o.y = pk2(y2, y3);
                    *(u32x2*)(Y + (size_t)(ci.r0 + tr) * D + h * 128 + wave * 16 + 4 * fq) = o;
                }
            }
#pragma unroll
            for (int t4 = 0; t4 < 4; ++t4) R.zf[t4] = Rn.zf[t4];
        } else {
            const ChunkInfo ci = chunk_info(it - n_gla);
            const int c0 = (tid & 31) * 8, t0 = ci.r0 + (tid >> 5) * 4;
            {
                float z[6][8];
#pragma unroll
                for (int j = 0; j < 6; ++j) {
                    const int rr = t0 + j - 1; const bool ok = rr >= ci.seg_lo && rr < ci.seg_hi; const int rc = min(max(rr, ci.seg_lo), ci.seg_hi - 1);
                    const u32x4 cw = *(const u32x4*)(proj + PC + (size_t)rc * 768 + 256 + c0), hw = *(const u32x4*)(proj + PC + (size_t)rc * 768 + 512 + c0);
                    const unsigned cc[4] = {cw.x, cw.y, cw.z, cw.w}, hh[4] = {hw.x, hw.y, hw.z, hw.w};
#pragma unroll
                    for (int i = 0; i < 4; ++i) { z[j][2 * i] = ok ? bflo(cc[i]) * bflo(hh[i]) : 0.f; z[j][2 * i + 1] = ok ? bfhi(cc[i]) * bfhi(hh[i]) : 0.f; }
                }
                float w0[8], w1[8], w2[8];
#pragma unroll
                for (int i = 0; i < 8; ++i) { w0[i] = conv_w[c0 + i]; w1[i] = conv_w[256 + c0 + i]; w2[i] = conv_w[512 + c0 + i]; }
#pragma unroll
                for (int tt = 0; tt < 4; ++tt) {
                    const u32x4 bw = *(const u32x4*)(proj + PC + (size_t)(t0 + tt) * 768 + c0);
                    const unsigned bbv[4] = {bw.x, bw.y, bw.z, bw.w};
                    float yc[8];
#pragma unroll
                    for (int i = 0; i < 8; ++i) { const float bgv = (i & 1) ? bfhi(bbv[i >> 1]) : bflo(bbv[i >> 1]); yc[i] = bgv * (w0[i] * z[tt][i] + w1[i] * z[tt + 1][i] + w2[i] * z[tt + 2][i]); }
                    *(u32x4*)(Y + (size_t)(t0 + tt) * D + 512 + c0) = (u32x4){pk2(yc[0], yc[1]), pk2(yc[2], yc[3]), pk2(yc[4], yc[5]), pk2(yc[6], yc[7])};
                }
            }
            {
                const int pg = __builtin_amdgcn_readfirstlane(wave & 3);
                const int pc0 = pg * 64 + (lane & 7) * 8, pt0 = ci.r0 + ((wave >> 2) * 8 + (lane >> 3)) * 4;
                if (pg == 0) pool_rows<1>(proj, Y, pc0, pt0, ci.seg_lo, ci.seg_hi);
                else if (pg == 1) pool_rows<2>(proj, Y, pc0, pt0, ci.seg_lo, ci.seg_hi);
                else if (pg == 2) pool_rows<4>(proj, Y, pc0, pt0, ci.seg_lo, ci.seg_hi);
                else pool_rows<8>(proj, Y, pc0, pt0, ci.seg_lo, ci.seg_hi);
            }
        }
    }
}

#define XB_TMO      128
#define XB_XCNT(j)  (256  + 64 * (j))
#define XB_XSUB(j)  (1280 + 64 * (j))
#define XB_XGEN(j)  (2304 + 64 * (j))
#define XB_TOP      3328
#define XB_TOPGEN   3392
#define XCD_BAR_WORDS 3456
#define XB_SPIN_CAP (1u << 18)

__device__ __forceinline__ unsigned xb_ld(unsigned* p)              { return __hip_atomic_load(p, __ATOMIC_RELAXED, __HIP_MEMORY_SCOPE_AGENT); }
__device__ __forceinline__ unsigned xb_add(unsigned* p, unsigned v) { return __hip_atomic_fetch_add(p, v, __ATOMIC_RELAXED, __HIP_MEMORY_SCOPE_AGENT); }
__device__ __forceinline__ unsigned xb_xcc_id() { return (unsigned)__builtin_amdgcn_s_getreg((3 << 11) | 20) & 0xFu; }
#define XB_SPIN(cond, bar) do { unsigned _sp = 0; while (cond) { __builtin_amdgcn_s_sleep(1); \
    if ((++_sp & 255u) == 0u) { if (xb_ld(&(bar)[XB_TMO])) break; if (_sp > XB_SPIN_CAP) { atomicAdd(&(bar)[XB_TMO], 1u); break; } } } } while (0)

struct XcdBarrier {
    unsigned* bar; unsigned x;
    volatile LAS unsigned* st;
};

__device__ __forceinline__ XcdBarrier xcd_barrier_post(unsigned* bar, volatile LAS unsigned* st) {
    XcdBarrier b; b.bar = bar; b.x = xb_xcc_id(); b.st = st;
    if (threadIdx.x == 0) (void)xb_add(&bar[XB_XCNT(b.x)], 1u);
    return b;
}
__device__ __forceinline__ void xcd_barrier_complete(unsigned* bar, unsigned x, unsigned& nloc, unsigned& nx) {
    const unsigned G = gridDim.x * gridDim.y * gridDim.z;
    unsigned sum, cnt, mine, sp = 0u;
    for (;;) {
        sum = 0u; cnt = 0u; mine = 0u;
#pragma unroll
        for (unsigned j = 0; j < 16; ++j) { const unsigned c = xb_ld(&bar[XB_XCNT(j)]); sum += c; cnt += (c > 0u) ? 1u : 0u; mine = (j == x) ? c : mine; }
        if (sum == G) break;
        __builtin_amdgcn_s_sleep(1);
        if ((++sp & 255u) == 0u) { if (xb_ld(&bar[XB_TMO])) break; if (sp > XB_SPIN_CAP) { atomicAdd(&bar[XB_TMO], 1u); break; } }
    }
    nloc = mine > 0u ? mine : 1u; nx = cnt > 0u ? cnt : 1u;
}

__device__ __forceinline__ void xcd_barrier(const XcdBarrier& b) {
    asm volatile("s_waitcnt vmcnt(0)" ::: "memory");
    __syncthreads();
    if (threadIdx.x == 0) {
        unsigned* bar = b.bar; asm volatile("" : "+s"(bar));
        __builtin_amdgcn_s_waitcnt(0);
        unsigned nloc = b.st[0], nx = b.st[1];
        if (nloc == 0u) { xcd_barrier_complete(bar, b.x, nloc, nx); b.st[0] = nloc; b.st[1] = nx; }
        const unsigned old = xb_add(&bar[XB_XSUB(b.x)], 1u);
        const unsigned gen = old / nloc;
        if (old + 1u == (gen + 1u) * nloc) {
            __builtin_amdgcn_fence(__ATOMIC_RELEASE, "agent");
            asm volatile("s_waitcnt vmcnt(0)" ::: "memory");
            const unsigned og = xb_add(&bar[XB_TOP], 1u);
            const unsigned tg = og / nx;
            if (og + 1u == (tg + 1u) * nx) xb_add(&bar[XB_TOPGEN], 1u);
            else XB_SPIN(xb_ld(&bar[XB_TOPGEN]) == tg, bar);
            __builtin_amdgcn_fence(__ATOMIC_ACQUIRE, "agent");
            xb_add(&bar[XB_XGEN(b.x)], 1u);
            asm volatile("s_waitcnt vmcnt(0)" ::: "memory");
        } else {
            XB_SPIN(xb_ld(&bar[XB_XGEN(b.x)]) == gen, bar);
            __builtin_amdgcn_fence(__ATOMIC_ACQUIRE, "agent");
            asm volatile("s_waitcnt vmcnt(0)" ::: "memory");
        }
    }
    __syncthreads();
}


__global__ void __launch_bounds__(NTHREADS, 2) hybrid_fwd(Args a) {
    extern __shared__ __attribute__((aligned(16))) unsigned char smem[];
    LAS unsigned char* lds = (LAS unsigned char*)smem;
    cg::grid_group grid = cg::this_grid();
    const int G = gridDim.x;
    volatile LAS unsigned* bst = (volatile LAS unsigned*)(lds + 131072 + 64);
    if (tid_opaque() < 2) bst[tid_opaque()] = 0u;
    __syncthreads();
    const XcdBarrier bar = xcd_barrier_post((unsigned*)(a.ws + WS_BAR), bst);
#pragma unroll 1
    for (int ph = a.ph_lo; ph < a.ph_hi; ++ph) {
      {
        unsigned char* ws = a.ws; asm volatile("" : "+s"(ws));
        float* MOD = (float*)(ws + WS_MOD);
        bf16_t* H = (bf16_t*)a.out; bf16_t* X = (bf16_t*)(ws + WS_X); bf16_t* PROJ = (bf16_t*)(ws + WS_PROJ); bf16_t* Yb = (bf16_t*)(ws + WS_Y); bf16_t* ACT = (bf16_t*)(ws + WS_ACT);
        float* XC = (float*)(ws + WS_XC);
        if (ph == 0) { phase_prep(a, lds); }
        else if (ph == NPHASES - 1) { phase_final(X, a.out, a.in[18]); }
        else {
            const int l = (ph - 1) / 9, sp = (ph - 1) % 9;
            const float* xctx = l == 0 ? a.in[2] : XC;
            const float* mod = MOD + l * 3 * NMODV;
            const int mrows = l == 0 ? MALL : MLAT;
            if (sp == 0) phase_norm(l == 0 ? a.in[0] : nullptr, X, xctx, MALL, a.in[6] + l * D, mod, 0, 1024, H, (const float*)(ws + WS_PART), l == 0 ? 0 : FF / 256, XC);
            else if (sp == 1) {
                pg8::Gemm g{H, (const bf16_t*)(ws + WS_WIN) + (size_t)l * INP * D, MALL, INP, D, D}; pg8::StaticOrder S; S.init(MALL, INP, G, bid_opaque()); S.ntk = D / 64;
                EpiProj E{PROJ}; pg8::gemm_phase<EpiProj, pg8::StaticOrder, GEMM_ALIGN, GEMM_SP2>(lds, g, S, E);
            }
            else if (sp == 2) phase_gla_u(a, l, lds);
            else if (sp == 3) phase_gla_scan(a, lds);
            else if (sp == 4) phase_gla_out(a, l, mrows / 64, lds);
            else if (sp == 5 || sp == 8) {
                const bool mix = sp == 5; const int KK = mix ? D : FF;
                const bf16_t* Ap = mix ? Yb : ACT; const bf16_t* Bp = mix ? (const bf16_t*)(ws + WS_WOUT) + (size_t)l * D * D : (const bf16_t*)(ws + WS_W2) + (size_t)l * D * FF;
                const float* gate = mod + (mix ? 2048 : 5120);
                pg8::Gemm g{Ap, Bp, MALL, D, KK, KK};
                pg8::MixedOrder S; S.lat.init(MLAT, D, G, bid_opaque()); S.lat.ntk = KK / 64; S.nks = l == 0 ? KK / 256 : 0; S.kslice = 256;
                EpiRes E{(mix && l == 0) ? a.in[0] : nullptr, X, (float*)(ws + WS_PART), gate};
                pg8::gemm_phase<EpiRes, pg8::MixedOrder, GEMM_ALIGN, GEMM_SP2>(lds, g, S, E);
            }
            else if (sp == 6) phase_norm(nullptr, X, l == 0 ? a.in[2] : (const float*)XC, mrows, a.in[7] + l * D, mod, 3072, 4096, H, (const float*)(ws + WS_PART), l == 0 ? D / 256 : 0, XC);
            else {
                pg8::Gemm g{H, (const bf16_t*)(ws + WS_W1) + (size_t)l * FF * D, mrows, FF, D, D}; pg8::StaticOrder S; S.init(mrows, FF, G, bid_opaque()); S.ntk = D / 64;
                EpiAct E{ACT}; pg8::gemm_phase<EpiAct, pg8::StaticOrder, GEMM_ALIGN, GEMM_SP2>(lds, g, S, E);
            }
        }
      }
        if (ph + 1 < a.ph_hi) {
            if (a.ph_hi > NPHASES) {
                __builtin_amdgcn_fence(__ATOMIC_RELEASE, "agent"); asm volatile("s_waitcnt vmcnt(0)" ::: "memory");
                grid.sync();
                __builtin_amdgcn_fence(__ATOMIC_ACQUIRE, "agent"); asm volatile("s_waitcnt vmcnt(0)" ::: "memory");
            }
            xcd_barrier(bar);
        }
    }
}

extern "C" void kernel_launch(void* const* d_in, const int* in_sizes, int n_in, void* d_out, int out_size, void* d_ws, size_t ws_size, hipStream_t stream) {
    static int grid = 0;
    if (grid == 0) {
        int dev = 0, cus = 0, per_cu = 0;
        hipGetDevice(&dev);
        hipDeviceGetAttribute(&cus, hipDeviceAttributeMultiprocessorCount, dev);
        hipFuncSetAttribute((const void*)hybrid_fwd, hipFuncAttributeMaxDynamicSharedMemorySize, LDS_BYTES);
        hipOccupancyMaxActiveBlocksPerMultiprocessor(&per_cu, (const void*)hybrid_fwd, NTHREADS, LDS_BYTES);
        if (per_cu < 1) { fprintf(stderr, "kernel_launch: occupancy query reports %d blocks per CU\n", per_cu); per_cu = 1; }
        (void)hipGetLastError();
        grid = cus * per_cu;
        if (n_in != 19 || ws_size < WS_END) fprintf(stderr, "kernel_launch: unexpected n_in %d / ws_size %zu\n", n_in, ws_size);
    }
    (void)hipMemsetAsync((char*)d_ws + WS_BAR, 0, BAR_BYTES, stream);
    Args a{};
    for (int i = 0; i < 19; ++i) a.in[i] = (const float*)d_in[i];
    a.out = (float*)d_out; a.ws = (unsigned char*)d_ws;
    a.ph_lo = 0; a.ph_hi = NPHASES;
    void* args[] = {&a};
    hipError_t e = hipLaunchCooperativeKernel((const void*)hybrid_fwd, dim3(grid), dim3(NTHREADS), args, LDS_BYTES, stream);
    if (e != hipSuccess) fprintf(stderr, "cooperative launch failed: %s (grid %d)\n", hipGetErrorString(e), grid);
}
```

```cpp
#include <hip/hip_runtime.h>
#include <hip/hip_cooperative_groups.h>
#include <cstdio>
namespace cg = cooperative_groups;
__device__ __forceinline__ int tid_opaque() { int t = threadIdx.x; asm volatile("" : "+v"(t)); return t; }
__device__ __forceinline__ int bid_opaque() { int t = blockIdx.x; asm volatile("" : "+s"(t)); return t; }
namespace pg8 {
#define PG8_LAS __attribute__((address_space(3)))
typedef unsigned short bf16_t;
typedef short bf16x8 __attribute__((ext_vector_type(8)));
typedef float f32x4 __attribute__((ext_vector_type(4)));
typedef unsigned u32x4 __attribute__((ext_vector_type(4)));
constexpr int BM = 256, BK = 64, HALF = 128, HTB = HALF * BK * 2  , STAGE_BYTES = 8 * HTB, NXCD = 8, WGM = 4;

__host__ __device__ __forceinline__ int lds_byte(int r, int c) { const int st = (r >> 4) * 2 + (c >> 5), rr = r & 15, cc = c & 31, ob = rr * 64 + cc * 2; return st * 1024 + (ob ^ (((ob >> 9) & 1) << 5)); }
__host__ __device__ __forceinline__ void stage_rc(int b, int& R, int& C) { const int st = b / 1024, sb = b % 1024, swz = sb ^ (((sb >> 9) & 1) << 5); R = (st >> 1) * 16 + swz / 64; C = (st & 1) * 32 + (swz % 64) / 2; }
__host__ __device__ __forceinline__ int perm32(int rho) { const int n = rho >> 4, i = rho & 15; return 8 * (i >> 2) + 4 * n + (i & 3); }

struct Unit { int pm, pn, kofs, nt; };
struct Gemm { const bf16_t* A; const bf16_t* Bt; int M, N, K, ld; };

struct StaticOrder {
    int nM, nN, nwg, G, c, ntk;
    __host__ __device__ void init(int M, int N, int G_, int c_) { nM = M / BM; nN = N / BM; nwg = nM * nN; G = G_; c = c_; }
    __host__ __device__ bool next(int i, Unit& u) const {
        const long L = (long)i * G + c; if (L >= nwg) return false;
        int wgid = (int)L; { const int q = nwg / NXCD, r = nwg % NXCD, xcd = wgid % NXCD, off = wgid / NXCD; wgid = (xcd < r ? xcd * (q + 1) : r * (q + 1) + (xcd - r) * q) + off; }
        const int nig = WGM * nN, gid = wgid / nig, fm = gid * WGM, gsz = (nM - fm) < WGM ? (nM - fm) : WGM;
        u.pm = fm + ((wgid % nig) % gsz); u.pn = (wgid % nig) / gsz; u.kofs = 0; u.nt = ntk; return true;
    }
    __device__ __forceinline__ void a_ready(const Unit&) const {}
    __device__ __forceinline__ void done(const Unit&) const {}
};
struct MixedOrder {
    StaticOrder lat; int nks, kslice;
    __device__ __forceinline__ bool next(int i, Unit& u) const {
        const int L = i * lat.G + lat.c;
        if (L < lat.nwg) return lat.next(i, u);
        const int j = L - lat.nwg; if (j >= 8 * nks) return false;
        u.pm = 64 + (j & 1); u.pn = (j >> 1) & 3; u.kofs = (j >> 3) * kslice; u.nt = kslice / BK; return true;
    }
    __device__ __forceinline__ void a_ready(const Unit&) const {}
    __device__ __forceinline__ void done(const Unit&) const {}
};
__device__ __forceinline__ unsigned cvt_pk_bf16(float lo, float hi) { unsigned r; asm volatile("v_cvt_pk_bf16_f32 %0, %1, %2" : "=v"(r) : "v"(lo), "v"(hi)); return r; }
template <class Epi, class Sched, bool ALIGN_EPI = false, bool SP2 = false>
__device__ __forceinline__ void gemm_phase(PG8_LAS unsigned char* lds, const Gemm g, const Sched& S, const Epi& E) {
    const int tid = tid_opaque(), wid = __builtin_amdgcn_readfirstlane(tid >> 6), lane = tid & 63, wr = wid >> 2, wc = wid & 3, fr = lane & 15, fq = lane >> 4;
    const int LD = g.ld;
    unsigned voffA[2], voffB[2];
#pragma unroll
    for (int i = 0; i < 2; ++i) { int R, C; stage_rc(tid * 16 + i * 8192, R, C); const int Rb = Epi::PERM ? ((R & ~31) + perm32(R & 31)) : R;
        voffA[i] = (unsigned)(R * LD + C) * 2u; voffB[i] = (unsigned)(Rb * LD + C) * 2u; }
    const size_t kstep = (size_t)(BK * 2);
    const size_t hstep = (size_t)HALF * LD * 2;
    const size_t tstep = 2 * hstep;
    const unsigned ldsw = (unsigned)wid * 1024u;
    const int aoff = lds_byte(wr * 64 + fr, fq * 8), boff = lds_byte(wc * 32 + fr, fq * 8);
#define PG8_SA(b, h) (((b) * 2 + (h)) * HTB)
#define PG8_SB(b, h) ((4 + (b) * 2 + (h)) * HTB)
#define PG8_STAGE(bufoff, gbase, voff) do { _Pragma("unroll") for (int _i = 0; _i < 2; ++_i) \
        __builtin_amdgcn_global_load_lds((const unsigned*)((const char*)(gbase) + (voff)[_i]), (PG8_LAS unsigned*)(lds + (bufoff) + ldsw + _i * 8192), 16, 0, 0); } while (0)
#define PG8_LDA(dst, b, h) do { _Pragma("unroll") for (int m = 0; m < 4; ++m) _Pragma("unroll") for (int k = 0; k < 2; ++k) dst[m][k] = *(const PG8_LAS bf16x8*)(lds + PG8_SA(b, h) + aoff + m * 2048 + k * 1024); } while (0)
#define PG8_LDB(dst, b, h) do { _Pragma("unroll") for (int n = 0; n < 2; ++n) _Pragma("unroll") for (int k = 0; k < 2; ++k) dst[n][k] = *(const PG8_LAS bf16x8*)(lds + PG8_SB(b, h) + boff + n * 2048 + k * 1024); } while (0)
#define PG8_MMA(ai, bj, At, Bt) do { __builtin_amdgcn_s_setprio(1); _Pragma("unroll") for (int m = 0; m < 4; ++m) _Pragma("unroll") for (int n = 0; n < 2; ++n) _Pragma("unroll") for (int k = 0; k < 2; ++k) \
        acc[ai][bj][m][n] = __builtin_amdgcn_mfma_f32_16x16x32_bf16(Bt[n][k], At[m][k], acc[ai][bj][m][n], 0, 0, 0); __builtin_amdgcn_s_setprio(0); } while (0)
#define PG8_WAIT_V(n) asm volatile("s_waitcnt vmcnt(" #n ")" ::: "memory")
#define PG8_WAIT_L(n) asm volatile("s_waitcnt lgkmcnt(" #n ")" ::: "memory")
#define PG8_BAR __builtin_amdgcn_s_barrier()
#define PG8_SCHED __builtin_amdgcn_sched_barrier(0)
    Unit cur, nxt; int ui = 0;
    if (!S.next(0, cur)) return;
    f32x4 acc[2][2][4][2];
#pragma unroll
    for (int a = 0; a < 2; ++a)
#pragma unroll
        for (int b = 0; b < 2; ++b)
#pragma unroll
            for (int m = 0; m < 4; ++m)
#pragma unroll
                for (int n = 0; n < 2; ++n) acc[a][b][m][n] = (f32x4){0.f, 0.f, 0.f, 0.f};
    bf16x8 At[4][2], B0[2][2], B1[2][2];
    const char* cA = (const char*)g.A + (size_t)cur.pm * tstep + (size_t)cur.kofs * 2; const char* cB = (const char*)g.Bt + (size_t)cur.pn * tstep + (size_t)cur.kofs * 2;
    S.a_ready(cur);
    if constexpr (SP2) {
        PG8_STAGE(PG8_SB(0, 0), cB, voffB); PG8_STAGE(PG8_SB(0, 1), cB + hstep, voffB); PG8_STAGE(PG8_SA(0, 0), cA, voffA); PG8_STAGE(PG8_SA(0, 1), cA + hstep, voffA);
        if (wr == 1) PG8_BAR;
        PG8_WAIT_V(2); PG8_BAR;
        PG8_STAGE(PG8_SB(1, 0), cB + kstep, voffB); PG8_STAGE(PG8_SA(1, 0), cA + kstep, voffA); PG8_STAGE(PG8_SB(1, 1), cB + hstep + kstep, voffB);
        PG8_WAIT_V(6); PG8_BAR;
    } else {
        PG8_STAGE(PG8_SB(0, 0), cB, voffB); PG8_STAGE(PG8_SA(0, 0), cA, voffA); PG8_STAGE(PG8_SB(0, 1), cB + hstep, voffB); PG8_STAGE(PG8_SA(0, 1), cA + hstep, voffA);
        if (wr == 1) PG8_BAR;
        PG8_WAIT_V(4); PG8_BAR;
        PG8_STAGE(PG8_SB(1, 0), cB + kstep, voffB); PG8_STAGE(PG8_SA(1, 0), cA + kstep, voffA); PG8_STAGE(PG8_SB(1, 1), cB + hstep + kstep, voffB);
        PG8_WAIT_V(6); PG8_BAR;
    }
    for (;;) {
        const bool has_next = S.next(ui + 1, nxt);
        const char* nA = has_next ? (const char*)g.A + (size_t)nxt.pm * tstep + (size_t)nxt.kofs * 2 : cA; const char* nB = has_next ? (const char*)g.Bt + (size_t)nxt.pn * tstep + (size_t)nxt.kofs * 2 : cB;
        const int nt = cur.nt;
        for (int t = 0; t < nt; t += 2) {
            const bool last = (t == nt - 2);
            const char* a1 = cA + (size_t)(t + 1) * kstep;
            const char* a2 = last ? nA : cA + (size_t)(t + 2) * kstep; const char* b2 = last ? nB : cB + (size_t)(t + 2) * kstep;
            const char* a3 = a2 + kstep; const char* b3 = b2 + kstep;
            if (last && has_next) S.a_ready(nxt);
            if constexpr (SP2) {
            PG8_LDB(B0, 0, 0); PG8_LDB(B1, 0, 1); PG8_SCHED; PG8_LDA(At, 0, 0); PG8_STAGE(PG8_SA(1, 1), a1 + hstep, voffA);
            PG8_WAIT_V(8); PG8_WAIT_L(0); PG8_BAR; PG8_MMA(0, 0, At, B0); PG8_MMA(0, 1, At, B1); PG8_BAR; PG8_SCHED;
            PG8_LDA(At, 0, 1); PG8_STAGE(PG8_SB(0, 0), b2, voffB); PG8_STAGE(PG8_SB(0, 1), b2 + hstep, voffB); PG8_STAGE(PG8_SA(0, 0), a2, voffA);
            PG8_WAIT_V(8); PG8_WAIT_L(0); PG8_BAR; PG8_MMA(1, 0, At, B0); PG8_MMA(1, 1, At, B1); PG8_BAR; PG8_SCHED;
            PG8_LDB(B0, 1, 0); PG8_LDB(B1, 1, 1); PG8_SCHED; PG8_LDA(At, 1, 0); PG8_STAGE(PG8_SA(0, 1), a2 + hstep, voffA);
            PG8_WAIT_V(8); PG8_WAIT_L(0); PG8_BAR; PG8_MMA(0, 0, At, B0); PG8_MMA(0, 1, At, B1); PG8_BAR; PG8_SCHED;
            PG8_LDA(At, 1, 1); PG8_STAGE(PG8_SB(1, 0), b3, voffB); PG8_STAGE(PG8_SB(1, 1), b3 + hstep, voffB); PG8_STAGE(PG8_SA(1, 0), a3, voffA);
            PG8_WAIT_V(8); PG8_WAIT_L(0); PG8_BAR; PG8_MMA(1, 0, At, B0); PG8_MMA(1, 1, At, B1); PG8_BAR; PG8_SCHED;
            } else {
            PG8_LDB(B0, 0, 0); PG8_SCHED; PG8_LDA(At, 0, 0); PG8_STAGE(PG8_SA(1, 1), a1 + hstep, voffA);
            PG8_WAIT_L(8); PG8_BAR; PG8_WAIT_L(0); PG8_MMA(0, 0, At, B0); PG8_BAR; PG8_SCHED;
            PG8_LDB(B1, 0, 1); PG8_STAGE(PG8_SB(0, 0), b2, voffB);
            PG8_BAR; PG8_WAIT_L(0); PG8_MMA(0, 1, At, B1); PG8_BAR;
            PG8_LDA(At, 0, 1); PG8_STAGE(PG8_SA(0, 0), a2, voffA);
            PG8_BAR; PG8_WAIT_L(0); PG8_MMA(1, 0, At, B0); PG8_BAR; PG8_SCHED;
            PG8_STAGE(PG8_SB(0, 1), b2 + hstep, voffB);
            PG8_WAIT_V(6); PG8_BAR; PG8_MMA(1, 1, At, B1); PG8_BAR;
            PG8_LDB(B0, 1, 0); PG8_SCHED; PG8_LDA(At, 1, 0); PG8_STAGE(PG8_SA(0, 1), a2 + hstep, voffA);
            PG8_WAIT_L(8); PG8_BAR; PG8_WAIT_L(0); PG8_MMA(0, 0, At, B0); PG8_BAR; PG8_SCHED;
            PG8_LDB(B1, 1, 1); PG8_STAGE(PG8_SB(1, 0), b3, voffB);
            PG8_BAR; PG8_WAIT_L(0); PG8_MMA(0, 1, At, B1); PG8_BAR;
            PG8_LDA(At, 1, 1); PG8_STAGE(PG8_SA(1, 0), a3, voffA);
            PG8_BAR; PG8_WAIT_L(0); PG8_MMA(1, 0, At, B0); PG8_BAR; PG8_SCHED;
            PG8_STAGE(PG8_SB(1, 1), b3 + hstep, voffB);
            PG8_WAIT_V(6); PG8_BAR; PG8_MMA(1, 1, At, B1); PG8_BAR;
            }
        }
        if constexpr (ALIGN_EPI) { if (wr == 0) PG8_BAR; }
        if constexpr (!Epi::AFTER_DRAIN) { E(acc, cur, wr, wc, fr, fq); S.done(cur); }
        if (!has_next) break;
#pragma unroll
        for (int a = 0; a < 2; ++a)
#pragma unroll
            for (int b = 0; b < 2; ++b)
#pragma unroll
                for (int m = 0; m < 4; ++m)
#pragma unroll
                    for (int n = 0; n < 2; ++n) acc[a][b][m][n] = (f32x4){0.f, 0.f, 0.f, 0.f};
        cur = nxt; cA = nA; cB = nB; ++ui;
        if constexpr (ALIGN_EPI) { if (wr == 1) PG8_BAR; }
    }
    PG8_WAIT_V(0);
    if constexpr (!ALIGN_EPI) { if (wr == 0) PG8_BAR; }
    PG8_BAR;
    if constexpr (Epi::AFTER_DRAIN) { E.fused(acc, cur, wr, wc, fr, fq, lds, wid, lane); S.done(cur); }
#undef PG8_SA
#undef PG8_SB
#undef PG8_STAGE
#undef PG8_LDA
#undef PG8_LDB
#undef PG8_MMA
#undef PG8_WAIT_V
#undef PG8_WAIT_L
#undef PG8_BAR
#undef PG8_SCHED
}
}

#define LAS __attribute__((address_space(3)))
typedef unsigned short bf16_t;
typedef short bf16x8 __attribute__((ext_vector_type(8)));
typedef float f32x4 __attribute__((ext_vector_type(4)));
typedef unsigned u32x4 __attribute__((ext_vector_type(4)));
typedef unsigned u32x2 __attribute__((ext_vector_type(2)));

#ifndef GEMM_SP2
#define GEMM_SP2 true
#endif
#ifndef GEMM_ALIGN
#define GEMM_ALIGN true
#endif

constexpr int D = 1024, MLAT = 16384, MCTX = 512, MALL = 16896, HALFLAT = 8192;
constexpr int INC = 2592, INP = 2816, FF = 4096;
constexpr int K_OFF = 256, V_OFF = 512, G_OFF = 1024, R_OFF = 1056, CB_OFF = 1568, CC_OFF = 1824, CH_OFF = 2080, P_OFF = 2336;
constexpr int NPOS = 132, NMODV = 6144;
constexpr size_t PQ = 0, PK = PQ + (size_t)4 * MALL * 64, PV = PK + (size_t)4 * MALL * 64, PZ = PV + (size_t)4 * MALL * 128, PR = PZ + (size_t)MALL * 32,
                 PC = PR + (size_t)4 * MALL * 128, PP = PC + (size_t)MALL * 768;
static_assert(PP + (size_t)MALL * 256 == (size_t)MALL * INC, "PROJ segments");
constexpr float EPS = 1e-6f;
constexpr int NTHREADS = 512, NWAVES = 8;
constexpr int LDS_BYTES = 147456;
constexpr int NPHASES = 20;

constexpr size_t MiB = 1u << 20;
constexpr size_t WS_MOD = 0;
constexpr size_t WS_WIN = 1 * MiB;
constexpr size_t WS_WOUT = 12 * MiB;
constexpr size_t WS_W1 = 16 * MiB;
constexpr size_t WS_W2 = 32 * MiB;
constexpr size_t WS_XC = 48 * MiB;
constexpr size_t WS_X = 50 * MiB;
constexpr size_t WS_PROJ = 83 * MiB;
constexpr size_t WS_Y = 167 * MiB;
constexpr size_t WS_ACT = 83 * MiB;
constexpr size_t WS_S = 215 * MiB;
constexpr size_t WS_PART = 215 * MiB;
constexpr size_t WS_DEC = 248 * MiB;
constexpr size_t WS_BAR = 250 * MiB;
constexpr size_t BAR_BYTES = 16384;
constexpr size_t WS_END = 251 * MiB;

struct Args {
    const float* in[19];
    float* out;
    unsigned char* ws;
    int ph_lo, ph_hi;
};

__device__ __forceinline__ float bf2f(unsigned h) { return __uint_as_float(h << 16); }
__device__ __forceinline__ float bflo(unsigned w) { return __uint_as_float(w << 16); }
__device__ __forceinline__ float bfhi(unsigned w) { return __uint_as_float(w & 0xffff0000u); }
typedef __bf16 bf16v2_t __attribute__((ext_vector_type(2)));
typedef float f32v2_t __attribute__((ext_vector_type(2)));
__device__ __forceinline__ unsigned pk2(float lo, float hi) { const f32v2_t v = {lo, hi}; const bf16v2_t b = __builtin_convertvector(v, bf16v2_t); return __builtin_bit_cast(unsigned, b); }
__device__ __forceinline__ bf16_t f2bf(float f) { return (bf16_t)(pk2(f, 0.f) & 0xffffu); }
__device__ __forceinline__ float wave_sum(float v) {
#pragma unroll
    for (int o = 1; o < 64; o <<= 1) v += __shfl_xor(v, o);
    return v;
}
__device__ __forceinline__ float siluf(float x) { return x * __builtin_amdgcn_rcpf(1.0f + __builtin_amdgcn_exp2f(-1.4426950409f * x)); }
__device__ __forceinline__ int modvec_of_row(int row) { return row < HALFLAT ? 0 : (row < MLAT ? 1 : 2); }

struct EpiProj {
    static constexpr bool PERM = true, AFTER_DRAIN = false;
    bf16_t* O;
    __device__ __forceinline__ void operator()(const f32x4 (&acc)[2][2][4][2], const pg8::Unit& u, int wr, int wc, int fr, int fq) const {
        const int row0 = u.pm * 256 + wr * 64 + fr, colt = u.pn * 256;
#pragma unroll
        for (int bj = 0; bj < 2; ++bj) {
            const int cb = colt + bj * 128 + wc * 32;
            if (cb >= INC) continue;
            size_t off0; int pitch;
            if (cb < K_OFF)       { off0 = PQ + (size_t)(cb >> 6) * MALL * 64 + (cb & 63); pitch = 64; }
            else if (cb < V_OFF)  { const int c = cb - K_OFF;  off0 = PK + (size_t)(c >> 6) * MALL * 64 + (c & 63); pitch = 64; }
            else if (cb < G_OFF)  { const int c = cb - V_OFF;  off0 = PV + (size_t)(c >> 7) * MALL * 128 + (c & 127); pitch = 128; }
            else if (cb < R_OFF)  { off0 = PZ; pitch = 32; }
            else if (cb < CB_OFF) { const int c = cb - R_OFF;  off0 = PR + (size_t)(c >> 7) * MALL * 128 + (c & 127); pitch = 128; }
            else if (cb < P_OFF)  { off0 = PC + (cb - CB_OFF); pitch = 768; }
            else                  { off0 = PP + (cb - P_OFF); pitch = 256; }
            bf16_t* base = O + off0 + 8 * fq;
#pragma unroll
            for (int ai = 0; ai < 2; ++ai)
#pragma unroll
                for (int m = 0; m < 4; ++m) {
                    const f32x4 v0 = acc[ai][bj][m][0], v1 = acc[ai][bj][m][1];
                    u32x4 w; w.x = pk2(v0[0], v0[1]); w.y = pk2(v0[2], v0[3]); w.z = pk2(v1[0], v1[1]); w.w = pk2(v1[2], v1[3]);
                    *(u32x4*)(base + (size_t)(row0 + ai * 128 + m * 16) * pitch) = w;
                }
        }
    }
};
struct EpiAct {
    static constexpr bool PERM = true, AFTER_DRAIN = false;
    bf16_t* O;
    __device__ __forceinline__ void operator()(const f32x4 (&acc)[2][2][4][2], const pg8::Unit& u, int wr, int wc, int fr, int fq) const {
        const int row0 = u.pm * 256 + wr * 64 + fr, colt = u.pn * 256;
#pragma unroll
        for (int ai = 0; ai < 2; ++ai)
#pragma unroll
            for (int m = 0; m < 4; ++m) {
                bf16_t* rowp = O + (size_t)(row0 + ai * 128 + m * 16) * FF + colt + wc * 32 + 8 * fq;
#pragma unroll
                for (int bj = 0; bj < 2; ++bj) {
                    f32x4 v0 = acc[ai][bj][m][0], v1 = acc[ai][bj][m][1];
#pragma unroll
                    for (int j = 0; j < 4; ++j) { const float a = fmaxf(v0[j], 0.f), b = fmaxf(v1[j], 0.f); v0[j] = a * a; v1[j] = b * b; }
                    u32x4 w; w.x = pk2(v0[0], v0[1]); w.y = pk2(v0[2], v0[3]); w.z = pk2(v1[0], v1[1]); w.w = pk2(v1[2], v1[3]);
                    *(u32x4*)(rowp + bj * 128) = w;
                }
            }
    }
};
struct EpiRes {
    static constexpr bool PERM = true, AFTER_DRAIN = false;
    const float* xin_f32; bf16_t* X; float* part; const float* gate;
    __device__ __forceinline__ void operator()(const f32x4 (&acc)[2][2][4][2], const pg8::Unit& u, int wr, int wc, int fr, int fq) const {
        asm volatile("" ::: "memory");
        const int rbase = __builtin_amdgcn_readfirstlane(u.pm * 256), cbase = __builtin_amdgcn_readfirstlane(u.pn * 256);
        const unsigned c32 = (unsigned)(wc * 32 + 8 * fq), o32 = (unsigned)((wr * 64 + fr) * D) + c32;
        if (rbase < MLAT) {
            const float* gp = gate + (rbase < HALFLAT ? 0 : NMODV) + cbase;
            f32x4 gv[2][2];
#pragma unroll
            for (int bj = 0; bj < 2; ++bj)
#pragma unroll
                for (int n = 0; n < 2; ++n) gv[bj][n] = *(const f32x4*)(gp + c32 + bj * 128 + 4 * n);
            bf16_t* xo = X + (size_t)rbase * D + cbase;
            if (xin_f32) {
                const float* xi = xin_f32 + (size_t)rbase * D + cbase;
#pragma unroll
                for (int ai = 0; ai < 2; ++ai) {
                    f32x4 xv[4][2][2];
#pragma unroll
                    for (int m = 0; m < 4; ++m)
#pragma unroll
                        for (int bj = 0; bj < 2; ++bj)
#pragma unroll
                            for (int n = 0; n < 2; ++n) xv[m][bj][n] = *(const f32x4*)(xi + (size_t)(ai * 128 + m * 16) * D + o32 + bj * 128 + 4 * n);
#pragma unroll
                    for (int m = 0; m < 4; ++m)
#pragma unroll
                        for (int bj = 0; bj < 2; ++bj) {
                            const f32x4 y0 = xv[m][bj][0] + gv[bj][0] * acc[ai][bj][m][0], y1 = xv[m][bj][1] + gv[bj][1] * acc[ai][bj][m][1];
                            *(u32x4*)(xo + (size_t)(ai * 128 + m * 16) * D + o32 + bj * 128) = (u32x4){pk2(y0[0], y0[1]), pk2(y0[2], y0[3]), pk2(y1[0], y1[1]), pk2(y1[2], y1[3])};
                        }
                    asm volatile("" ::: "memory");
                }
            } else {
#pragma unroll
                for (int ai = 0; ai < 2; ++ai) {
                    u32x4 xb[4][2];
#pragma unroll
                    for (int m = 0; m < 4; ++m)
#pragma unroll
                        for (int bj = 0; bj < 2; ++bj) xb[m][bj] = *(const u32x4*)(xo + (size_t)(ai * 128 + m * 16) * D + o32 + bj * 128);
#pragma unroll
                    for (int m = 0; m < 4; ++m)
#pragma unroll
                        for (int bj = 0; bj < 2; ++bj) {
                            const u32x4 w = xb[m][bj];
                            const f32x4 x0 = (f32x4){bflo(w.x), bfhi(w.x), bflo(w.y), bfhi(w.y)}, x1 = (f32x4){bflo(w.z), bfhi(w.z), bflo(w.w), bfhi(w.w)};
                            const f32x4 y0 = x0 + gv[bj][0] * acc[ai][bj][m][0], y1 = x1 + gv[bj][1] * acc[ai][bj][m][1];
                            *(u32x4*)(xo + (size_t)(ai * 128 + m * 16) * D + o32 + bj * 128) = (u32x4){pk2(y0[0], y0[1]), pk2(y0[2], y0[3]), pk2(y1[0], y1[1]), pk2(y1[2], y1[3])};
                        }
                    asm volatile("" ::: "memory");
                }
            }
        } else {
            float* xo = part + ((size_t)(u.kofs >> 8) * MCTX + (size_t)(rbase - MLAT)) * D + cbase; const float* gp = gate + 2 * NMODV + cbase;
#pragma unroll
            for (int ai = 0; ai < 2; ++ai)
#pragma unroll
                for (int m = 0; m < 4; ++m) {
                    float* xw = xo + (size_t)(ai * 128 + m * 16) * D;
#pragma unroll
                    for (int bj = 0; bj < 2; ++bj)
#pragma unroll
                        for (int n = 0; n < 2; ++n) {
                            const f32x4 gv = *(const f32x4*)(gp + c32 + bj * 128 + 4 * n);
                            *(f32x4*)(xw + o32 + bj * 128 + 4 * n) = gv * acc[ai][bj][m][n];
                        }
                    asm volatile("" ::: "memory");
                }
        }
    }
};

__device__ __forceinline__ void transpose_item(const float* W, int N, bf16_t* WT, int ldt, LAS float* scr, int item, int lane) {
    const int nblk = N / 32, kb = item / nblk, nb = item % nblk, k0 = 64 * kb, n0 = 32 * nb;
#pragma unroll 8
    for (int i = 0; i < 32; ++i) { const int kk = 2 * i + (lane >> 5); scr[kk * 33 + (lane & 31)] = W[(size_t)(k0 + kk) * N + n0 + (lane & 31)]; }
    asm volatile("s_waitcnt lgkmcnt(0)" ::: "memory");
    const int c = lane & 7;
#pragma unroll
    for (int j = 0; j < 4; ++j) { const int n = (lane >> 3) + 8 * j; const LAS float* s = scr + (8 * c) * 33 + n;
        u32x4 o; o.x = pk2(s[0 * 33], s[1 * 33]); o.y = pk2(s[2 * 33], s[3 * 33]); o.z = pk2(s[4 * 33], s[5 * 33]); o.w = pk2(s[6 * 33], s[7 * 33]);
        *(u32x4*)(WT + (size_t)(n0 + n) * ldt + k0 + 8 * c) = o; }
    asm volatile("s_waitcnt lgkmcnt(0)" ::: "memory");
}

__device__ __forceinline__ void phase_prep(const Args& a, LAS unsigned char* lds) {
    const int tid = tid_opaque(), lane = tid & 63, wave = tid >> 6, G = gridDim.x;
    unsigned char* ws = a.ws;
    {
        LAS float* sc = (LAS float*)lds;
        LAS float* part = (LAS float*)(lds + 12288);
        bool have = false;
        for (int it = bid_opaque(); it < 192; it += G) {
            if (!have) {
                for (int i = tid; i < 3072; i += NTHREADS) { const int v = i >> 10, k = i & 1023; const float cv = v < 2 ? a.in[1][v * D + k] : a.in[3][k]; sc[i] = siluf(cv); }
                have = true; __syncthreads();
            }
            const int l = it / 96, cgp = it % 96, col = tid & 63, ks = tid >> 6;
            const float* W = a.in[4] + (size_t)l * D * NMODV + cgp * 64 + col;
            float a0 = 0.f, a1 = 0.f, a2 = 0.f;
#pragma unroll 32
            for (int k = ks * 128; k < ks * 128 + 128; ++k) { const float w = W[(size_t)k * NMODV]; a0 += sc[k] * w; a1 += sc[1024 + k] * w; a2 += sc[2048 + k] * w; }
            part[(ks * 3 + 0) * 64 + col] = a0; part[(ks * 3 + 1) * 64 + col] = a1; part[(ks * 3 + 2) * 64 + col] = a2;
            __syncthreads();
            if (tid < 192) { const int v = tid >> 6, c2 = tid & 63; float s = a.in[5][l * NMODV + cgp * 64 + c2];
#pragma unroll
                for (int q = 0; q < 8; ++q) s += part[(q * 3 + v) * 64 + c2];
                ((float*)(ws + WS_MOD))[(l * 3 + v) * NMODV + cgp * 64 + c2] = s; }
            __syncthreads();
        }
        __syncthreads();
    }
    {
        LAS float* scr = (LAS float*)(lds + wave * 16384);
        const int gw = bid_opaque() * NWAVES + wave, NGW = G * NWAVES;
        constexpr int I_IN = 16 * 81, I_OUT = 12 * 32, I_1 = 16 * 128, I_2 = 64 * 32, I_L = I_IN + I_OUT + I_1 + I_2;
        for (int it = gw; it < 2 * I_L; it += NGW) {
            const int l = it / I_L; int r = it % I_L;
            if (r < I_IN) { transpose_item(a.in[8] + (size_t)l * D * INC, INC, (bf16_t*)(ws + WS_WIN) + (size_t)l * INP * D, D, scr, r, lane); continue; } r -= I_IN;
            if (r < I_OUT) { transpose_item(a.in[15] + (size_t)l * D * D, D, (bf16_t*)(ws + WS_WOUT) + (size_t)l * D * D, D, scr, r, lane); continue; } r -= I_OUT;
            if (r < I_1) { transpose_item(a.in[16] + (size_t)l * D * FF, FF, (bf16_t*)(ws + WS_W1) + (size_t)l * FF * D, D, scr, r, lane); continue; } r -= I_1;
            transpose_item(a.in[17] + (size_t)l * FF * D, D, (bf16_t*)(ws + WS_W2) + (size_t)l * D * FF, FF, scr, r, lane);
        }
        for (int i = bid_opaque() * NTHREADS + tid; i < 2 * 224 * 128; i += G * NTHREADS) {
            const int l = i / (224 * 128), r = i % (224 * 128);
            *(u32x4*)((bf16_t*)(ws + WS_WIN) + (size_t)l * INP * D + (size_t)INC * D + (size_t)r * 8) = (u32x4){0u, 0u, 0u, 0u};
        }
    }
    {
        for (int i = bid_opaque() * NTHREADS + tid; i < 2 * 32 * 1024; i += G * NTHREADS) {
            const int l = i >> 15, r = i & 32767, n = r & 1023, kc8 = (r >> 10) * 8, g = kc8 >> 6, c0 = kc8 & 63;
            const float* pw = a.in[13] + ((size_t)(l * 4 + g) * 64 + c0) * 64;
            const float* sc = a.in[14] + l * 256 + g * 64;
            const float* wo = a.in[15] + (size_t)l * D * D + (size_t)(768 + g * 64) * D + n;
            float acc[8];
#pragma unroll
            for (int j = 0; j < 8; ++j) acc[j] = 0.f;
            for (int d = 0; d < 64; ++d) { const float w = wo[(size_t)d * D] * sc[d];
#pragma unroll
                for (int j = 0; j < 8; ++j) acc[j] += pw[j * 64 + d] * w; }
            u32x4 o; o.x = pk2(acc[0], acc[1]); o.y = pk2(acc[2], acc[3]); o.z = pk2(acc[4], acc[5]); o.w = pk2(acc[6], acc[7]);
            *(u32x4*)((bf16_t*)(ws + WS_WOUT) + (size_t)l * D * D + (size_t)n * D + 768 + kc8) = o;
        }
    }
}

__device__ __forceinline__ void load_row_f32(f32x4 (&v)[4], const float* p, int lane) {
#pragma unroll
    for (int j = 0; j < 2; ++j) { v[2 * j] = *(const f32x4*)(p + 8 * lane + 512 * j); v[2 * j + 1] = *(const f32x4*)(p + 8 * lane + 512 * j + 4); }
}
__device__ __forceinline__ void load_row_bf16(f32x4 (&v)[4], const bf16_t* p, int lane) {
#pragma unroll
    for (int j = 0; j < 2; ++j) { const u32x4 w = *(const u32x4*)(p + 8 * lane + 512 * j);
        v[2 * j] = (f32x4){bflo(w.x), bfhi(w.x), bflo(w.y), bfhi(w.y)}; v[2 * j + 1] = (f32x4){bflo(w.z), bfhi(w.z), bflo(w.w), bfhi(w.w)}; }
}
__device__ __forceinline__ float row_sumsq(const f32x4 (&v)[4]) {
    float s = 0.f;
#pragma unroll
    for (int j = 0; j < 4; ++j) s += (v[j].x * v[j].x + v[j].y * v[j].y) + (v[j].z * v[j].z + v[j].w * v[j].w);
    return s;
}
__device__ __forceinline__ void phase_norm(const float* xlat32, const bf16_t* X, const float* xctx, int nrows, const float* nw, const float* mod, int sh_off, int sc_off, bf16_t* H,
                                           const float* part, int npart, float* xc_store) {
    const int tid = tid_opaque(), lane = tid & 63, wave = tid >> 6;
    const int gw = bid_opaque() * NWAVES + wave, NGW = gridDim.x * NWAVES;
    int cur_v = -1; f32x4 aw[4], shv[4];
#pragma unroll
    for (int j = 0; j < 4; ++j) { aw[j] = (f32x4){0.f, 0.f, 0.f, 0.f}; shv[j] = aw[j]; }
    for (int r = gw; r < nrows; r += 2 * NGW) {
        const int rowA = nrows - 1 - r, rowB0 = rowA - NGW;
        const bool hasB = rowB0 >= 0; const int rowB = hasB ? rowB0 : rowA;
        f32x4 va[4], vb[4];
        if (rowA >= MLAT) load_row_f32(va, xctx + (size_t)(rowA - MLAT) * D, lane);
        else if (xlat32) load_row_f32(va, xlat32 + (size_t)rowA * D, lane);
        else load_row_bf16(va, X + (size_t)rowA * D, lane);
        if (rowB >= MLAT) load_row_f32(vb, xctx + (size_t)(rowB - MLAT) * D, lane);
        else if (xlat32) load_row_f32(vb, xlat32 + (size_t)rowB * D, lane);
        else load_row_bf16(vb, X + (size_t)rowB * D, lane);
        if (rowA >= MLAT && npart > 0) {
            const float* pr = part + (size_t)(rowA - MLAT) * D;
            for (int k = 0; k < npart; k += 2) {
                f32x4 t0[4], t1[4];
                load_row_f32(t0, pr + (size_t)k * MCTX * D, lane); load_row_f32(t1, pr + (size_t)(k + 1) * MCTX * D, lane);
#pragma unroll
                for (int j = 0; j < 4; ++j) va[j] += t0[j] + t1[j];
            }
            float* xs = xc_store + (size_t)(rowA - MLAT) * D;
#pragma unroll
            for (int j = 0; j < 2; ++j) { *(f32x4*)(xs + 8 * lane + 512 * j) = va[2 * j]; *(f32x4*)(xs + 8 * lane + 512 * j + 4) = va[2 * j + 1]; }
        }
        float sa = row_sumsq(va), sb = row_sumsq(vb);
#pragma unroll
        for (int o = 1; o < 64; o <<= 1) { sa += __shfl_xor(sa, o); sb += __shfl_xor(sb, o); }
        const float ra = rsqrtf(sa * (1.0f / D) + EPS), rb = rsqrtf(sb * (1.0f / D) + EPS);
#pragma unroll 1
        for (int which = 0; which < 2; ++which) {
            if (which == 1 && !hasB) break;
            const int row = which ? rowB : rowA; const float rstd = which ? rb : ra;
            const int v = modvec_of_row(row);
            if (v != cur_v) {
                const float* mv = mod + v * NMODV;
#pragma unroll
                for (int j = 0; j < 4; ++j) { const int c = 8 * lane + 512 * (j >> 1) + 4 * (j & 1); aw[j] = *(const f32x4*)(nw + c) * (*(const f32x4*)(mv + sc_off + c) + 1.0f); shv[j] = *(const f32x4*)(mv + sh_off + c); }
                cur_v = v;
            }
#pragma unroll
            for (int j = 0; j < 2; ++j) {
                const f32x4 y0 = ((which ? vb[2 * j] : va[2 * j]) * rstd) * aw[2 * j] + shv[2 * j], y1 = ((which ? vb[2 * j + 1] : va[2 * j + 1]) * rstd) * aw[2 * j + 1] + shv[2 * j + 1];
                *(u32x4*)(H + (size_t)row * D + 8 * lane + 512 * j) = (u32x4){pk2(y0.x, y0.y), pk2(y0.z, y0.w), pk2(y1.x, y1.y), pk2(y1.z, y1.w)};
            }
        }
    }
}
__device__ __forceinline__ void phase_final(const bf16_t* X, float* out, const float* nw) {
    const int tid = tid_opaque(), lane = tid & 63, wave = tid >> 6;
    const int gw = bid_opaque() * NWAVES + wave, NGW = gridDim.x * NWAVES;
    f32x4 w[4];
    load_row_f32(w, nw, lane);
    for (int row = gw; row < MLAT; row += 2 * NGW) {
        const bool hasB = row + NGW < MLAT; const int rowB = hasB ? row + NGW : row;
        f32x4 va[4], vb[4];
        load_row_bf16(va, X + (size_t)row * D, lane); load_row_bf16(vb, X + (size_t)rowB * D, lane);
        float sa = row_sumsq(va), sb = row_sumsq(vb);
#pragma unroll
        for (int o = 1; o < 64; o <<= 1) { sa += __shfl_xor(sa, o); sb += __shfl_xor(sb, o); }
        const float ra = rsqrtf(sa * (1.0f / D) + EPS), rb = rsqrtf(sb * (1.0f / D) + EPS);
        float* oa = out + (size_t)row * D; float* ob = out + (size_t)rowB * D;
#pragma unroll
        for (int j = 0; j < 2; ++j) { *(f32x4*)(oa + 8 * lane + 512 * j) = (va[2 * j] * ra) * w[2 * j]; *(f32x4*)(oa + 8 * lane + 512 * j + 4) = (va[2 * j + 1] * ra) * w[2 * j + 1]; }
        if (hasB) {
#pragma unroll
            for (int j = 0; j < 2; ++j) { *(f32x4*)(ob + 8 * lane + 512 * j) = (vb[2 * j] * rb) * w[2 * j]; *(f32x4*)(ob + 8 * lane + 512 * j + 4) = (vb[2 * j + 1] * rb) * w[2 * j + 1]; }
        }
    }
}

constexpr int L_ZS = 0, L_GW = 8192, L_GB = 16384, L_SEG = 16896;
constexpr int BPITCH = 68;
constexpr int L_BF = 21504, L_BB = L_BF + 64 * BPITCH * 4;
constexpr int L_QEF = 56320, L_QEB = L_QEF + 9216, L_KIF = L_QEB + 9216, L_KIB = L_KIF + 9216, L_VT = L_KIB + 9216, L_PF = L_VT + 18432, L_PB = L_PF + 9216;
constexpr int PITCH = 72;
static_assert(L_PB + 9216 <= 131072, "GLA LDS map");

struct ChunkInfo { int r0, b, posf, posb, seg_lo, seg_hi; };
__device__ __forceinline__ ChunkInfo chunk_info(int cidx) {
    ChunkInfo ci;
    if (cidx < 256) { ci.b = cidx >> 7; const int c = cidx & 127; ci.r0 = cidx * 64; ci.posf = 4 + c; ci.posb = 4 + (127 - c); ci.seg_lo = ci.r0; ci.seg_hi = ci.r0 + 64; }
    else { const int cc = cidx - 256; ci.b = cc >> 2; const int j = cc & 3; ci.r0 = MLAT + cc * 64; ci.posf = j; ci.posb = 3 - j; ci.seg_lo = MLAT + ci.b * 256; ci.seg_hi = ci.seg_lo + 256; }
    return ci;
}
__device__ __forceinline__ float pick8(const f32x4& a, const f32x4& b, int i) { return i < 4 ? a[i & 3] : b[i & 3]; }
__device__ __forceinline__ float logsigmoidf(float x) { return fminf(x, 0.f) - 0.6931471806f * __builtin_amdgcn_logf(1.0f + __builtin_amdgcn_exp2f(-1.4426950409f * fabsf(x))); }

struct GFirst { u32x4 zf[4]; u32x4 k, q, v0, v1; };
__device__ __forceinline__ void gla_load_a(GFirst& R, const bf16_t* proj, int r0, int tid) {
    const int fr = tid & 15, fq = (tid >> 4) & 3;
#pragma unroll
    for (int tt = 0; tt < 4; ++tt) R.zf[tt] = *(const u32x4*)(proj + PZ + (size_t)(r0 + 16 * tt + fr) * 32 + 8 * fq);
}
struct GateConst { bf16x8 bfrag; float gbias; int h; };
__device__ __forceinline__ void gate_const(GateConst& gc, const float* gate_w, const float* gate_b, int h, int tid) {
    const int fr = tid & 15, fq = (tid >> 4) & 3, w = tid >> 6, d = w >> 2, n = h * 64 + (w & 3) * 16 + fr;
    float v[8];
#pragma unroll
    for (int j = 0; j < 8; ++j) v[j] = 0.f;
    if ((fq >> 1) == d) {
        const unsigned o = (unsigned)((d * 16 + 8 * (fq & 1)) * 256 + n);
#pragma unroll
        for (int j = 0; j < 8; ++j) v[j] = gate_w[o + (unsigned)(j * 256)];
    }
    const u32x4 p = (u32x4){pk2(v[0], v[1]), pk2(v[2], v[3]), pk2(v[4], v[5]), pk2(v[6], v[7])};
    gc.bfrag = __builtin_bit_cast(bf16x8, p);
    gc.gbias = gate_b[d * 256 + n]; gc.h = h;
}
template <bool WITH_Q>
__device__ __forceinline__ void gla_load_b(GFirst& R, const bf16_t* proj, int r0, int h, int tid) {
    const int t = tid & 63, cg = tid >> 6;
    const size_t hr = (size_t)h * MALL + (size_t)(r0 + t);
    R.k = *(const u32x4*)(proj + PK + hr * 64 + cg * 8);
    if (WITH_Q) R.q = *(const u32x4*)(proj + PQ + hr * 64 + cg * 8);
    R.v0 = *(const u32x4*)(proj + PV + hr * 128 + cg * 8);
    R.v1 = *(const u32x4*)(proj + PV + hr * 128 + 64 + cg * 8);
}
template <bool WITH_Q>
__device__ __forceinline__ void gla_load_first(GFirst& R, const bf16_t* proj, int r0, int h, int tid) {
    gla_load_a(R, proj, r0, tid); gla_load_b<WITH_Q>(R, proj, r0, h, tid);
}

__device__ __forceinline__ void gla_gates(const GFirst& R, const GateConst& gc, LAS unsigned char* lds, int tid) {
    const int lane = tid & 63, fr = lane & 15, fq = lane >> 4, w = tid >> 6, d = w >> 2, j = (w & 3) * 16 + fr;
    LAS float* BX = (LAS float*)(lds + (d ? L_BB : L_BF));
    float g[4][4];
#pragma unroll
    for (int tt = 0; tt < 4; ++tt) {
        const f32x4 acc = __builtin_amdgcn_mfma_f32_16x16x32_bf16(__builtin_bit_cast(bf16x8, R.zf[tt]), gc.bfrag, (f32x4){0.f, 0.f, 0.f, 0.f}, 0, 0, 0);
#pragma unroll
        for (int r = 0; r < 4; ++r) g[tt][r] = logsigmoidf(acc[r] + gc.gbias) * (1.0f / 16.0f);
    }
    if (d == 0) {
        float off = 0.f;
#pragma unroll
        for (int tt = 0; tt < 4; ++tt) {
            const float p0 = g[tt][0], p1 = p0 + g[tt][1], p2 = p1 + g[tt][2], p3 = p2 + g[tt][3];
            float s = p3; float v = __shfl(s, (lane - 16) & 63); s += fq >= 1 ? v : 0.f; v = __shfl(s, (lane - 32) & 63); s += fq >= 2 ? v : 0.f;
            const float e = off + (s - p3), tot = __shfl(s, 48 + fr);
            LAS float* bp = BX + (16 * tt + 4 * fq) * BPITCH + j;
            bp[0] = e + p0; bp[BPITCH] = e + p1; bp[2 * BPITCH] = e + p2; bp[3 * BPITCH] = e + p3;
            off += tot;
        }
    } else {
        float off = 0.f;
#pragma unroll
        for (int tt = 3; tt >= 0; --tt) {
            const float s3 = g[tt][3], s2 = s3 + g[tt][2], s1 = s2 + g[tt][1], s0 = s1 + g[tt][0];
            float s = s0; float v = __shfl(s, (lane + 16) & 63); s += fq <= 2 ? v : 0.f; v = __shfl(s, (lane + 32) & 63); s += fq <= 1 ? v : 0.f;
            const float e = off + (s - s0), tot = __shfl(s, fr);
            LAS float* bp = BX + (16 * tt + 4 * fq) * BPITCH + j;
            bp[0] = e + s0; bp[BPITCH] = e + s1; bp[2 * BPITCH] = e + s2; bp[3 * BPITCH] = e + s3;
            off += tot;
        }
    }
    __syncthreads();
}
__device__ __forceinline__ void gla_write_vt(const GFirst& R, LAS unsigned char* lds, int tid) {
    LAS bf16_t* VT = (LAS bf16_t*)(lds + L_VT); const int t = tid & 63, cg = tid >> 6;
    const unsigned a[4] = {R.v0.x, R.v0.y, R.v0.z, R.v0.w}, b[4] = {R.v1.x, R.v1.y, R.v1.z, R.v1.w};
#pragma unroll
    for (int i = 0; i < 4; ++i) {
        VT[(cg * 8 + 2 * i) * PITCH + t] = (bf16_t)(a[i] & 0xffffu); VT[(cg * 8 + 2 * i + 1) * PITCH + t] = (bf16_t)(a[i] >> 16);
        VT[(64 + cg * 8 + 2 * i) * PITCH + t] = (bf16_t)(b[i] & 0xffffu); VT[(64 + cg * 8 + 2 * i + 1) * PITCH + t] = (bf16_t)(b[i] >> 16);
    }
}

__device__ __forceinline__ void phase_gla_u(const Args& a, int l, LAS unsigned char* lds) {
    const int tid = tid_opaque(), lane = tid & 63, wave = tid >> 6;
    const bf16_t* proj = (const bf16_t*)(a.ws + WS_PROJ);
    bf16_t* U = (bf16_t*)a.out; float* DEC = (float*)(a.ws + WS_DEC);
    const float* gate_w = a.in[9] + (size_t)l * 2 * 16 * 256; const float* gate_b = a.in[10] + (size_t)l * 2 * 256;
    LAS float* BF = (LAS float*)(lds + L_BF); LAS float* BB = (LAS float*)(lds + L_BB);
    LAS bf16_t* KTF = (LAS bf16_t*)(lds + L_QEF); LAS bf16_t* KTB = (LAS bf16_t*)(lds + L_QEB); LAS bf16_t* VT = (LAS bf16_t*)(lds + L_VT);
    constexpr int NIT = 264 * 4;
    GFirst R; GateConst gc; gc.h = -1;
    if (bid_opaque() < NIT) { const ChunkInfo c0 = chunk_info(bid_opaque() >> 2); gla_load_first<false>(R, proj, c0.r0, bid_opaque() & 3, tid); }
#pragma unroll 1
    for (int it = bid_opaque(); it < NIT; it += gridDim.x) {
        const int cidx = it >> 2, h = it & 3; const ChunkInfo ci = chunk_info(cidx);
        const int itn = it + gridDim.x; const ChunkInfo cn = chunk_info((itn < NIT ? itn : it) >> 2);
        if (gc.h != h) gate_const(gc, gate_w, gate_b, h, tid);
        GFirst Rn;
#pragma unroll
        for (int tt = 0; tt < 4; ++tt) Rn.zf[tt] = R.zf[tt];
        if (itn < NIT) gla_load_a(Rn, proj, cn.r0, tid);
        gla_gates(R, gc, lds, tid);
        { const int t = tid & 63, cg = tid >> 6;
          const unsigned ww[4] = {R.k.x, R.k.y, R.k.z, R.k.w};
          const f32x4 bfa = *(const LAS f32x4*)(BF + t * BPITCH + cg * 8), bfb = *(const LAS f32x4*)(BF + t * BPITCH + cg * 8 + 4);
          const f32x4 bba = *(const LAS f32x4*)(BB + t * BPITCH + cg * 8), bbb = *(const LAS f32x4*)(BB + t * BPITCH + cg * 8 + 4);
          const f32x4 fla = *(const LAS f32x4*)(BF + 63 * BPITCH + cg * 8), flb = *(const LAS f32x4*)(BF + 63 * BPITCH + cg * 8 + 4);
          const f32x4 b0a = *(const LAS f32x4*)(BB + cg * 8), b0b = *(const LAS f32x4*)(BB + cg * 8 + 4);
#pragma unroll
          for (int i = 0; i < 8; ++i) { const int dk = cg * 8 + i; const float kf = (i & 1) ? bfhi(ww[i >> 1]) : bflo(ww[i >> 1]);
              KTF[dk * PITCH + t] = f2bf(kf * __expf(pick8(fla, flb, i) - pick8(bfa, bfb, i)));
              KTB[dk * PITCH + t] = f2bf(kf * __expf(pick8(b0a, b0b, i) - pick8(bba, bbb, i))); } }
        gla_write_vt(R, lds, tid);
        if (tid < 128) { const int d = tid >> 6, j = tid & 63;
            DEC[((size_t)((ci.b * 4 + h) * 2 + d) * NPOS + (d ? ci.posb : ci.posf)) * 64 + j] = __expf(d ? BB[j] : BF[63 * BPITCH + j]); }
        if (itn < NIT) gla_load_b<false>(R, proj, cn.r0, itn & 3, tid);
        __syncthreads();
        {
            const int dir = wave >> 2, jv = (wave & 3) * 32, fr = lane & 15, fq = lane >> 4;
            const LAS bf16_t* KT = dir ? KTB : KTF;
            bf16x8 af[4][2], bfr[2][2];
#pragma unroll
            for (int i = 0; i < 4; ++i)
#pragma unroll
                for (int ks = 0; ks < 2; ++ks) af[i][ks] = *(const LAS bf16x8*)(KT + (i * 16 + fr) * PITCH + ks * 32 + 8 * fq);
#pragma unroll
            for (int jt = 0; jt < 2; ++jt)
#pragma unroll
                for (int ks = 0; ks < 2; ++ks) bfr[jt][ks] = *(const LAS bf16x8*)(VT + (jv + jt * 16 + fr) * PITCH + ks * 32 + 8 * fq);
            bf16_t* Ub = U + ((size_t)((ci.b * 4 + h) * 2 + dir) * NPOS + (dir ? ci.posb : ci.posf)) * 8192 + (size_t)jv * 64;
            LAS unsigned char* wst = lds + (wave < 4 ? wave * 4608 : L_KIF + (wave - 4) * 4608);
#pragma unroll
            for (int i = 0; i < 4; ++i)
#pragma unroll
                for (int jt = 0; jt < 2; ++jt) {
                    f32x4 acc = (f32x4){0.f, 0.f, 0.f, 0.f};
#pragma unroll
                    for (int ks = 0; ks < 2; ++ks) acc = __builtin_amdgcn_mfma_f32_16x16x32_bf16(af[i][ks], bfr[jt][ks], acc, 0, 0, 0);
                    u32x2 o; o.x = pk2(acc[0], acc[1]); o.y = pk2(acc[2], acc[3]);
                    *(LAS u32x2*)(wst + (jt * 16 + fr) * 144 + (i * 16 + 4 * fq) * 2) = o;
                }
#pragma unroll
            for (int c4 = 0; c4 < 4; ++c4) {
                const int c = c4 * 64 + lane, row = c >> 3, piece = c & 7;
                const u32x4 w = *(const LAS u32x4*)(wst + row * 144 + piece * 16);
                *(u32x4*)(Ub + (size_t)c * 8) = w;
            }
        }
#pragma unroll
        for (int tt = 0; tt < 4; ++tt) R.zf[tt] = Rn.zf[tt];
    }
}

__device__ __forceinline__ void phase_gla_scan(const Args& a, LAS unsigned char* lds) {
    const unsigned* U = (const unsigned*)a.out; unsigned* S = (unsigned*)(a.ws + WS_S); const float* DEC = (const float*)(a.ws + WS_DEC);
    constexpr int SEGL = NPOS / 4;
    const int tid = tid_opaque(), lane = tid & 63, wave = tid >> 6, seg = wave & 3, grp = wave >> 2;
    LAS float* X = (LAS float*)lds;
    for (int bi = bid_opaque(); bi < 16 * 4096 / 128; bi += gridDim.x) {
        const int pidx = bi * 128 + grp * 64 + lane, seq = pidx >> 12, e2 = pidx & 4095, dk = (e2 * 2) & 63, pl = grp * 64 + lane;
        const unsigned* up = U + ((size_t)seq * NPOS + seg * SEGL) * 4096 + e2; unsigned* sp = S + ((size_t)seq * NPOS + seg * SEGL) * 4096 + e2;
        const float* dp = DEC + ((size_t)seq * NPOS + seg * SEGL) * 64 + dk;
        unsigned u[SEGL]; float d0[SEGL], d1[SEGL];
#pragma unroll
        for (int i = 0; i < SEGL; ++i) { u[i] = up[(size_t)i * 4096]; const float2 dd = *(const float2*)(dp + i * 64); d0[i] = dd.x; d1[i] = dd.y; }
        float s0 = 0.f, s1 = 0.f, c0 = 1.f, c1 = 1.f;
#pragma unroll
        for (int i = 0; i < SEGL; ++i) { s0 = d0[i] * s0 + bflo(u[i]); s1 = d1[i] * s1 + bfhi(u[i]); c0 *= d0[i]; c1 *= d1[i]; }
        X[(0 * 4 + seg) * 128 + pl] = s0; X[(1 * 4 + seg) * 128 + pl] = s1; X[(2 * 4 + seg) * 128 + pl] = c0; X[(3 * 4 + seg) * 128 + pl] = c1;
        __syncthreads();
        float k0 = 0.f, k1 = 0.f;
#pragma unroll
        for (int k = 0; k < 3; ++k) {
            if (k < seg) { k0 = X[(2 * 4 + k) * 128 + pl] * k0 + X[(0 * 4 + k) * 128 + pl]; k1 = X[(3 * 4 + k) * 128 + pl] * k1 + X[(1 * 4 + k) * 128 + pl]; }
        }
        s0 = k0; s1 = k1;
#pragma unroll
        for (int i = 0; i < SEGL; ++i) { sp[(size_t)i * 4096] = pk2(s0, s1); s0 = d0[i] * s0 + bflo(u[i]); s1 = d1[i] * s1 + bfhi(u[i]); }
        __syncthreads();
    }
}

template <int HALF>
__device__ __forceinline__ void pool_rows(const bf16_t* proj, bf16_t* Y, int c0, int t0, int seg_lo, int seg_hi) {
    constexpr int NR = 2 * HALF + 3;
    u32x4 uw[NR];
#pragma unroll
    for (int j = 0; j < NR; ++j) { const int rc = min(max(t0 - HALF + j, seg_lo), seg_hi - 1); uw[j] = *(const u32x4*)(proj + PP + (size_t)rc * 256 + c0); }
    float sm[8];
#pragma unroll
    for (int i = 0; i < 8; ++i) sm[i] = 0.f;
#pragma unroll
    for (int j = 0; j < NR; ++j) {
        const int rr = t0 - HALF + j; const bool inseg = rr >= seg_lo && rr < seg_hi;
        const unsigned uu[4] = {uw[j].x, uw[j].y, uw[j].z, uw[j].w};
        float uv[8];
#pragma unroll
        for (int i = 0; i < 4; ++i) { uv[2 * i] = inseg ? bflo(uu[i]) : 0.f; uv[2 * i + 1] = inseg ? bfhi(uu[i]) : 0.f; }
#pragma unroll
        for (int i = 0; i < 8; ++i) sm[i] += uv[i];
        if (j >= 2 * HALF - 1) {
            const int tt = j - (2 * HALF - 1), tk = t0 + tt, lo = max(tk - HALF, seg_lo), hi = min(tk + HALF, seg_hi);
            const float inv = 1.0f / (float)(hi - lo);
            const unsigned su[4] = {uw[HALF + tt].x, uw[HALF + tt].y, uw[HALF + tt].z, uw[HALF + tt].w};
            float pp[8];
#pragma unroll
            for (int i = 0; i < 8; ++i) pp[i] = sm[i] * inv - ((i & 1) ? bfhi(su[i >> 1]) : bflo(su[i >> 1]));
            *(u32x4*)(Y + (size_t)tk * D + 768 + c0) = (u32x4){pk2(pp[0], pp[1]), pk2(pp[2], pp[3]), pk2(pp[4], pp[5]), pk2(pp[6], pp[7])};
            const int jl = tt; const int rl = t0 - HALF + jl; const bool insl = rl >= seg_lo && rl < seg_hi;
            const unsigned ul[4] = {uw[jl].x, uw[jl].y, uw[jl].z, uw[jl].w};
#pragma unroll
            for (int i = 0; i < 4; ++i) { sm[2 * i] -= insl ? bflo(ul[i]) : 0.f; sm[2 * i + 1] -= insl ? bfhi(ul[i]) : 0.f; }
        }
    }
}

__device__ __forceinline__ void phase_gla_out(const Args& a, int l, int nchunks, LAS unsigned char* lds) {
    const int tid = tid_opaque(), lane = tid & 63, wave = tid >> 6, fr = lane & 15, fq = lane >> 4;
    const bf16_t* proj = (const bf16_t*)(a.ws + WS_PROJ);
    const bf16_t* S = (const bf16_t*)(a.ws + WS_S); bf16_t* Y = (bf16_t*)(a.ws + WS_Y);
    const float* gate_w = a.in[9] + (size_t)l * 2 * 16 * 256; const float* gate_b = a.in[10] + (size_t)l * 2 * 256;
    const float* gnw = a.in[11] + l * 128; const float* conv_w = a.in[12] + l * 3 * 256;
    LAS float* BF = (LAS float*)(lds + L_BF); LAS float* BB = (LAS float*)(lds + L_BB); LAS float* SSX = (LAS float*)(lds + L_SEG);
    LAS bf16_t* QEF = (LAS bf16_t*)(lds + L_QEF); LAS bf16_t* QEB = (LAS bf16_t*)(lds + L_QEB);
    LAS bf16_t* KIF = (LAS bf16_t*)(lds + L_KIF); LAS bf16_t* KIB = (LAS bf16_t*)(lds + L_KIB);
    LAS bf16_t* VT = (LAS bf16_t*)(lds + L_VT); LAS bf16_t* PF = (LAS bf16_t*)(lds + L_PF); LAS bf16_t* PB = (LAS bf16_t*)(lds + L_PB);
    const int n_gla = nchunks * 4;
    GFirst R; GateConst gc; gc.h = -1;
    if (bid_opaque() < n_gla) { const ChunkInfo c0 = chunk_info(bid_opaque() >> 2); gla_load_first<true>(R, proj, c0.r0, bid_opaque() & 3, tid); }
#pragma unroll 1
    for (int it = bid_opaque(); it < n_gla + nchunks; it += gridDim.x) {
        if (it < n_gla) {
            const int cidx = it >> 2, h = it & 3; const ChunkInfo ci = chunk_info(cidx);
            const int tt = wave & 3, trow = tt * 16 + fr;
            const int dvr = wave * 16 + fr;
            bf16x8 sfa[2], sba[2]; u32x2 rw[4];
            {
                const bf16_t* Sf = S + ((size_t)((ci.b * 4 + h) * 2 + 0) * NPOS + ci.posf) * 8192;
                const bf16_t* Sb = S + ((size_t)((ci.b * 4 + h) * 2 + 1) * NPOS + ci.posb) * 8192;
#pragma unroll
                for (int ks = 0; ks < 2; ++ks) { sfa[ks] = *(const bf16x8*)(Sf + (size_t)dvr * 64 + ks * 32 + 8 * fq); sba[ks] = *(const bf16x8*)(Sb + (size_t)dvr * 64 + ks * 32 + 8 * fq); }
#pragma unroll
                for (int t4 = 0; t4 < 4; ++t4) rw[t4] = *(const u32x2*)(proj + PR + ((size_t)h * MALL + (size_t)(ci.r0 + t4 * 16 + fr)) * 128 + wave * 16 + 4 * fq);
            }
            const int itn = it + gridDim.x; const ChunkInfo cn = chunk_info((itn < n_gla ? itn : it) >> 2);
            if (gc.h != h) gate_const(gc, gate_w, gate_b, h, tid);
            GFirst Rn;
#pragma unroll
            for (int tt = 0; tt < 4; ++tt) Rn.zf[tt] = R.zf[tt];
            if (itn < n_gla) gla_load_a(Rn, proj, cn.r0, tid);
            gla_gates(R, gc, lds, tid);
            { const int t = tid & 63, cg = tid >> 6;
              const unsigned qq[4] = {R.q.x, R.q.y, R.q.z, R.q.w}, kk[4] = {R.k.x, R.k.y, R.k.z, R.k.w};
              const f32x4 bfa = *(const LAS f32x4*)(BF + t * BPITCH + cg * 8), bfb = *(const LAS f32x4*)(BF + t * BPITCH + cg * 8 + 4);
              const f32x4 bba = *(const LAS f32x4*)(BB + t * BPITCH + cg * 8), bbb = *(const LAS f32x4*)(BB + t * BPITCH + cg * 8 + 4);
              unsigned oqf[4], oqb[4], okf[4], okb[4];
#pragma unroll
              for (int i = 0; i < 4; ++i) {
                  const float ef0 = __expf(pick8(bfa, bfb, 2 * i)), ef1 = __expf(pick8(bfa, bfb, 2 * i + 1)), eb0 = __expf(pick8(bba, bbb, 2 * i)), eb1 = __expf(pick8(bba, bbb, 2 * i + 1));
                  const float q0 = bflo(qq[i]) * 0.125f, q1 = bfhi(qq[i]) * 0.125f, k0 = bflo(kk[i]), k1 = bfhi(kk[i]);
                  oqf[i] = pk2(q0 * ef0, q1 * ef1); oqb[i] = pk2(q0 * eb0, q1 * eb1);
                  okf[i] = pk2(k0 * __builtin_amdgcn_rcpf(ef0), k1 * __builtin_amdgcn_rcpf(ef1)); okb[i] = pk2(k0 * __builtin_amdgcn_rcpf(eb0), k1 * __builtin_amdgcn_rcpf(eb1));
              }
              *(LAS u32x4*)(QEF + t * PITCH + cg * 8) = (u32x4){oqf[0], oqf[1], oqf[2], oqf[3]};
              *(LAS u32x4*)(QEB + t * PITCH + cg * 8) = (u32x4){oqb[0], oqb[1], oqb[2], oqb[3]};
              *(LAS u32x4*)(KIF + t * PITCH + cg * 8) = (u32x4){okf[0], okf[1], okf[2], okf[3]};
              *(LAS u32x4*)(KIB + t * PITCH + cg * 8) = (u32x4){okb[0], okb[1], okb[2], okb[3]}; }
            gla_write_vt(R, lds, tid);
            if (itn < n_gla) gla_load_b<true>(R, proj, cn.r0, itn & 3, tid);
            __syncthreads();
            {
                const int dir = wave >> 2;
                const LAS bf16_t* KI = dir ? KIB : KIF; const LAS bf16_t* QE = dir ? QEB : QEF; LAS bf16_t* P = dir ? PB : PF;
                bf16x8 qb[2];
#pragma unroll
                for (int ks = 0; ks < 2; ++ks) qb[ks] = *(const LAS bf16x8*)(QE + trow * PITCH + ks * 32 + 8 * fq);
#pragma unroll
                for (int st = 0; st < 4; ++st) {
                    f32x4 acc = (f32x4){0.f, 0.f, 0.f, 0.f};
#pragma unroll
                    for (int ks = 0; ks < 2; ++ks) { const bf16x8 ka = *(const LAS bf16x8*)(KI + (st * 16 + fr) * PITCH + ks * 32 + 8 * fq);
                        acc = __builtin_amdgcn_mfma_f32_16x16x32_bf16(ka, qb[ks], acc, 0, 0, 0); }
                    const int s0 = st * 16 + 4 * fq;
#pragma unroll
                    for (int r = 0; r < 4; ++r) { const int s = s0 + r; const bool keep = dir ? (s >= trow) : (s <= trow); acc[r] = keep ? acc[r] : 0.f; }
                    u32x2 o; o.x = pk2(acc[0], acc[1]); o.y = pk2(acc[2], acc[3]);
                    *(LAS u32x2*)(P + trow * PITCH + s0) = o;
                }
            }
            __syncthreads();
            {
                f32x4 acc[4];
#pragma unroll
                for (int t4 = 0; t4 < 4; ++t4) acc[t4] = (f32x4){0.f, 0.f, 0.f, 0.f};
#pragma unroll
                for (int ks = 0; ks < 2; ++ks) {
                    const bf16x8 va = *(const LAS bf16x8*)(VT + dvr * PITCH + ks * 32 + 8 * fq);
#pragma unroll
                    for (int t4 = 0; t4 < 4; ++t4) {
                        const int tr = t4 * 16 + fr;
                        const bf16x8 pf = *(const LAS bf16x8*)(PF + tr * PITCH + ks * 32 + 8 * fq), pb = *(const LAS bf16x8*)(PB + tr * PITCH + ks * 32 + 8 * fq);
                        const bf16x8 qf = *(const LAS bf16x8*)(QEF + tr * PITCH + ks * 32 + 8 * fq), qb = *(const LAS bf16x8*)(QEB + tr * PITCH + ks * 32 + 8 * fq);
                        acc[t4] = __builtin_amdgcn_mfma_f32_16x16x32_bf16(va, pf, acc[t4], 0, 0, 0);
                        acc[t4] = __builtin_amdgcn_mfma_f32_16x16x32_bf16(va, pb, acc[t4], 0, 0, 0);
                        acc[t4] = __builtin_amdgcn_mfma_f32_16x16x32_bf16(sfa[ks], qf, acc[t4], 0, 0, 0);
                        acc[t4] = __builtin_amdgcn_mfma_f32_16x16x32_bf16(sba[ks], qb, acc[t4], 0, 0, 0);
                    }
                }
#pragma unroll
                for (int t4 = 0; t4 < 4; ++t4) {
                    float ss = (acc[t4][0] * acc[t4][0] + acc[t4][1] * acc[t4][1]) + (acc[t4][2] * acc[t4][2] + acc[t4][3] * acc[t4][3]);
                    ss += __shfl_xor(ss, 16); ss += __shfl_xor(ss, 32);
                    if (fq == 0) SSX[wave * 64 + t4 * 16 + fr] = ss;
                }
                __syncthreads();
                const f32x4 nw = *(const f32x4*)(gnw + wave * 16 + 4 * fq);
#pragma unroll
                for (int t4 = 0; t4 < 4; ++t4) {
                    const int tr = t4 * 16 + fr;
                    float tot = 0.f;
#pragma unroll
                    for (int w8 = 0; w8 < 8; ++w8) tot += SSX[w8 * 64 + tr];
                    const float rs = rsqrtf(tot * (1.0f / 128.0f) + EPS);
                    const float y0 = acc[t4][0] * rs * nw.x * siluf(bflo(rw[t4].x)), y1 = acc[t4][1] * rs * nw.y * siluf(bfhi(rw[t4].x));
                    const float y2 = acc[t4][2] * rs * nw.z * siluf(bflo(rw[t4].y)), y3 = acc[t4][3] * rs * nw.w * siluf(bfhi(rw[t4].y));
                    u32x2 o; o.x = pk2(y0, y1); o.y = pk2(y2, y3);
                    *(u32x2*)(Y + (size_t)(ci.r0 + tr) * D + h * 128 + wave * 16 + 4 * fq) = o;
                }
            }
#pragma unroll
            for (int t4 = 0; t4 < 4; ++t4) R.zf[t4] = Rn.zf[t4];
        } else {
            const ChunkInfo ci = chunk_info(it - n_gla);
            const int c0 = (tid & 31) * 8, t0 = ci.r0 + (tid >> 5) * 4;
            {
                float z[6][8];
#pragma unroll
                for (int j = 0; j < 6; ++j) {
                    const int rr = t0 + j - 1; const bool ok = rr >= ci.seg_lo && rr < ci.seg_hi; const int rc = min(max(rr, ci.seg_lo), ci.seg_hi - 1);
                    const u32x4 cw = *(const u32x4*)(proj + PC + (size_t)rc * 768 + 256 + c0), hw = *(const u32x4*)(proj + PC + (size_t)rc * 768 + 512 + c0);
                    const unsigned cc[4] = {cw.x, cw.y, cw.z, cw.w}, hh[4] = {hw.x, hw.y, hw.z, hw.w};
#pragma unroll
                    for (int i = 0; i < 4; ++i) { z[j][2 * i] = ok ? bflo(cc[i]) * bflo(hh[i]) : 0.f; z[j][2 * i + 1] = ok ? bfhi(cc[i]) * bfhi(hh[i]) : 0.f; }
                }
                float w0[8], w1[8], w2[8];
#pragma unroll
                for (int i = 0; i < 8; ++i) { w0[i] = conv_w[c0 + i]; w1[i] = conv_w[256 + c0 + i]; w2[i] = conv_w[512 + c0 + i]; }
#pragma unroll
                for (int tt = 0; tt < 4; ++tt) {
                    const u32x4 bw = *(const u32x4*)(proj + PC + (size_t)(t0 + tt) * 768 + c0);
                    const unsigned bbv[4] = {bw.x, bw.y, bw.z, bw.w};
                    float yc[8];
#pragma unroll
                    for (int i = 0; i < 8; ++i) { const float bgv = (i & 1) ? bfhi(bbv[i >> 1]) : bflo(bbv[i >> 1]); yc[i] = bgv * (w0[i] * z[tt][i] + w1[i] * z[tt + 1][i] + w2[i] * z[tt + 2][i]); }
                    *(u32x4*)(Y + (size_t)(t0 + tt) * D + 512 + c0) = (u32x4){pk2(yc[0], yc[1]), pk2(yc[2], yc[3]), pk2(yc[4], yc[5]), pk2(yc[6], yc[7])};
                }
            }
            {
                const int pg = __builtin_amdgcn_readfirstlane(wave & 3);
                const int pc0 = pg * 64 + (lane & 7) * 8, pt0 = ci.r0 + ((wave >> 2) * 8 + (lane >> 3)) * 4;
                if (pg == 0) pool_rows<1>(proj, Y, pc0, pt0, ci.seg_lo, ci.seg_hi);
                else if (pg == 1) pool_rows<2>(proj, Y, pc0, pt0, ci.seg_lo, ci.seg_hi);
                else if (pg == 2) pool_rows<4>(proj, Y, pc0, pt0, ci.seg_lo, ci.seg_hi);
                else pool_rows<8>(proj, Y, pc0, pt0, ci.seg_lo, ci.seg_hi);
            }
        }
    }
}

#define XB_TMO      128
#define XB_XCNT(j)  (256  + 64 * (j))
#define XB_XSUB(j)  (1280 + 64 * (j))
#define XB_XGEN(j)  (2304 + 64 * (j))
#define XB_TOP      3328
#define XB_TOPGEN   3392
#define XCD_BAR_WORDS 3456
#define XB_SPIN_CAP (1u << 18)

__device__ __forceinline__ unsigned xb_ld(unsigned* p)              { return __hip_atomic_load(p, __ATOMIC_RELAXED, __HIP_MEMORY_SCOPE_AGENT); }
__device__ __forceinline__ unsigned xb_add(unsigned* p, unsigned v) { return __hip_atomic_fetch_add(p, v, __ATOMIC_RELAXED, __HIP_MEMORY_SCOPE_AGENT); }
__device__ __forceinline__ unsigned xb_xcc_id() { return (unsigned)__builtin_amdgcn_s_getreg((3 << 11) | 20) & 0xFu; }
#define XB_SPIN(cond, bar) do { unsigned _sp = 0; while (cond) { __builtin_amdgcn_s_sleep(1); \
    if ((++_sp & 255u) == 0u) { if (xb_ld(&(bar)[XB_TMO])) break; if (_sp > XB_SPIN_CAP) { atomicAdd(&(bar)[XB_TMO], 1u); break; } } } } while (0)

struct XcdBarrier {
    unsigned* bar; unsigned x;
    volatile LAS unsigned* st;
};

__device__ __forceinline__ XcdBarrier xcd_barrier_post(unsigned* bar, volatile LAS unsigned* st) {
    XcdBarrier b; b.bar = bar; b.x = xb_xcc_id(); b.st = st;
    if (threadIdx.x == 0) (void)xb_add(&bar[XB_XCNT(b.x)], 1u);
    return b;
}
__device__ __forceinline__ void xcd_barrier_complete(unsigned* bar, unsigned x, unsigned& nloc, unsigned& nx) {
    const unsigned G = gridDim.x * gridDim.y * gridDim.z;
    unsigned sum, cnt, mine, sp = 0u;
    for (;;) {
        sum = 0u; cnt = 0u; mine = 0u;
#pragma unroll
        for (unsigned j = 0; j < 16; ++j) { const unsigned c = xb_ld(&bar[XB_XCNT(j)]); sum += c; cnt += (c > 0u) ? 1u : 0u; mine = (j == x) ? c : mine; }
        if (sum == G) break;
        __builtin_amdgcn_s_sleep(1);
        if ((++sp & 255u) == 0u) { if (xb_ld(&bar[XB_TMO])) break; if (sp > XB_SPIN_CAP) { atomicAdd(&bar[XB_TMO], 1u); break; } }
    }
    nloc = mine > 0u ? mine : 1u; nx = cnt > 0u ? cnt : 1u;
}

__device__ __forceinline__ void xcd_barrier(const XcdBarrier& b) {
    asm volatile("s_waitcnt vmcnt(0)" ::: "memory");
    __syncthreads();
    if (threadIdx.x == 0) {
        unsigned* bar = b.bar; asm volatile("" : "+s"(bar));
        __builtin_amdgcn_s_waitcnt(0);
        unsigned nloc = b.st[0], nx = b.st[1];
        if (nloc == 0u) { xcd_barrier_complete(bar, b.x, nloc, nx); b.st[0] = nloc; b.st[1] = nx; }
        const unsigned old = xb_add(&bar[XB_XSUB(b.x)], 1u);
        const unsigned gen = old / nloc;
        if (old + 1u == (gen + 1u) * nloc) {
            __builtin_amdgcn_fence(__ATOMIC_RELEASE, "agent");
            asm volatile("s_waitcnt vmcnt(0)" ::: "memory");
            const unsigned og = xb_add(&bar[XB_TOP], 1u);
            const unsigned tg = og / nx;
            if (og + 1u == (tg + 1u) * nx) xb_add(&bar[XB_TOPGEN], 1u);
            else XB_SPIN(xb_ld(&bar[XB_TOPGEN]) == tg, bar);
            __builtin_amdgcn_fence(__ATOMIC_ACQUIRE, "agent");
            xb_add(&bar[XB_XGEN(b.x)], 1u);
            asm volatile("s_waitcnt vmcnt(0)" ::: "memory");
        } else {
            XB_SPIN(xb_ld(&bar[XB_XGEN(b.x)]) == gen, bar);
            __builtin_amdgcn_fence(__ATOMIC_ACQUIRE, "agent");
            asm volatile("s_waitcnt vmcnt(0)" ::: "memory");
        }
    }
    __syncthreads();
}


__global__ void __launch_bounds__(NTHREADS, 2) hybrid_fwd(Args a) {
    extern __shared__ __attribute__((aligned(16))) unsigned char smem[];
    LAS unsigned char* lds = (LAS unsigned char*)smem;
    cg::grid_group grid = cg::this_grid();
    const int G = gridDim.x;
    volatile LAS unsigned* bst = (volatile LAS unsigned*)(lds + 131072 + 64);
    if (tid_opaque() < 2) bst[tid_opaque()] = 0u;
    __syncthreads();
    const XcdBarrier bar = xcd_barrier_post((unsigned*)(a.ws + WS_BAR), bst);
#pragma unroll 1
    for (int ph = a.ph_lo; ph < a.ph_hi; ++ph) {
      {
        unsigned char* ws = a.ws; asm volatile("" : "+s"(ws));
        float* MOD = (float*)(ws + WS_MOD);
        bf16_t* H = (bf16_t*)a.out; bf16_t* X = (bf16_t*)(ws + WS_X); bf16_t* PROJ = (bf16_t*)(ws + WS_PROJ); bf16_t* Yb = (bf16_t*)(ws + WS_Y); bf16_t* ACT = (bf16_t*)(ws + WS_ACT);
        float* XC = (float*)(ws + WS_XC);
        if (ph == 0) { phase_prep(a, lds); }
        else if (ph == NPHASES - 1) { phase_final(X, a.out, a.in[18]); }
        else {
            const int l = (ph - 1) / 9, sp = (ph - 1) % 9;
            const float* xctx = l == 0 ? a.in[2] : XC;
            const float* mod = MOD + l * 3 * NMODV;
            const int mrows = l == 0 ? MALL : MLAT;
            if (sp == 0) phase_norm(l == 0 ? a.in[0] : nullptr, X, xctx, MALL, a.in[6] + l * D, mod, 0, 1024, H, (const float*)(ws + WS_PART), l == 0 ? 0 : FF / 256, XC);
            else if (sp == 1) {
                pg8::Gemm g{H, (const bf16_t*)(ws + WS_WIN) + (size_t)l * INP * D, MALL, INP, D, D}; pg8::StaticOrder S; S.init(MALL, INP, G, bid_opaque()); S.ntk = D / 64;
                EpiProj E{PROJ}; pg8::gemm_phase<EpiProj, pg8::StaticOrder, GEMM_ALIGN, GEMM_SP2>(lds, g, S, E);
            }
            else if (sp == 2) phase_gla_u(a, l, lds);
            else if (sp == 3) phase_gla_scan(a, lds);
            else if (sp == 4) phase_gla_out(a, l, mrows / 64, lds);
            else if (sp == 5 || sp == 8) {
                const bool mix = sp == 5; const int KK = mix ? D : FF;
                const bf16_t* Ap = mix ? Yb : ACT; const bf16_t* Bp = mix ? (const bf16_t*)(ws + WS_WOUT) + (size_t)l * D * D : (const bf16_t*)(ws + WS_W2) + (size_t)l * D * FF;
                const float* gate = mod + (mix ? 2048 : 5120);
                pg8::Gemm g{Ap, Bp, MALL, D, KK, KK};
                pg8::MixedOrder S; S.lat.init(MLAT, D, G, bid_opaque()); S.lat.ntk = KK / 64; S.nks = l == 0 ? KK / 256 : 0; S.kslice = 256;
                EpiRes E{(mix && l == 0) ? a.in[0] : nullptr, X, (float*)(ws + WS_PART), gate};
                pg8::gemm_phase<EpiRes, pg8::MixedOrder, GEMM_ALIGN, GEMM_SP2>(lds, g, S, E);
            }
            else if (sp == 6) phase_norm(nullptr, X, l == 0 ? a.in[2] : (const float*)XC, mrows, a.in[7] + l * D, mod, 3072, 4096, H, (const float*)(ws + WS_PART), l == 0 ? D / 256 : 0, XC);
            else {
                pg8::Gemm g{H, (const bf16_t*)(ws + WS_W1) + (size_t)l * FF * D, mrows, FF, D, D}; pg8::StaticOrder S; S.init(mrows, FF, G, bid_opaque()); S.ntk = D / 64;
                EpiAct E{ACT}; pg8::gemm_phase<EpiAct, pg8::StaticOrder, GEMM_ALIGN, GEMM_SP2>(lds, g, S, E);
            }
        }
      }
        if (ph + 1 < a.ph_hi) {
            if (a.ph_hi > NPHASES) {
                __builtin_amdgcn_fence(__ATOMIC_RELEASE, "agent"); asm volatile("s_waitcnt vmcnt(0)" ::: "memory");
                grid.sync();
                __builtin_amdgcn_fence(__ATOMIC_ACQUIRE, "agent"); asm volatile("s_waitcnt vmcnt(0)" ::: "memory");
            }
            xcd_barrier(bar);
        }
    }
}

extern "C" void kernel_launch(void* const* d_in, const int* in_sizes, int n_in, void* d_out, int out_size, void* d_ws, size_t ws_size, hipStream_t stream) {
    static int grid = 0;
    if (grid == 0) {
        int dev = 0, cus = 0, per_cu = 0;
        hipGetDevice(&dev);
        hipDeviceGetAttribute(&cus, hipDeviceAttributeMultiprocessorCount, dev);
        hipFuncSetAttribute((const void*)hybrid_fwd, hipFuncAttributeMaxDynamicSharedMemorySize, LDS_BYTES);
        hipOccupancyMaxActiveBlocksPerMultiprocessor(&per_cu, (const void*)hybrid_fwd, NTHREADS, LDS_BYTES);
        if (per_cu < 1) { fprintf(stderr, "kernel_launch: occupancy query reports %d blocks per CU\n", per_cu); per_cu = 1; }
        (void)hipGetLastError();
        grid = cus * per_cu;
        if (n_in != 19 || ws_size < WS_END) fprintf(stderr, "kernel_launch: unexpected n_in %d / ws_size %zu\n", n_in, ws_size);
    }
    (void)hipMemsetAsync((char*)d_ws + WS_BAR, 0, BAR_BYTES, stream);
    Args a{};
    for (int i = 0; i < 19; ++i) a.in[i] = (const float*)d_in[i];
    a.out = (float*)d_out; a.ws = (unsigned char*)d_ws;
    a.ph_lo = 0; a.ph_hi = NPHASES;
    void* args[] = {&a};
    hipError_t e = hipLaunchCooperativeKernel((const void*)hybrid_fwd, dim3(grid), dim3(NTHREADS), args, LDS_BYTES, stream);
    if (e != hipSuccess) fprintf(stderr, "cooperative launch failed: %s (grid %d)\n", hipGetErrorString(e), grid);
}
```

```cpp
#include <hip/hip_runtime.h>
#include <hip/hip_cooperative_groups.h>
#include <cstdio>
namespace cg = cooperative_groups;
__device__ __forceinline__ int tid_opaque() { int t = threadIdx.x; asm volatile("" : "+v"(t)); return t; }
__device__ __forceinline__ int bid_opaque() { int t = blockIdx.x; asm volatile("" : "+s"(t)); return t; }
namespace pg8 {
#define PG8_LAS __attribute__((address_space(3)))
typedef unsigned short bf16_t;
typedef short bf16x8 __attribute__((ext_vector_type(8)));
typedef float f32x4 __attribute__((ext_vector_type(4)));
typedef unsigned u32x4 __attribute__((ext_vector_type(4)));
constexpr int BM = 256, BK = 64, HALF = 128, HTB = HALF * BK * 2  , STAGE_BYTES = 8 * HTB, NXCD = 8, WGM = 4;

__host__ __device__ __forceinline__ int lds_byte(int r, int c) { const int st = (r >> 4) * 2 + (c >> 5), rr = r & 15, cc = c & 31, ob = rr * 64 + cc * 2; return st * 1024 + (ob ^ (((ob >> 9) & 1) << 5)); }
__host__ __device__ __forceinline__ void stage_rc(int b, int& R, int& C) { const int st = b / 1024, sb = b % 1024, swz = sb ^ (((sb >> 9) & 1) << 5); R = (st >> 1) * 16 + swz / 64; C = (st & 1) * 32 + (swz % 64) / 2; }
__host__ __device__ __forceinline__ int perm32(int rho) { const int n = rho >> 4, i = rho & 15; return 8 * (i >> 2) + 4 * n + (i & 3); }

struct Unit { int pm, pn, kofs, nt; };
struct Gemm { const bf16_t* A; const bf16_t* Bt; int M, N, K, ld; };

struct StaticOrder {
    int nM, nN, nwg, G, c, ntk;
    __host__ __device__ void init(int M, int N, int G_, int c_) { nM = M / BM; nN = N / BM; nwg = nM * nN; G = G_; c = c_; }
    __host__ __device__ bool next(int i, Unit& u) const {
        const long L = (long)i * G + c; if (L >= nwg) return false;
        int wgid = (int)L; { const int q = nwg / NXCD, r = nwg % NXCD, xcd = wgid % NXCD, off = wgid / NXCD; wgid = (xcd < r ? xcd * (q + 1) : r * (q + 1) + (xcd - r) * q) + off; }
        const int nig = WGM * nN, gid = wgid / nig, fm = gid * WGM, gsz = (nM - fm) < WGM ? (nM - fm) : WGM;
        u.pm = fm + ((wgid % nig) % gsz); u.pn = (wgid % nig) / gsz; u.kofs = 0; u.nt = ntk; return true;
    }
    __device__ __forceinline__ void a_ready(const Unit&) const {}
    __device__ __forceinline__ void done(const Unit&) const {}
};
struct MixedOrder {
    StaticOrder lat; int nks, kslice;
    __device__ __forceinline__ bool next(int i, Unit& u) const {
        const int L = i * lat.G + lat.c;
        if (L < lat.nwg) return lat.next(i, u);
        const int j = L - lat.nwg; if (j >= 8 * nks) return false;
        u.pm = 64 + (j & 1); u.pn = (j >> 1) & 3; u.kofs = (j >> 3) * kslice; u.nt = kslice / BK; return true;
    }
    __device__ __forceinline__ void a_ready(const Unit&) const {}
    __device__ __forceinline__ void done(const Unit&) const {}
};
__device__ __forceinline__ unsigned cvt_pk_bf16(float lo, float hi) { unsigned r; asm volatile("v_cvt_pk_bf16_f32 %0, %1, %2" : "=v"(r) : "v"(lo), "v"(hi)); return r; }
template <class Epi, class Sched, bool ALIGN_EPI = false, bool SP2 = false>
__device__ __forceinline__ void gemm_phase(PG8_LAS unsigned char* lds, const Gemm g, const Sched& S, const Epi& E) {
    const int tid = tid_opaque(), wid = __builtin_amdgcn_readfirstlane(tid >> 6), lane = tid & 63, wr = wid >> 2, wc = wid & 3, fr = lane & 15, fq = lane >> 4;
    const int LD = g.ld;
    unsigned voffA[2], voffB[2];
#pragma unroll
    for (int i = 0; i < 2; ++i) { int R, C; stage_rc(tid * 16 + i * 8192, R, C); const int Rb = Epi::PERM ? ((R & ~31) + perm32(R & 31)) : R;
        voffA[i] = (unsigned)(R * LD + C) * 2u; voffB[i] = (unsigned)(Rb * LD + C) * 2u; }
    const size_t kstep = (size_t)(BK * 2);
    const size_t hstep = (size_t)HALF * LD * 2;
    const size_t tstep = 2 * hstep;
    const unsigned ldsw = (unsigned)wid * 1024u;
    const int aoff = lds_byte(wr * 64 + fr, fq * 8), boff = lds_byte(wc * 32 + fr, fq * 8);
#define PG8_SA(b, h) (((b) * 2 + (h)) * HTB)
#define PG8_SB(b, h) ((4 + (b) * 2 + (h)) * HTB)
#define PG8_STAGE(bufoff, gbase, voff) do { _Pragma("unroll") for (int _i = 0; _i < 2; ++_i) \
        __builtin_amdgcn_global_load_lds((const unsigned*)((const char*)(gbase) + (voff)[_i]), (PG8_LAS unsigned*)(lds + (bufoff) + ldsw + _i * 8192), 16, 0, 0); } while (0)
#define PG8_LDA(dst, b, h) do { _Pragma("unroll") for (int m = 0; m < 4; ++m) _Pragma("unroll") for (int k = 0; k < 2; ++k) dst[m][k] = *(const PG8_LAS bf16x8*)(lds + PG8_SA(b, h) + aoff + m * 2048 + k * 1024); } while (0)
#define PG8_LDB(dst, b, h) do { _Pragma("unroll") for (int n = 0; n < 2; ++n) _Pragma("unroll") for (int k = 0; k < 2; ++k) dst[n][k] = *(const PG8_LAS bf16x8*)(lds + PG8_SB(b, h) + boff + n * 2048 + k * 1024); } while (0)
#define PG8_MMA(ai, bj, At, Bt) do { __builtin_amdgcn_s_setprio(1); _Pragma("unroll") for (int m = 0; m < 4; ++m) _Pragma("unroll") for (int n = 0; n < 2; ++n) _Pragma("unroll") for (int k = 0; k < 2; ++k) \
        acc[ai][bj][m][n] = __builtin_amdgcn_mfma_f32_16x16x32_bf16(Bt[n][k], At[m][k], acc[ai][bj][m][n], 0, 0, 0); __builtin_amdgcn_s_setprio(0); } while (0)
#define PG8_WAIT_V(n) asm volatile("s_waitcnt vmcnt(" #n ")" ::: "memory")
#define PG8_WAIT_L(n) asm volatile("s_waitcnt lgkmcnt(" #n ")" ::: "memory")
#define PG8_BAR __builtin_amdgcn_s_barrier()
#define PG8_SCHED __builtin_amdgcn_sched_barrier(0)
    Unit cur, nxt; int ui = 0;
    if (!S.next(0, cur)) return;
    f32x4 acc[2][2][4][2];
#pragma unroll
    for (int a = 0; a < 2; ++a)
#pragma unroll
        for (int b = 0; b < 2; ++b)
#pragma unroll
            for (int m = 0; m < 4; ++m)
#pragma unroll
                for (int n = 0; n < 2; ++n) acc[a][b][m][n] = (f32x4){0.f, 0.f, 0.f, 0.f};
    bf16x8 At[4][2], B0[2][2], B1[2][2];
    const char* cA = (const char*)g.A + (size_t)cur.pm * tstep + (size_t)cur.kofs * 2; const char* cB = (const char*)g.Bt + (size_t)cur.pn * tstep + (size_t)cur.kofs * 2;
    S.a_ready(cur);
    if constexpr (SP2) {
        PG8_STAGE(PG8_SB(0, 0), cB, voffB); PG8_STAGE(PG8_SB(0, 1), cB + hstep, voffB); PG8_STAGE(PG8_SA(0, 0), cA, voffA); PG8_STAGE(PG8_SA(0, 1), cA + hstep, voffA);
        if (wr == 1) PG8_BAR;
        PG8_WAIT_V(2); PG8_BAR;
        PG8_STAGE(PG8_SB(1, 0), cB + kstep, voffB); PG8_STAGE(PG8_SA(1, 0), cA + kstep, voffA); PG8_STAGE(PG8_SB(1, 1), cB + hstep + kstep, voffB);
        PG8_WAIT_V(6); PG8_BAR;
    } else {
        PG8_STAGE(PG8_SB(0, 0), cB, voffB); PG8_STAGE(PG8_SA(0, 0), cA, voffA); PG8_STAGE(PG8_SB(0, 1), cB + hstep, voffB); PG8_STAGE(PG8_SA(0, 1), cA + hstep, voffA);
        if (wr == 1) PG8_BAR;
        PG8_WAIT_V(4); PG8_BAR;
        PG8_STAGE(PG8_SB(1, 0), cB + kstep, voffB); PG8_STAGE(PG8_SA(1, 0), cA + kstep, voffA); PG8_STAGE(PG8_SB(1, 1), cB + hstep + kstep, voffB);
        PG8_WAIT_V(6); PG8_BAR;
    }
    for (;;) {
        const bool has_next = S.next(ui + 1, nxt);
        const char* nA = has_next ? (const char*)g.A + (size_t)nxt.pm * tstep + (size_t)nxt.kofs * 2 : cA; const char* nB = has_next ? (const char*)g.Bt + (size_t)nxt.pn * tstep + (size_t)nxt.kofs * 2 : cB;
        const int nt = cur.nt;
        for (int t = 0; t < nt; t += 2) {
            const bool last = (t == nt - 2);
            const char* a1 = cA + (size_t)(t + 1) * kstep;
            const char* a2 = last ? nA : cA + (size_t)(t + 2) * kstep; const char* b2 = last ? nB : cB + (size_t)(t + 2) * kstep;
            const char* a3 = a2 + kstep; const char* b3 = b2 + kstep;
            if (last && has_next) S.a_ready(nxt);
            if constexpr (SP2) {
            PG8_LDB(B0, 0, 0); PG8_LDB(B1, 0, 1); PG8_SCHED; PG8_LDA(At, 0, 0); PG8_STAGE(PG8_SA(1, 1), a1 + hstep, voffA);
            PG8_WAIT_V(8); PG8_WAIT_L(0); PG8_BAR; PG8_MMA(0, 0, At, B0); PG8_MMA(0, 1, At, B1); PG8_BAR; PG8_SCHED;
            PG8_LDA(At, 0, 1); PG8_STAGE(PG8_SB(0, 0), b2, voffB); PG8_STAGE(PG8_SB(0, 1), b2 + hstep, voffB); PG8_STAGE(PG8_SA(0, 0), a2, voffA);
            PG8_WAIT_V(8); PG8_WAIT_L(0); PG8_BAR; PG8_MMA(1, 0, At, B0); PG8_MMA(1, 1, At, B1); PG8_BAR; PG8_SCHED;
            PG8_LDB(B0, 1, 0); PG8_LDB(B1, 1, 1); PG8_SCHED; PG8_LDA(At, 1, 0); PG8_STAGE(PG8_SA(0, 1), a2 + hstep, voffA);
            PG8_WAIT_V(8); PG8_WAIT_L(0); PG8_BAR; PG8_MMA(0, 0, At, B0); PG8_MMA(0, 1, At, B1); PG8_BAR; PG8_SCHED;
            PG8_LDA(At, 1, 1); PG8_STAGE(PG8_SB(1, 0), b3, voffB); PG8_STAGE(PG8_SB(1, 1), b3 + hstep, voffB); PG8_STAGE(PG8_SA(1, 0), a3, voffA);
            PG8_WAIT_V(8); PG8_WAIT_L(0); PG8_BAR; PG8_MMA(1, 0, At, B0); PG8_MMA(1, 1, At, B1); PG8_BAR; PG8_SCHED;
            } else {
            PG8_LDB(B0, 0, 0); PG8_SCHED; PG8_LDA(At, 0, 0); PG8_STAGE(PG8_SA(1, 1), a1 + hstep, voffA);
            PG8_WAIT_L(8); PG8_BAR; PG8_WAIT_L(0); PG8_MMA(0, 0, At, B0); PG8_BAR; PG8_SCHED;
            PG8_LDB(B1, 0, 1); PG8_STAGE(PG8_SB(0, 0), b2, voffB);
            PG8_BAR; PG8_WAIT_L(0); PG8_MMA(0, 1, At, B1); PG8_BAR;
            PG8_LDA(At, 0, 1); PG8_STAGE(PG8_SA(0, 0), a2, voffA);
            PG8_BAR; PG8_WAIT_L(0); PG8_MMA(1, 0, At, B0); PG8_BAR; PG8_SCHED;
            PG8_STAGE(PG8_SB(0, 1), b2 + hstep, voffB);
            PG8_WAIT_V(6); PG8_BAR; PG8_MMA(1, 1, At, B1); PG8_BAR;
            PG8_LDB(B0, 1, 0); PG8_SCHED; PG8_LDA(At, 1, 0); PG8_STAGE(PG8_SA(0, 1), a2 + hstep, voffA);
            PG8_WAIT_L(8); PG8_BAR; PG8_WAIT_L(0); PG8_MMA(0, 0, At, B0); PG8_BAR; PG8_SCHED;
            PG8_LDB(B1, 1, 1); PG8_STAGE(PG8_SB(1, 0), b3, voffB);
            PG8_BAR; PG8_WAIT_L(0); PG8_MMA(0, 1, At, B1); PG8_BAR;
            PG8_LDA(At, 1, 1); PG8_STAGE(PG8_SA(1, 0), a3, voffA);
            PG8_BAR; PG8_WAIT_L(0); PG8_MMA(1, 0, At, B0); PG8_BAR; PG8_SCHED;
            PG8_STAGE(PG8_SB(1, 1), b3 + hstep, voffB);
            PG8_WAIT_V(6); PG8_BAR; PG8_MMA(1, 1, At, B1); PG8_BAR;
            }
        }
        if constexpr (ALIGN_EPI) { if (wr == 0) PG8_BAR; }
        if constexpr (!Epi::AFTER_DRAIN) { E(acc, cur, wr, wc, fr, fq); S.done(cur); }
        if (!has_next) break;
#pragma unroll
        for (int a = 0; a < 2; ++a)
#pragma unroll
            for (int b = 0; b < 2; ++b)
#pragma unroll
                for (int m = 0; m < 4; ++m)
#pragma unroll
                    for (int n = 0; n < 2; ++n) acc[a][b][m][n] = (f32x4){0.f, 0.f, 0.f, 0.f};
        cur = nxt; cA = nA; cB = nB; ++ui;
        if constexpr (ALIGN_EPI) { if (wr == 1) PG8_BAR; }
    }
    PG8_WAIT_V(0);
    if constexpr (!ALIGN_EPI) { if (wr == 0) PG8_BAR; }
    PG8_BAR;
    if constexpr (Epi::AFTER_DRAIN) { E.fused(acc, cur, wr, wc, fr, fq, lds, wid, lane); S.done(cur); }
#undef PG8_SA
#undef PG8_SB
#undef PG8_STAGE
#undef PG8_LDA
#undef PG8_LDB
#undef PG8_MMA
#undef PG8_WAIT_V
#undef PG8_WAIT_L
#undef PG8_BAR
#undef PG8_SCHED
}
}

#define LAS __attribute__((address_space(3)))
typedef unsigned short bf16_t;
typedef short bf16x8 __attribute__((ext_vector_type(8)));
typedef float f32x4 __attribute__((ext_vector_type(4)));
typedef unsigned u32x4 __attribute__((ext_vector_type(4)));
typedef unsigned u32x2 __attribute__((ext_vector_type(2)));

#ifndef GEMM_SP2
#define GEMM_SP2 true
#endif
#ifndef GEMM_ALIGN
#define GEMM_ALIGN true
#endif

constexpr int D = 1024, MLAT = 16384, MCTX = 512, MALL = 16896, HALFLAT = 8192;
constexpr int INC = 2592, INP = 2816, FF = 4096;
constexpr int K_OFF = 256, V_OFF = 512, G_OFF = 1024, R_OFF = 1056, CB_OFF = 1568, CC_OFF = 1824, CH_OFF = 2080, P_OFF = 2336;
constexpr int NPOS = 132, NMODV = 6144;
constexpr size_t PQ = 0, PK = PQ + (size_t)4 * MALL * 64, PV = PK + (size_t)4 * MALL * 64, PZ = PV + (size_t)4 * MALL * 128, PR = PZ + (size_t)MALL * 32,
                 PC = PR + (size_t)4 * MALL * 128, PP = PC + (size_t)MALL * 768;
static_assert(PP + (size_t)MALL * 256 == (size_t)MALL * INC, "PROJ segments");
constexpr float EPS = 1e-6f;
constexpr int NTHREADS = 512, NWAVES = 8;
constexpr int LDS_BYTES = 147456;
constexpr int NPHASES = 20;

constexpr size_t MiB = 1u << 20;
constexpr size_t WS_MOD = 0;
constexpr size_t WS_WIN = 1 * MiB;
constexpr size_t WS_WOUT = 12 * MiB;
constexpr size_t WS_W1 = 16 * MiB;
constexpr size_t WS_W2 = 32 * MiB;
constexpr size_t WS_XC = 48 * MiB;
constexpr size_t WS_X = 50 * MiB;
constexpr size_t WS_PROJ = 83 * MiB;
constexpr size_t WS_Y = 167 * MiB;
constexpr size_t WS_ACT = 83 * MiB;
constexpr size_t WS_S = 215 * MiB;
constexpr size_t WS_PART = 215 * MiB;
constexpr size_t WS_DEC = 248 * MiB;
constexpr size_t WS_BAR = 250 * MiB;
constexpr size_t BAR_BYTES = 16384;
constexpr size_t WS_END = 251 * MiB;

struct Args {
    const float* in[19];
    float* out;
    unsigned char* ws;
    int ph_lo, ph_hi;
};

__device__ __forceinline__ float bf2f(unsigned h) { return __uint_as_float(h << 16); }
__device__ __forceinline__ float bflo(unsigned w) { return __uint_as_float(w << 16); }
__device__ __forceinline__ float bfhi(unsigned w) { return __uint_as_float(w & 0xffff0000u); }
typedef __bf16 bf16v2_t __attribute__((ext_vector_type(2)));
typedef float f32v2_t __attribute__((ext_vector_type(2)));
__device__ __forceinline__ unsigned pk2(float lo, float hi) { const f32v2_t v = {lo, hi}; const bf16v2_t b = __builtin_convertvector(v, bf16v2_t); return __builtin_bit_cast(unsigned, b); }
__device__ __forceinline__ bf16_t f2bf(float f) { return (bf16_t)(pk2(f, 0.f) & 0xffffu); }
__device__ __forceinline__ float wave_sum(float v) {
#pragma unroll
    for (int o = 1; o < 64; o <<= 1) v += __shfl_xor(v, o);
    return v;
}
__device__ __forceinline__ float siluf(float x) { return x * __builtin_amdgcn_rcpf(1.0f + __builtin_amdgcn_exp2f(-1.4426950409f * x)); }
__device__ __forceinline__ int modvec_of_row(int row) { return row < HALFLAT ? 0 : (row < MLAT ? 1 : 2); }

struct EpiProj {
    static constexpr bool PERM = true, AFTER_DRAIN = false;
    bf16_t* O;
    __device__ __forceinline__ void operator()(const f32x4 (&acc)[2][2][4][2], const pg8::Unit& u, int wr, int wc, int fr, int fq) const {
        const int row0 = u.pm * 256 + wr * 64 + fr, colt = u.pn * 256;
#pragma unroll
        for (int bj = 0; bj < 2; ++bj) {
            const int cb = colt + bj * 128 + wc * 32;
            if (cb >= INC) continue;
            size_t off0; int pitch;
            if (cb < K_OFF)       { off0 = PQ + (size_t)(cb >> 6) * MALL * 64 + (cb & 63); pitch = 64; }
            else if (cb < V_OFF)  { const int c = cb - K_OFF;  off0 = PK + (size_t)(c >> 6) * MALL * 64 + (c & 63); pitch = 64; }
            else if (cb < G_OFF)  { const int c = cb - V_OFF;  off0 = PV + (size_t)(c >> 7) * MALL * 128 + (c & 127); pitch = 128; }
            else if (cb < R_OFF)  { off0 = PZ; pitch = 32; }
            else if (cb < CB_OFF) { const int c = cb - R_OFF;  off0 = PR + (size_t)(c >> 7) * MALL * 128 + (c & 127); pitch = 128; }
            else if (cb < P_OFF)  { off0 = PC + (cb - CB_OFF); pitch = 768; }
            else                  { off0 = PP + (cb - P_OFF); pitch = 256; }
            bf16_t* base = O + off0 + 8 * fq;
#pragma unroll
            for (int ai = 0; ai < 2; ++ai)
#pragma unroll
                for (int m = 0; m < 4; ++m) {
                    const f32x4 v0 = acc[ai][bj][m][0], v1 = acc[ai][bj][m][1];
                    u32x4 w; w.x = pk2(v0[0], v0[1]); w.y = pk2(v0[2], v0[3]); w.z = pk2(v1[0], v1[1]); w.w = pk2(v1[2], v1[3]);
                    *(u32x4*)(base + (size_t)(row0 + ai * 128 + m * 16) * pitch) = w;
                }
        }
    }
};
struct EpiAct {
    static constexpr bool PERM = true, AFTER_DRAIN = false;
    bf16_t* O;
    __device__ __forceinline__ void operator()(const f32x4 (&acc)[2][2][4][2], const pg8::Unit& u, int wr, int wc, int fr, int fq) const {
        const int row0 = u.pm * 256 + wr * 64 + fr, colt = u.pn * 256;
#pragma unroll
        for (int ai = 0; ai < 2; ++ai)
#pragma unroll
            for (int m = 0; m < 4; ++m) {
                bf16_t* rowp = O + (size_t)(row0 + ai * 128 + m * 16) * FF + colt + wc * 32 + 8 * fq;
#pragma unroll
                for (int bj = 0; bj < 2; ++bj) {
                    f32x4 v0 = acc[ai][bj][m][0], v1 = acc[ai][bj][m][1];
#pragma unroll
                    for (int j = 0; j < 4; ++j) { const float a = fmaxf(v0[j], 0.f), b = fmaxf(v1[j], 0.f); v0[j] = a * a; v1[j] = b * b; }
                    u32x4 w; w.x = pk2(v0[0], v0[1]); w.y = pk2(v0[2], v0[3]); w.z = pk2(v1[0], v1[1]); w.w = pk2(v1[2], v1[3]);
                    *(u32x4*)(rowp + bj * 128) = w;
                }
            }
    }
};
struct EpiRes {
    static constexpr bool PERM = true, AFTER_DRAIN = false;
    const float* xin_f32; bf16_t* X; float* part; const float* gate;
    __device__ __forceinline__ void operator()(const f32x4 (&acc)[2][2][4][2], const pg8::Unit& u, int wr, int wc, int fr, int fq) const {
        asm volatile("" ::: "memory");
        const int rbase = __builtin_amdgcn_readfirstlane(u.pm * 256), cbase = __builtin_amdgcn_readfirstlane(u.pn * 256);
        const unsigned c32 = (unsigned)(wc * 32 + 8 * fq), o32 = (unsigned)((wr * 64 + fr) * D) + c32;
        if (rbase < MLAT) {
            const float* gp = gate + (rbase < HALFLAT ? 0 : NMODV) + cbase;
            f32x4 gv[2][2];
#pragma unroll
            for (int bj = 0; bj < 2; ++bj)
#pragma unroll
                for (int n = 0; n < 2; ++n) gv[bj][n] = *(const f32x4*)(gp + c32 + bj * 128 + 4 * n);
            bf16_t* xo = X + (size_t)rbase * D + cbase;
            if (xin_f32) {
                const float* xi = xin_f32 + (size_t)rbase * D + cbase;
#pragma unroll
                for (int ai = 0; ai < 2; ++ai) {
                    f32x4 xv[4][2][2];
#pragma unroll
                    for (int m = 0; m < 4; ++m)
#pragma unroll
                        for (int bj = 0; bj < 2; ++bj)
#pragma unroll
                            for (int n = 0; n < 2; ++n) xv[m][bj][n] = *(const f32x4*)(xi + (size_t)(ai * 128 + m * 16) * D + o32 + bj * 128 + 4 * n);
#pragma unroll
                    for (int m = 0; m < 4; ++m)
#pragma unroll
                        for (int bj = 0; bj < 2; ++bj) {
                            const f32x4 y0 = xv[m][bj][0] + gv[bj][0] * acc[ai][bj][m][0], y1 = xv[m][bj][1] + gv[bj][1] * acc[ai][bj][m][1];
                            *(u32x4*)(xo + (size_t)(ai * 128 + m * 16) * D + o32 + bj * 128) = (u32x4){pk2(y0[0], y0[1]), pk2(y0[2], y0[3]), pk2(y1[0], y1[1]), pk2(y1[2], y1[3])};
                        }
                    asm volatile("" ::: "memory");
                }
            } else {
#pragma unroll
                for (int ai = 0; ai < 2; ++ai) {
                    u32x4 xb[4][2];
#pragma unroll
                    for (int m = 0; m < 4; ++m)
#pragma unroll
                        for (int bj = 0; bj < 2; ++bj) xb[m][bj] = *(const u32x4*)(xo + (size_t)(ai * 128 + m * 16) * D + o32 + bj * 128);
#pragma unroll
                    for (int m = 0; m < 4; ++m)
#pragma unroll
                        for (int bj = 0; bj < 2; ++bj) {
                            const u32x4 w = xb[m][bj];
                            const f32x4 x0 = (f32x4){bflo(w.x), bfhi(w.x), bflo(w.y), bfhi(w.y)}, x1 = (f32x4){bflo(w.z), bfhi(w.z), bflo(w.w), bfhi(w.w)};
                            const f32x4 y0 = x0 + gv[bj][0] * acc[ai][bj][m][0], y1 = x1 + gv[bj][1] * acc[ai][bj][m][1];
                            *(u32x4*)(xo + (size_t)(ai * 128 + m * 16) * D + o32 + bj * 128) = (u32x4){pk2(y0[0], y0[1]), pk2(y0[2], y0[3]), pk2(y1[0], y1[1]), pk2(y1[2], y1[3])};
                        }
                    asm volatile("" ::: "memory");
                }
            }
        } else {
            float* xo = part + ((size_t)(u.kofs >> 8) * MCTX + (size_t)(rbase - MLAT)) * D + cbase; const float* gp = gate + 2 * NMODV + cbase;
#pragma unroll
            for (int ai = 0; ai < 2; ++ai)
#pragma unroll
                for (int m = 0; m < 4; ++m) {
                    float* xw = xo + (size_t)(ai * 128 + m * 16) * D;
#pragma unroll
                    for (int bj = 0; bj < 2; ++bj)
#pragma unroll
                        for (int n = 0; n < 2; ++n) {
                            const f32x4 gv = *(const f32x4*)(gp + c32 + bj * 128 + 4 * n);
                            *(f32x4*)(xw + o32 + bj * 128 + 4 * n) = gv * acc[ai][bj][m][n];
                        }
                    asm volatile("" ::: "memory");
                }
        }
    }
};

__device__ __forceinline__ void transpose_item(const float* W, int N, bf16_t* WT, int ldt, LAS float* scr, int item, int lane) {
    const int nblk = N / 32, kb = item / nblk, nb = item % nblk, k0 = 64 * kb, n0 = 32 * nb;
#pragma unroll 8
    for (int i = 0; i < 32; ++i) { const int kk = 2 * i + (lane >> 5); scr[kk * 33 + (lane & 31)] = W[(size_t)(k0 + kk) * N + n0 + (lane & 31)]; }
    asm volatile("s_waitcnt lgkmcnt(0)" ::: "memory");
    const int c = lane & 7;
#pragma unroll
    for (int j = 0; j < 4; ++j) { const int n = (lane >> 3) + 8 * j; const LAS float* s = scr + (8 * c) * 33 + n;
        u32x4 o; o.x = pk2(s[0 * 33], s[1 * 33]); o.y = pk2(s[2 * 33], s[3 * 33]); o.z = pk2(s[4 * 33], s[5 * 33]); o.w = pk2(s[6 * 33], s[7 * 33]);
        *(u32x4*)(WT + (size_t)(n0 + n) * ldt + k0 + 8 * c) = o; }
    asm volatile("s_waitcnt lgkmcnt(0)" ::: "memory");
}

__device__ __forceinline__ void phase_prep(const Args& a, LAS unsigned char* lds) {
    const int tid = tid_opaque(), lane = tid & 63, wave = tid >> 6, G = gridDim.x;
    unsigned char* ws = a.ws;
    {
        LAS float* sc = (LAS float*)lds;
        LAS float* part = (LAS float*)(lds + 12288);
        bool have = false;
        for (int it = bid_opaque(); it < 192; it += G) {
            if (!have) {
                for (int i = tid; i < 3072; i += NTHREADS) { const int v = i >> 10, k = i & 1023; const float cv = v < 2 ? a.in[1][v * D + k] : a.in[3][k]; sc[i] = siluf(cv); }
                have = true; __syncthreads();
            }
            const int l = it / 96, cgp = it % 96, col = tid & 63, ks = tid >> 6;
            const float* W = a.in[4] + (size_t)l * D * NMODV + cgp * 64 + col;
            float a0 = 0.f, a1 = 0.f, a2 = 0.f;
#pragma unroll 32
            for (int k = ks * 128; k < ks * 128 + 128; ++k) { const float w = W[(size_t)k * NMODV]; a0 += sc[k] * w; a1 += sc[1024 + k] * w; a2 += sc[2048 + k] * w; }
            part[(ks * 3 + 0) * 64 + col] = a0; part[(ks * 3 + 1) * 64 + col] = a1; part[(ks * 3 + 2) * 64 + col] = a2;
            __syncthreads();
            if (tid < 192) { const int v = tid >> 6, c2 = tid & 63; float s = a.in[5][l * NMODV + cgp * 64 + c2];
#pragma unroll
                for (int q = 0; q < 8; ++q) s += part[(q * 3 + v) * 64 + c2];
                ((float*)(ws + WS_MOD))[(l * 3 + v) * NMODV + cgp * 64 + c2] = s; }
            __syncthreads();
        }
        __syncthreads();
    }
    {
        LAS float* scr = (LAS float*)(lds + wave * 16384);
        const int gw = bid_opaque() * NWAVES + wave, NGW = G * NWAVES;
        constexpr int I_IN = 16 * 81, I_OUT = 12 * 32, I_1 = 16 * 128, I_2 = 64 * 32, I_L = I_IN + I_OUT + I_1 + I_2;
        for (int it = gw; it < 2 * I_L; it += NGW) {
            const int l = it / I_L; int r = it % I_L;
            if (r < I_IN) { transpose_item(a.in[8] + (size_t)l * D * INC, INC, (bf16_t*)(ws + WS_WIN) + (size_t)l * INP * D, D, scr, r, lane); continue; } r -= I_IN;
            if (r < I_OUT) { transpose_item(a.in[15] + (size_t)l * D * D, D, (bf16_t*)(ws + WS_WOUT) + (size_t)l * D * D, D, scr, r, lane); continue; } r -= I_OUT;
            if (r < I_1) { transpose_item(a.in[16] + (size_t)l * D * FF, FF, (bf16_t*)(ws + WS_W1) + (size_t)l * FF * D, D, scr, r, lane); continue; } r -= I_1;
            transpose_item(a.in[17] + (size_t)l * FF * D, D, (bf16_t*)(ws + WS_W2) + (size_t)l * D * FF, FF, scr, r, lane);
        }
        for (int i = bid_opaque() * NTHREADS + tid; i < 2 * 224 * 128; i += G * NTHREADS) {
            const int l = i / (224 * 128), r = i % (224 * 128);
            *(u32x4*)((bf16_t*)(ws + WS_WIN) + (size_t)l * INP * D + (size_t)INC * D + (size_t)r * 8) = (u32x4){0u, 0u, 0u, 0u};
        }
    }
    {
        for (int i = bid_opaque() * NTHREADS + tid; i < 2 * 32 * 1024; i += G * NTHREADS) {
            const int l = i >> 15, r = i & 32767, n = r & 1023, kc8 = (r >> 10) * 8, g = kc8 >> 6, c0 = kc8 & 63;
            const float* pw = a.in[13] + ((size_t)(l * 4 + g) * 64 + c0) * 64;
            const float* sc = a.in[14] + l * 256 + g * 64;
            const float* wo = a.in[15] + (size_t)l * D * D + (size_t)(768 + g * 64) * D + n;
            float acc[8];
#pragma unroll
            for (int j = 0; j < 8; ++j) acc[j] = 0.f;
            for (int d = 0; d < 64; ++d) { const float w = wo[(size_t)d * D] * sc[d];
#pragma unroll
                for (int j = 0; j < 8; ++j) acc[j] += pw[j * 64 + d] * w; }
            u32x4 o; o.x = pk2(acc[0], acc[1]); o.y = pk2(acc[2], acc[3]); o.z = pk2(acc[4], acc[5]); o.w = pk2(acc[6], acc[7]);
            *(u32x4*)((bf16_t*)(ws + WS_WOUT) + (size_t)l * D * D + (size_t)n * D + 768 + kc8) = o;
        }
    }
}

__device__ __forceinline__ void load_row_f32(f32x4 (&v)[4], const float* p, int lane) {
#pragma unroll
    for (int j = 0; j < 2; ++j) { v[2 * j] = *(const f32x4*)(p + 8 * lane + 512 * j); v[2 * j + 1] = *(const f32x4*)(p + 8 * lane + 512 * j + 4); }
}
__device__ __forceinline__ void load_row_bf16(f32x4 (&v)[4], const bf16_t* p, int lane) {
#pragma unroll
    for (int j = 0; j < 2; ++j) { const u32x4 w = *(const u32x4*)(p + 8 * lane + 512 * j);
        v[2 * j] = (f32x4){bflo(w.x), bfhi(w.x), bflo(w.y), bfhi(w.y)}; v[2 * j + 1] = (f32x4){bflo(w.z), bfhi(w.z), bflo(w.w), bfhi(w.w)}; }
}
__device__ __forceinline__ float row_sumsq(const f32x4 (&v)[4]) {
    float s = 0.f;
#pragma unroll
    for (int j = 0; j < 4; ++j) s += (v[j].x * v[j].x + v[j].y * v[j].y) + (v[j].z * v[j].z + v[j].w * v[j].w);
    return s;
}
__device__ __forceinline__ void phase_norm(const float* xlat32, const bf16_t* X, const float* xctx, int nrows, const float* nw, const float* mod, int sh_off, int sc_off, bf16_t* H,
                                           const float* part, int npart, float* xc_store, bf16_t* xcopy) {
    const int tid = tid_opaque(), lane = tid & 63, wave = tid >> 6;
    const int gw = bid_opaque() * NWAVES + wave, NGW = gridDim.x * NWAVES;
    int cur_v = -1; f32x4 aw[4], shv[4];
#pragma unroll
    for (int j = 0; j < 4; ++j) { aw[j] = (f32x4){0.f, 0.f, 0.f, 0.f}; shv[j] = aw[j]; }
    for (int r = gw; r < nrows; r += 2 * NGW) {
        const int rowA = nrows - 1 - r, rowB0 = rowA - NGW;
        const bool hasB = rowB0 >= 0; const int rowB = hasB ? rowB0 : rowA;
        f32x4 va[4], vb[4];
        if (rowA >= MLAT) load_row_f32(va, xctx + (size_t)(rowA - MLAT) * D, lane);
        else if (xlat32) load_row_f32(va, xlat32 + (size_t)rowA * D, lane);
        else load_row_bf16(va, X + (size_t)rowA * D, lane);
        if (rowB >= MLAT) load_row_f32(vb, xctx + (size_t)(rowB - MLAT) * D, lane);
        else if (xlat32) load_row_f32(vb, xlat32 + (size_t)rowB * D, lane);
        else load_row_bf16(vb, X + (size_t)rowB * D, lane);
        if (rowA >= MLAT && npart > 0) {
            const float* pr = part + (size_t)(rowA - MLAT) * D;
            for (int k = 0; k < npart; k += 2) {
                f32x4 t0[4], t1[4];
                load_row_f32(t0, pr + (size_t)k * MCTX * D, lane); load_row_f32(t1, pr + (size_t)(k + 1) * MCTX * D, lane);
#pragma unroll
                for (int j = 0; j < 4; ++j) va[j] += t0[j] + t1[j];
            }
            float* xs = xc_store + (size_t)(rowA - MLAT) * D;
#pragma unroll
            for (int j = 0; j < 2; ++j) { *(f32x4*)(xs + 8 * lane + 512 * j) = va[2 * j]; *(f32x4*)(xs + 8 * lane + 512 * j + 4) = va[2 * j + 1]; }
        }
        if (xcopy) {
#pragma unroll
            for (int j = 0; j < 2; ++j) {
                if (rowA < MLAT) *(u32x4*)(xcopy + (size_t)rowA * D + 8 * lane + 512 * j) = (u32x4){pk2(va[2 * j].x, va[2 * j].y), pk2(va[2 * j].z, va[2 * j].w), pk2(va[2 * j + 1].x, va[2 * j + 1].y), pk2(va[2 * j + 1].z, va[2 * j + 1].w)};
                if (hasB && rowB < MLAT) *(u32x4*)(xcopy + (size_t)rowB * D + 8 * lane + 512 * j) = (u32x4){pk2(vb[2 * j].x, vb[2 * j].y), pk2(vb[2 * j].z, vb[2 * j].w), pk2(vb[2 * j + 1].x, vb[2 * j + 1].y), pk2(vb[2 * j + 1].z, vb[2 * j + 1].w)};
            }
        }
        float sa = row_sumsq(va), sb = row_sumsq(vb);
#pragma unroll
        for (int o = 1; o < 64; o <<= 1) { sa += __shfl_xor(sa, o); sb += __shfl_xor(sb, o); }
        const float ra = rsqrtf(sa * (1.0f / D) + EPS), rb = rsqrtf(sb * (1.0f / D) + EPS);
#pragma unroll 1
        for (int which = 0; which < 2; ++which) {
            if (which == 1 && !hasB) break;
            const int row = which ? rowB : rowA; const float rstd = which ? rb : ra;
            const int v = modvec_of_row(row);
            if (v != cur_v) {
                const float* mv = mod + v * NMODV;
#pragma unroll
                for (int j = 0; j < 4; ++j) { const int c = 8 * lane + 512 * (j >> 1) + 4 * (j & 1); aw[j] = *(const f32x4*)(nw + c) * (*(const f32x4*)(mv + sc_off + c) + 1.0f); shv[j] = *(const f32x4*)(mv + sh_off + c); }
                cur_v = v;
            }
#pragma unroll
            for (int j = 0; j < 2; ++j) {
                const f32x4 y0 = ((which ? vb[2 * j] : va[2 * j]) * rstd) * aw[2 * j] + shv[2 * j], y1 = ((which ? vb[2 * j + 1] : va[2 * j + 1]) * rstd) * aw[2 * j + 1] + shv[2 * j + 1];
                *(u32x4*)(H + (size_t)row * D + 8 * lane + 512 * j) = (u32x4){pk2(y0.x, y0.y), pk2(y0.z, y0.w), pk2(y1.x, y1.y), pk2(y1.z, y1.w)};
            }
        }
    }
}
__device__ __forceinline__ void phase_final(const bf16_t* X, float* out, const float* nw) {
    const int tid = tid_opaque(), lane = tid & 63, wave = tid >> 6;
    const int gw = bid_opaque() * NWAVES + wave, NGW = gridDim.x * NWAVES;
    f32x4 w[4];
    load_row_f32(w, nw, lane);
    for (int row = gw; row < MLAT; row += 2 * NGW) {
        const bool hasB = row + NGW < MLAT; const int rowB = hasB ? row + NGW : row;
        f32x4 va[4], vb[4];
        load_row_bf16(va, X + (size_t)row * D, lane); load_row_bf16(vb, X + (size_t)rowB * D, lane);
        float sa = row_sumsq(va), sb = row_sumsq(vb);
#pragma unroll
        for (int o = 1; o < 64; o <<= 1) { sa += __shfl_xor(sa, o); sb += __shfl_xor(sb, o); }
        const float ra = rsqrtf(sa * (1.0f / D) + EPS), rb = rsqrtf(sb * (1.0f / D) + EPS);
        float* oa = out + (size_t)row * D; float* ob = out + (size_t)rowB * D;
#pragma unroll
        for (int j = 0; j < 2; ++j) { *(f32x4*)(oa + 8 * lane + 512 * j) = (va[2 * j] * ra) * w[2 * j]; *(f32x4*)(oa + 8 * lane + 512 * j + 4) = (va[2 * j + 1] * ra) * w[2 * j + 1]; }
        if (hasB) {
#pragma unroll
            for (int j = 0; j < 2; ++j) { *(f32x4*)(ob + 8 * lane + 512 * j) = (vb[2 * j] * rb) * w[2 * j]; *(f32x4*)(ob + 8 * lane + 512 * j + 4) = (vb[2 * j + 1] * rb) * w[2 * j + 1]; }
        }
    }
}

constexpr int L_ZS = 0, L_GW = 8192, L_GB = 16384, L_SEG = 16896;
constexpr int BPITCH = 68;
constexpr int L_BF = 21504, L_BB = L_BF + 64 * BPITCH * 4;
constexpr int L_QEF = 56320, L_QEB = L_QEF + 9216, L_KIF = L_QEB + 9216, L_KIB = L_KIF + 9216, L_VT = L_KIB + 9216, L_PF = L_VT + 18432, L_PB = L_PF + 9216;
constexpr int PITCH = 72;
static_assert(L_PB + 9216 <= 131072, "GLA LDS map");

struct ChunkInfo { int r0, b, posf, posb, seg_lo, seg_hi; };
__device__ __forceinline__ ChunkInfo chunk_info(int cidx) {
    ChunkInfo ci;
    if (cidx < 256) { ci.b = cidx >> 7; const int c = cidx & 127; ci.r0 = cidx * 64; ci.posf = 4 + c; ci.posb = 4 + (127 - c); ci.seg_lo = ci.r0; ci.seg_hi = ci.r0 + 64; }
    else { const int cc = cidx - 256; ci.b = cc >> 2; const int j = cc & 3; ci.r0 = MLAT + cc * 64; ci.posf = j; ci.posb = 3 - j; ci.seg_lo = MLAT + ci.b * 256; ci.seg_hi = ci.seg_lo + 256; }
    return ci;
}
__device__ __forceinline__ float pick8(const f32x4& a, const f32x4& b, int i) { return i < 4 ? a[i & 3] : b[i & 3]; }
__device__ __forceinline__ float logsigmoidf(float x) { return fminf(x, 0.f) - 0.6931471806f * __builtin_amdgcn_logf(1.0f + __builtin_amdgcn_exp2f(-1.4426950409f * fabsf(x))); }

struct GFirst { u32x4 zf[4]; u32x4 k, q, v0, v1; };
__device__ __forceinline__ void gla_load_a(GFirst& R, const bf16_t* proj, int r0, int tid) {
    const int fr = tid & 15, fq = (tid >> 4) & 3;
#pragma unroll
    for (int tt = 0; tt < 4; ++tt) R.zf[tt] = *(const u32x4*)(proj + PZ + (size_t)(r0 + 16 * tt + fr) * 32 + 8 * fq);
}
struct GateConst { bf16x8 bfrag; float gbias; int h; };
__device__ __forceinline__ void gate_const(GateConst& gc, const float* gate_w, const float* gate_b, int h, int tid) {
    const int fr = tid & 15, fq = (tid >> 4) & 3, w = tid >> 6, d = w >> 2, n = h * 64 + (w & 3) * 16 + fr;
    float v[8];
#pragma unroll
    for (int j = 0; j < 8; ++j) v[j] = 0.f;
    if ((fq >> 1) == d) {
        const unsigned o = (unsigned)((d * 16 + 8 * (fq & 1)) * 256 + n);
#pragma unroll
        for (int j = 0; j < 8; ++j) v[j] = gate_w[o + (unsigned)(j * 256)];
    }
    const u32x4 p = (u32x4){pk2(v[0], v[1]), pk2(v[2], v[3]), pk2(v[4], v[5]), pk2(v[6], v[7])};
    gc.bfrag = __builtin_bit_cast(bf16x8, p);
    gc.gbias = gate_b[d * 256 + n]; gc.h = h;
}
template <bool WITH_Q>
__device__ __forceinline__ void gla_load_b(GFirst& R, const bf16_t* proj, int r0, int h, int tid) {
    const int t = tid & 63, cg = tid >> 6;
    const size_t hr = (size_t)h * MALL + (size_t)(r0 + t);
    R.k = *(const u32x4*)(proj + PK + hr * 64 + cg * 8);
    if (WITH_Q) R.q = *(const u32x4*)(proj + PQ + hr * 64 + cg * 8);
    R.v0 = *(const u32x4*)(proj + PV + hr * 128 + cg * 8);
    R.v1 = *(const u32x4*)(proj + PV + hr * 128 + 64 + cg * 8);
}
template <bool WITH_Q>
__device__ __forceinline__ void gla_load_first(GFirst& R, const bf16_t* proj, int r0, int h, int tid) {
    gla_load_a(R, proj, r0, tid); gla_load_b<WITH_Q>(R, proj, r0, h, tid);
}

__device__ __forceinline__ void gla_gates(const GFirst& R, const GateConst& gc, LAS unsigned char* lds, int tid) {
    const int lane = tid & 63, fr = lane & 15, fq = lane >> 4, w = tid >> 6, d = w >> 2, j = (w & 3) * 16 + fr;
    LAS float* BX = (LAS float*)(lds + (d ? L_BB : L_BF));
    float g[4][4];
#pragma unroll
    for (int tt = 0; tt < 4; ++tt) {
        const f32x4 acc = __builtin_amdgcn_mfma_f32_16x16x32_bf16(__builtin_bit_cast(bf16x8, R.zf[tt]), gc.bfrag, (f32x4){0.f, 0.f, 0.f, 0.f}, 0, 0, 0);
#pragma unroll
        for (int r = 0; r < 4; ++r) g[tt][r] = logsigmoidf(acc[r] + gc.gbias) * (1.0f / 16.0f);
    }
    if (d == 0) {
        float off = 0.f;
#pragma unroll
        for (int tt = 0; tt < 4; ++tt) {
            const float p0 = g[tt][0], p1 = p0 + g[tt][1], p2 = p1 + g[tt][2], p3 = p2 + g[tt][3];
            float s = p3; float v = __shfl(s, (lane - 16) & 63); s += fq >= 1 ? v : 0.f; v = __shfl(s, (lane - 32) & 63); s += fq >= 2 ? v : 0.f;
            const float e = off + (s - p3), tot = __shfl(s, 48 + fr);
            LAS float* bp = BX + (16 * tt + 4 * fq) * BPITCH + j;
            bp[0] = e + p0; bp[BPITCH] = e + p1; bp[2 * BPITCH] = e + p2; bp[3 * BPITCH] = e + p3;
            off += tot;
        }
    } else {
        float off = 0.f;
#pragma unroll
        for (int tt = 3; tt >= 0; --tt) {
            const float s3 = g[tt][3], s2 = s3 + g[tt][2], s1 = s2 + g[tt][1], s0 = s1 + g[tt][0];
            float s = s0; float v = __shfl(s, (lane + 16) & 63); s += fq <= 2 ? v : 0.f; v = __shfl(s, (lane + 32) & 63); s += fq <= 1 ? v : 0.f;
            const float e = off + (s - s0), tot = __shfl(s, fr);
            LAS float* bp = BX + (16 * tt + 4 * fq) * BPITCH + j;
            bp[0] = e + s0; bp[BPITCH] = e + s1; bp[2 * BPITCH] = e + s2; bp[3 * BPITCH] = e + s3;
            off += tot;
        }
    }
    __syncthreads();
}
__device__ __forceinline__ void gla_write_vt(const GFirst& R, LAS unsigned char* lds, int tid) {
    LAS bf16_t* VT = (LAS bf16_t*)(lds + L_VT); const int t = tid & 63, cg = tid >> 6;
    const unsigned a[4] = {R.v0.x, R.v0.y, R.v0.z, R.v0.w}, b[4] = {R.v1.x, R.v1.y, R.v1.z, R.v1.w};
#pragma unroll
    for (int i = 0; i < 4; ++i) {
        VT[(cg * 8 + 2 * i) * PITCH + t] = (bf16_t)(a[i] & 0xffffu); VT[(cg * 8 + 2 * i + 1) * PITCH + t] = (bf16_t)(a[i] >> 16);
        VT[(64 + cg * 8 + 2 * i) * PITCH + t] = (bf16_t)(b[i] & 0xffffu); VT[(64 + cg * 8 + 2 * i + 1) * PITCH + t] = (bf16_t)(b[i] >> 16);
    }
}

__device__ __forceinline__ void phase_gla_u(const Args& a, int l, LAS unsigned char* lds) {
    const int tid = tid_opaque(), lane = tid & 63, wave = tid >> 6;
    const bf16_t* proj = (const bf16_t*)(a.ws + WS_PROJ);
    bf16_t* U = (bf16_t*)a.out; float* DEC = (float*)(a.ws + WS_DEC);
    const float* gate_w = a.in[9] + (size_t)l * 2 * 16 * 256; const float* gate_b = a.in[10] + (size_t)l * 2 * 256;
    LAS float* BF = (LAS float*)(lds + L_BF); LAS float* BB = (LAS float*)(lds + L_BB);
    LAS bf16_t* KTF = (LAS bf16_t*)(lds + L_QEF); LAS bf16_t* KTB = (LAS bf16_t*)(lds + L_QEB); LAS bf16_t* VT = (LAS bf16_t*)(lds + L_VT);
    constexpr int NIT = 264 * 4;
    GFirst R; GateConst gc; gc.h = -1;
    if (bid_opaque() < NIT) { const ChunkInfo c0 = chunk_info(bid_opaque() >> 2); gla_load_first<false>(R, proj, c0.r0, bid_opaque() & 3, tid); }
#pragma unroll 1
    for (int it = bid_opaque(); it < NIT; it += gridDim.x) {
        const int cidx = it >> 2, h = it & 3; const ChunkInfo ci = chunk_info(cidx);
        const int itn = it + gridDim.x; const ChunkInfo cn = chunk_info((itn < NIT ? itn : it) >> 2);
        if (gc.h != h) gate_const(gc, gate_w, gate_b, h, tid);
        GFirst Rn;
#pragma unroll
        for (int tt = 0; tt < 4; ++tt) Rn.zf[tt] = R.zf[tt];
        if (itn < NIT) gla_load_a(Rn, proj, cn.r0, tid);
        gla_gates(R, gc, lds, tid);
        { const int t = tid & 63, cg = tid >> 6;
          const unsigned ww[4] = {R.k.x, R.k.y, R.k.z, R.k.w};
          const f32x4 bfa = *(const LAS f32x4*)(BF + t * BPITCH + cg * 8), bfb = *(const LAS f32x4*)(BF + t * BPITCH + cg * 8 + 4);
          const f32x4 bba = *(const LAS f32x4*)(BB + t * BPITCH + cg * 8), bbb = *(const LAS f32x4*)(BB + t * BPITCH + cg * 8 + 4);
          const f32x4 fla = *(const LAS f32x4*)(BF + 63 * BPITCH + cg * 8), flb = *(const LAS f32x4*)(BF + 63 * BPITCH + cg * 8 + 4);
          const f32x4 b0a = *(const LAS f32x4*)(BB + cg * 8), b0b = *(const LAS f32x4*)(BB + cg * 8 + 4);
#pragma unroll
          for (int i = 0; i < 8; ++i) { const int dk = cg * 8 + i; const float kf = (i & 1) ? bfhi(ww[i >> 1]) : bflo(ww[i >> 1]);
              KTF[dk * PITCH + t] = f2bf(kf * __expf(pick8(fla, flb, i) - pick8(bfa, bfb, i)));
              KTB[dk * PITCH + t] = f2bf(kf * __expf(pick8(b0a, b0b, i) - pick8(bba, bbb, i))); } }
        gla_write_vt(R, lds, tid);
        if (tid < 128) { const int d = tid >> 6, j = tid & 63;
            DEC[((size_t)((ci.b * 4 + h) * 2 + d) * NPOS + (d ? ci.posb : ci.posf)) * 64 + j] = __expf(d ? BB[j] : BF[63 * BPITCH + j]); }
        if (itn < NIT) gla_load_b<false>(R, proj, cn.r0, itn & 3, tid);
        __syncthreads();
        {
            const int dir = wave >> 2, jv = (wave & 3) * 32, fr = lane & 15, fq = lane >> 4;
            const LAS bf16_t* KT = dir ? KTB : KTF;
            bf16x8 af[4][2], bfr[2][2];
#pragma unroll
            for (int i = 0; i < 4; ++i)
#pragma unroll
                for (int ks = 0; ks < 2; ++ks) af[i][ks] = *(const LAS bf16x8*)(KT + (i * 16 + fr) * PITCH + ks * 32 + 8 * fq);
#pragma unroll
            for (int jt = 0; jt < 2; ++jt)
#pragma unroll
                for (int ks = 0; ks < 2; ++ks) bfr[jt][ks] = *(const LAS bf16x8*)(VT + (jv + jt * 16 + fr) * PITCH + ks * 32 + 8 * fq);
            bf16_t* Ub = U + ((size_t)((ci.b * 4 + h) * 2 + dir) * NPOS + (dir ? ci.posb : ci.posf)) * 8192 + (size_t)jv * 64;
            LAS unsigned char* wst = lds + (wave < 4 ? wave * 4608 : L_KIF + (wave - 4) * 4608);
#pragma unroll
            for (int i = 0; i < 4; ++i)
#pragma unroll
                for (int jt = 0; jt < 2; ++jt) {
                    f32x4 acc = (f32x4){0.f, 0.f, 0.f, 0.f};
#pragma unroll
                    for (int ks = 0; ks < 2; ++ks) acc = __builtin_amdgcn_mfma_f32_16x16x32_bf16(af[i][ks], bfr[jt][ks], acc, 0, 0, 0);
                    u32x2 o; o.x = pk2(acc[0], acc[1]); o.y = pk2(acc[2], acc[3]);
                    *(LAS u32x2*)(wst + (jt * 16 + fr) * 144 + (i * 16 + 4 * fq) * 2) = o;
                }
#pragma unroll
            for (int c4 = 0; c4 < 4; ++c4) {
                const int c = c4 * 64 + lane, row = c >> 3, piece = c & 7;
                const u32x4 w = *(const LAS u32x4*)(wst + row * 144 + piece * 16);
                *(u32x4*)(Ub + (size_t)c * 8) = w;
            }
        }
#pragma unroll
        for (int tt = 0; tt < 4; ++tt) R.zf[tt] = Rn.zf[tt];
    }
}

__device__ __forceinline__ void phase_gla_scan(const Args& a, LAS unsigned char* lds) {
    const unsigned* U = (const unsigned*)a.out; unsigned* S = (unsigned*)(a.ws + WS_S); const float* DEC = (const float*)(a.ws + WS_DEC);
    constexpr int SEGL = NPOS / 4;
    const int tid = tid_opaque(), lane = tid & 63, wave = tid >> 6, seg = wave & 3, grp = wave >> 2;
    LAS float* X = (LAS float*)lds;
    for (int bi = bid_opaque(); bi < 16 * 4096 / 128; bi += gridDim.x) {
        const int pidx = bi * 128 + grp * 64 + lane, seq = pidx >> 12, e2 = pidx & 4095, dk = (e2 * 2) & 63, pl = grp * 64 + lane;
        const unsigned* up = U + ((size_t)seq * NPOS + seg * SEGL) * 4096 + e2; unsigned* sp = S + ((size_t)seq * NPOS + seg * SEGL) * 4096 + e2;
        const float* dp = DEC + ((size_t)seq * NPOS + seg * SEGL) * 64 + dk;
        unsigned u[SEGL]; float d0[SEGL], d1[SEGL];
#pragma unroll
        for (int i = 0; i < SEGL; ++i) { u[i] = up[(size_t)i * 4096]; const float2 dd = *(const float2*)(dp + i * 64); d0[i] = dd.x; d1[i] = dd.y; }
        float s0 = 0.f, s1 = 0.f, c0 = 1.f, c1 = 1.f;
#pragma unroll
        for (int i = 0; i < SEGL; ++i) { s0 = d0[i] * s0 + bflo(u[i]); s1 = d1[i] * s1 + bfhi(u[i]); c0 *= d0[i]; c1 *= d1[i]; }
        X[(0 * 4 + seg) * 128 + pl] = s0; X[(1 * 4 + seg) * 128 + pl] = s1; X[(2 * 4 + seg) * 128 + pl] = c0; X[(3 * 4 + seg) * 128 + pl] = c1;
        __syncthreads();
        float k0 = 0.f, k1 = 0.f;
#pragma unroll
        for (int k = 0; k < 3; ++k) {
            if (k < seg) { k0 = X[(2 * 4 + k) * 128 + pl] * k0 + X[(0 * 4 + k) * 128 + pl]; k1 = X[(3 * 4 + k) * 128 + pl] * k1 + X[(1 * 4 + k) * 128 + pl]; }
        }
        s0 = k0; s1 = k1;
#pragma unroll
        for (int i = 0; i < SEGL; ++i) { sp[(size_t)i * 4096] = pk2(s0, s1); s0 = d0[i] * s0 + bflo(u[i]); s1 = d1[i] * s1 + bfhi(u[i]); }
        __syncthreads();
    }
}

template <int HALF>
__device__ __forceinline__ void pool_rows(const bf16_t* proj, bf16_t* Y, int c0, int t0, int seg_lo, int seg_hi) {
    constexpr int NR = 2 * HALF + 3;
    u32x4 uw[NR];
#pragma unroll
    for (int j = 0; j < NR; ++j) { const int rc = min(max(t0 - HALF + j, seg_lo), seg_hi - 1); uw[j] = *(const u32x4*)(proj + PP + (size_t)rc * 256 + c0); }
    float sm[8];
#pragma unroll
    for (int i = 0; i < 8; ++i) sm[i] = 0.f;
#pragma unroll
    for (int j = 0; j < NR; ++j) {
        const int rr = t0 - HALF + j; const bool inseg = rr >= seg_lo && rr < seg_hi;
        const unsigned uu[4] = {uw[j].x, uw[j].y, uw[j].z, uw[j].w};
        float uv[8];
#pragma unroll
        for (int i = 0; i < 4; ++i) { uv[2 * i] = inseg ? bflo(uu[i]) : 0.f; uv[2 * i + 1] = inseg ? bfhi(uu[i]) : 0.f; }
#pragma unroll
        for (int i = 0; i < 8; ++i) sm[i] += uv[i];
        if (j >= 2 * HALF - 1) {
            const int tt = j - (2 * HALF - 1), tk = t0 + tt, lo = max(tk - HALF, seg_lo), hi = min(tk + HALF, seg_hi);
            const float inv = 1.0f / (float)(hi - lo);
            const unsigned su[4] = {uw[HALF + tt].x, uw[HALF + tt].y, uw[HALF + tt].z, uw[HALF + tt].w};
            float pp[8];
#pragma unroll
            for (int i = 0; i < 8; ++i) pp[i] = sm[i] * inv - ((i & 1) ? bfhi(su[i >> 1]) : bflo(su[i >> 1]));
            *(u32x4*)(Y + (size_t)tk * D + 768 + c0) = (u32x4){pk2(pp[0], pp[1]), pk2(pp[2], pp[3]), pk2(pp[4], pp[5]), pk2(pp[6], pp[7])};
            const int jl = tt; const int rl = t0 - HALF + jl; const bool insl = rl >= seg_lo && rl < seg_hi;
            const unsigned ul[4] = {uw[jl].x, uw[jl].y, uw[jl].z, uw[jl].w};
#pragma unroll
            for (int i = 0; i < 4; ++i) { sm[2 * i] -= insl ? bflo(ul[i]) : 0.f; sm[2 * i + 1] -= insl ? bfhi(ul[i]) : 0.f; }
        }
    }
}

__device__ __forceinline__ void phase_gla_out(const Args& a, int l, int nchunks, LAS unsigned char* lds) {
    const int tid = tid_opaque(), lane = tid & 63, wave = tid >> 6, fr = lane & 15, fq = lane >> 4;
    const bf16_t* proj = (const bf16_t*)(a.ws + WS_PROJ);
    const bf16_t* S = (const bf16_t*)(a.ws + WS_S); bf16_t* Y = (bf16_t*)(a.ws + WS_Y);
    const float* gate_w = a.in[9] + (size_t)l * 2 * 16 * 256; const float* gate_b = a.in[10] + (size_t)l * 2 * 256;
    const float* gnw = a.in[11] + l * 128; const float* conv_w = a.in[12] + l * 3 * 256;
    LAS float* BF = (LAS float*)(lds + L_BF); LAS float* BB = (LAS float*)(lds + L_BB); LAS float* SSX = (LAS float*)(lds + L_SEG);
    LAS bf16_t* QEF = (LAS bf16_t*)(lds + L_QEF); LAS bf16_t* QEB = (LAS bf16_t*)(lds + L_QEB);
    LAS bf16_t* KIF = (LAS bf16_t*)(lds + L_KIF); LAS bf16_t* KIB = (LAS bf16_t*)(lds + L_KIB);
    LAS bf16_t* VT = (LAS bf16_t*)(lds + L_VT); LAS bf16_t* PF = (LAS bf16_t*)(lds + L_PF); LAS bf16_t* PB = (LAS bf16_t*)(lds + L_PB);
    const int n_gla = nchunks * 4;
    GFirst R; GateConst gc; gc.h = -1;
    if (bid_opaque() < n_gla) { const ChunkInfo c0 = chunk_info(bid_opaque() >> 2); gla_load_first<true>(R, proj, c0.r0, bid_opaque() & 3, tid); }
#pragma unroll 1
    for (int it = bid_opaque(); it < n_gla + nchunks; it += gridDim.x) {
        if (it < n_gla) {
            const int cidx = it >> 2, h = it & 3; const ChunkInfo ci = chunk_info(cidx);
            const int tt = wave & 3, trow = tt * 16 + fr;
            const int dvr = wave * 16 + fr;
            bf16x8 sfa[2], sba[2]; u32x2 rw[4];
            {
                const bf16_t* Sf = S + ((size_t)((ci.b * 4 + h) * 2 + 0) * NPOS + ci.posf) * 8192;
                const bf16_t* Sb = S + ((size_t)((ci.b * 4 + h) * 2 + 1) * NPOS + ci.posb) * 8192;
#pragma unroll
                for (int ks = 0; ks < 2; ++ks) { sfa[ks] = *(const bf16x8*)(Sf + (size_t)dvr * 64 + ks * 32 + 8 * fq); sba[ks] = *(const bf16x8*)(Sb + (size_t)dvr * 64 + ks * 32 + 8 * fq); }
#pragma unroll
                for (int t4 = 0; t4 < 4; ++t4) rw[t4] = *(const u32x2*)(proj + PR + ((size_t)h * MALL + (size_t)(ci.r0 + t4 * 16 + fr)) * 128 + wave * 16 + 4 * fq);
            }
            const int itn = it + gridDim.x; const ChunkInfo cn = chunk_info((itn < n_gla ? itn : it) >> 2);
            if (gc.h != h) gate_const(gc, gate_w, gate_b, h, tid);
            GFirst Rn;
#pragma unroll
            for (int tt = 0; tt < 4; ++tt) Rn.zf[tt] = R.zf[tt];
            if (itn < n_gla) gla_load_a(Rn, proj, cn.r0, tid);
            gla_gates(R, gc, lds, tid);
            { const int t = tid & 63, cg = tid >> 6;
              const unsigned qq[4] = {R.q.x, R.q.y, R.q.z, R.q.w}, kk[4] = {R.k.x, R.k.y, R.k.z, R.k.w};
              const f32x4 bfa = *(const LAS f32x4*)(BF + t * BPITCH + cg * 8), bfb = *(const LAS f32x4*)(BF + t * BPITCH + cg * 8 + 4);
              const f32x4 bba = *(const LAS f32x4*)(BB + t * BPITCH + cg * 8), bbb = *(const LAS f32x4*)(BB + t * BPITCH + cg * 8 + 4);
              unsigned oqf[4], oqb[4], okf[4], okb[4];
#pragma unroll
              for (int i = 0; i < 4; ++i) {
                  const float ef0 = __expf(pick8(bfa, bfb, 2 * i)), ef1 = __expf(pick8(bfa, bfb, 2 * i + 1)), eb0 = __expf(pick8(bba, bbb, 2 * i)), eb1 = __expf(pick8(bba, bbb, 2 * i + 1));
                  const float q0 = bflo(qq[i]) * 0.125f, q1 = bfhi(qq[i]) * 0.125f, k0 = bflo(kk[i]), k1 = bfhi(kk[i]);
                  oqf[i] = pk2(q0 * ef0, q1 * ef1); oqb[i] = pk2(q0 * eb0, q1 * eb1);
                  okf[i] = pk2(k0 * __builtin_amdgcn_rcpf(ef0), k1 * __builtin_amdgcn_rcpf(ef1)); okb[i] = pk2(k0 * __builtin_amdgcn_rcpf(eb0), k1 * __builtin_amdgcn_rcpf(eb1));
              }
              *(LAS u32x4*)(QEF + t * PITCH + cg * 8) = (u32x4){oqf[0], oqf[1], oqf[2], oqf[3]};
              *(LAS u32x4*)(QEB + t * PITCH + cg * 8) = (u32x4){oqb[0], oqb[1], oqb[2], oqb[3]};
              *(LAS u32x4*)(KIF + t * PITCH + cg * 8) = (u32x4){okf[0], okf[1], okf[2], okf[3]};
              *(LAS u32x4*)(KIB + t * PITCH + cg * 8) = (u32x4){okb[0], okb[1], okb[2], okb[3]}; }
            gla_write_vt(R, lds, tid);
            if (itn < n_gla) gla_load_b<true>(R, proj, cn.r0, itn & 3, tid);
            __syncthreads();
            {
                const int dir = wave >> 2;
                const LAS bf16_t* KI = dir ? KIB : KIF; const LAS bf16_t* QE = dir ? QEB : QEF; LAS bf16_t* P = dir ? PB : PF;
                bf16x8 qb[2];
#pragma unroll
                for (int ks = 0; ks < 2; ++ks) qb[ks] = *(const LAS bf16x8*)(QE + trow * PITCH + ks * 32 + 8 * fq);
#pragma unroll
                for (int st = 0; st < 4; ++st) {
                    f32x4 acc = (f32x4){0.f, 0.f, 0.f, 0.f};
#pragma unroll
                    for (int ks = 0; ks < 2; ++ks) { const bf16x8 ka = *(const LAS bf16x8*)(KI + (st * 16 + fr) * PITCH + ks * 32 + 8 * fq);
                        acc = __builtin_amdgcn_mfma_f32_16x16x32_bf16(ka, qb[ks], acc, 0, 0, 0); }
                    const int s0 = st * 16 + 4 * fq;
#pragma unroll
                    for (int r = 0; r < 4; ++r) { const int s = s0 + r; const bool keep = dir ? (s >= trow) : (s <= trow); acc[r] = keep ? acc[r] : 0.f; }
                    u32x2 o; o.x = pk2(acc[0], acc[1]); o.y = pk2(acc[2], acc[3]);
                    *(LAS u32x2*)(P + trow * PITCH + s0) = o;
                }
            }
            __syncthreads();
            {
                f32x4 acc[4];
#pragma unroll
                for (int t4 = 0; t4 < 4; ++t4) acc[t4] = (f32x4){0.f, 0.f, 0.f, 0.f};
#pragma unroll
                for (int ks = 0; ks < 2; ++ks) {
                    const bf16x8 va = *(const LAS bf16x8*)(VT + dvr * PITCH + ks * 32 + 8 * fq);
#pragma unroll
                    for (int t4 = 0; t4 < 4; ++t4) {
                        const int tr = t4 * 16 + fr;
                        const bf16x8 pf = *(const LAS bf16x8*)(PF + tr * PITCH + ks * 32 + 8 * fq), pb = *(const LAS bf16x8*)(PB + tr * PITCH + ks * 32 + 8 * fq);
                        const bf16x8 qf = *(const LAS bf16x8*)(QEF + tr * PITCH + ks * 32 + 8 * fq), qb = *(const LAS bf16x8*)(QEB + tr * PITCH + ks * 32 + 8 * fq);
                        acc[t4] = __builtin_amdgcn_mfma_f32_16x16x32_bf16(va, pf, acc[t4], 0, 0, 0);
                        acc[t4] = __builtin_amdgcn_mfma_f32_16x16x32_bf16(va, pb, acc[t4], 0, 0, 0);
                        acc[t4] = __builtin_amdgcn_mfma_f32_16x16x32_bf16(sfa[ks], qf, acc[t4], 0, 0, 0);
                        acc[t4] = __builtin_amdgcn_mfma_f32_16x16x32_bf16(sba[ks], qb, acc[t4], 0, 0, 0);
                    }
                }
#pragma unroll
                for (int t4 = 0; t4 < 4; ++t4) {
                    float ss = (acc[t4][0] * acc[t4][0] + acc[t4][1] * acc[t4][1]) + (acc[t4][2] * acc[t4][2] + acc[t4][3] * acc[t4][3]);
                    ss += __shfl_xor(ss, 16); ss += __shfl_xor(ss, 32);
                    if (fq == 0) SSX[wave * 64 + t4 * 16 + fr] = ss;
                }
                __syncthreads();
                const f32x4 nw = *(const f32x4*)(gnw + wave * 16 + 4 * fq);
#pragma unroll
                for (int t4 = 0; t4 < 4; ++t4) {
                    const int tr = t4 * 16 + fr;
                    float tot = 0.f;
#pragma unroll
                    for (int w8 = 0; w8 < 8; ++w8) tot += SSX[w8 * 64 + tr];
                    const float rs = rsqrtf(tot * (1.0f / 128.0f) + EPS);
                    const float y0 = acc[t4][0] * rs * nw.x * siluf(bflo(rw[t4].x)), y1 = acc[t4][1] * rs * nw.y * siluf(bfhi(rw[t4].x));
                    const float y2 = acc[t4][2] * rs * nw.z * siluf(bflo(rw[t4].y)), y3 = acc[t4][3] * rs * nw.w * siluf(bfhi(rw[t4].y));
                    u32x2 o; o.x = pk2(y0, y1); o.y = pk2(y2, y3);
                    *(u32x2*)(Y + (size_t)(ci.r0 + tr) * D + h * 128 + wave * 16 + 4 * fq) = o;
                }
            }
#pragma unroll
            for (int t4 = 0; t4 < 4; ++t4) R.zf[t4] = Rn.zf[t4];
        } else {
            const ChunkInfo ci = chunk_info(it - n_gla);
            const int c0 = (tid & 31) * 8, t0 = ci.r0 + (tid >> 5) * 4;
            {
                float z[6][8];
#pragma unroll
                for (int j = 0; j < 6; ++j) {
                    const int rr = t0 + j - 1; const bool ok = rr >= ci.seg_lo && rr < ci.seg_hi; const int rc = min(max(rr, ci.seg_lo), ci.seg_hi - 1);
                    const u32x4 cw = *(const u32x4*)(proj + PC + (size_t)rc * 768 + 256 + c0), hw = *(const u32x4*)(proj + PC + (size_t)rc * 768 + 512 + c0);
                    const unsigned cc[4] = {cw.x, cw.y, cw.z, cw.w}, hh[4] = {hw.x, hw.y, hw.z, hw.w};
#pragma unroll
                    for (int i = 0; i < 4; ++i) { z[j][2 * i] = ok ? bflo(cc[i]) * bflo(hh[i]) : 0.f; z[j][2 * i + 1] = ok ? bfhi(cc[i]) * bfhi(hh[i]) : 0.f; }
                }
                float w0[8], w1[8], w2[8];
#pragma unroll
                for (int i = 0; i < 8; ++i) { w0[i] = conv_w[c0 + i]; w1[i] = conv_w[256 + c0 + i]; w2[i] = conv_w[512 + c0 + i]; }
#pragma unroll
                for (int tt = 0; tt < 4; ++tt) {
                    const u32x4 bw = *(const u32x4*)(proj + PC + (size_t)(t0 + tt) * 768 + c0);
                    const unsigned bbv[4] = {bw.x, bw.y, bw.z, bw.w};
                    float yc[8];
#pragma unroll
                    for (int i = 0; i < 8; ++i) { const float bgv = (i & 1) ? bfhi(bbv[i >> 1]) : bflo(bbv[i >> 1]); yc[i] = bgv * (w0[i] * z[tt][i] + w1[i] * z[tt + 1][i] + w2[i] * z[tt + 2][i]); }
                    *(u32x4*)(Y + (size_t)(t0 + tt) * D + 512 + c0) = (u32x4){pk2(yc[0], yc[1]), pk2(yc[2], yc[3]), pk2(yc[4], yc[5]), pk2(yc[6], yc[7])};
                }
            }
            {
                const int pg = __builtin_amdgcn_readfirstlane(wave & 3);
                const int pc0 = pg * 64 + (lane & 7) * 8, pt0 = ci.r0 + ((wave >> 2) * 8 + (lane >> 3)) * 4;
                if (pg == 0) pool_rows<1>(proj, Y, pc0, pt0, ci.seg_lo, ci.seg_hi);
                else if (pg == 1) pool_rows<2>(proj, Y, pc0, pt0, ci.seg_lo, ci.seg_hi);
                else if (pg == 2) pool_rows<4>(proj, Y, pc0, pt0, ci.seg_lo, ci.seg_hi);
                else pool_rows<8>(proj, Y, pc0, pt0, ci.seg_lo, ci.seg_hi);
            }
        }
    }
}

#define XB_TMO      128
#define XB_XCNT(j)  (256  + 64 * (j))
#define XB_XSUB(j)  (1280 + 64 * (j))
#define XB_XGEN(j)  (2304 + 64 * (j))
#define XB_TOP      3328
#define XB_TOPGEN   3392
#define XCD_BAR_WORDS 3456
#define XB_SPIN_CAP (1u << 18)

__device__ __forceinline__ unsigned xb_ld(unsigned* p)              { return __hip_atomic_load(p, __ATOMIC_RELAXED, __HIP_MEMORY_SCOPE_AGENT); }
__device__ __forceinline__ unsigned xb_add(unsigned* p, unsigned v) { return __hip_atomic_fetch_add(p, v, __ATOMIC_RELAXED, __HIP_MEMORY_SCOPE_AGENT); }
__device__ __forceinline__ unsigned xb_xcc_id() { return (unsigned)__builtin_amdgcn_s_getreg((3 << 11) | 20) & 0xFu; }
#define XB_SPIN(cond, bar) do { unsigned _sp = 0; while (cond) { __builtin_amdgcn_s_sleep(1); \
    if ((++_sp & 255u) == 0u) { if (xb_ld(&(bar)[XB_TMO])) break; if (_sp > XB_SPIN_CAP) { atomicAdd(&(bar)[XB_TMO], 1u); break; } } } } while (0)

struct XcdBarrier {
    unsigned* bar; unsigned x;
    volatile LAS unsigned* st;
};

__device__ __forceinline__ XcdBarrier xcd_barrier_post(unsigned* bar, volatile LAS unsigned* st) {
    XcdBarrier b; b.bar = bar; b.x = xb_xcc_id(); b.st = st;
    if (threadIdx.x == 0) (void)xb_add(&bar[XB_XCNT(b.x)], 1u);
    return b;
}
__device__ __forceinline__ void xcd_barrier_complete(unsigned* bar, unsigned x, unsigned& nloc, unsigned& nx) {
    const unsigned G = gridDim.x * gridDim.y * gridDim.z;
    unsigned sum, cnt, mine, sp = 0u;
    for (;;) {
        sum = 0u; cnt = 0u; mine = 0u;
#pragma unroll
        for (unsigned j = 0; j < 16; ++j) { const unsigned c = xb_ld(&bar[XB_XCNT(j)]); sum += c; cnt += (c > 0u) ? 1u : 0u; mine = (j == x) ? c : mine; }
        if (sum == G) break;
        __builtin_amdgcn_s_sleep(1);
        if ((++sp & 255u) == 0u) { if (xb_ld(&bar[XB_TMO])) break; if (sp > XB_SPIN_CAP) { atomicAdd(&bar[XB_TMO], 1u); break; } }
    }
    nloc = mine > 0u ? mine : 1u; nx = cnt > 0u ? cnt : 1u;
}

__device__ __forceinline__ void xcd_barrier(const XcdBarrier& b) {
    asm volatile("s_waitcnt vmcnt(0)" ::: "memory");
    __syncthreads();
    if (threadIdx.x == 0) {
        unsigned* bar = b.bar; asm volatile("" : "+s"(bar));
        __builtin_amdgcn_s_waitcnt(0);
        unsigned nloc = b.st[0], nx = b.st[1];
        if (nloc == 0u) { xcd_barrier_complete(bar, b.x, nloc, nx); b.st[0] = nloc; b.st[1] = nx; }
        const unsigned old = xb_add(&bar[XB_XSUB(b.x)], 1u);
        const unsigned gen = old / nloc;
        if (old + 1u == (gen + 1u) * nloc) {
            __builtin_amdgcn_fence(__ATOMIC_RELEASE, "agent");
            asm volatile("s_waitcnt vmcnt(0)" ::: "memory");
            const unsigned og = xb_add(&bar[XB_TOP], 1u);
            const unsigned tg = og / nx;
            if (og + 1u == (tg + 1u) * nx) xb_add(&bar[XB_TOPGEN], 1u);
            else XB_SPIN(xb_ld(&bar[XB_TOPGEN]) == tg, bar);
            __builtin_amdgcn_fence(__ATOMIC_ACQUIRE, "agent");
            xb_add(&bar[XB_XGEN(b.x)], 1u);
            asm volatile("s_waitcnt vmcnt(0)" ::: "memory");
        } else {
            XB_SPIN(xb_ld(&bar[XB_XGEN(b.x)]) == gen, bar);
            __builtin_amdgcn_fence(__ATOMIC_ACQUIRE, "agent");
            asm volatile("s_waitcnt vmcnt(0)" ::: "memory");
        }
    }
    __syncthreads();
}


__global__ void __launch_bounds__(NTHREADS, 2) hybrid_fwd(Args a) {
    extern __shared__ __attribute__((aligned(16))) unsigned char smem[];
    LAS unsigned char* lds = (LAS unsigned char*)smem;
    cg::grid_group grid = cg::this_grid();
    const int G = gridDim.x;
    volatile LAS unsigned* bst = (volatile LAS unsigned*)(lds + 131072 + 64);
    if (tid_opaque() < 2) bst[tid_opaque()] = 0u;
    __syncthreads();
    const XcdBarrier bar = xcd_barrier_post((unsigned*)(a.ws + WS_BAR), bst);
#pragma unroll 1
    for (int ph = a.ph_lo; ph < a.ph_hi; ++ph) {
      {
        unsigned char* ws = a.ws; asm volatile("" : "+s"(ws));
        float* MOD = (float*)(ws + WS_MOD);
        bf16_t* H = (bf16_t*)a.out; bf16_t* X = (bf16_t*)(ws + WS_X); bf16_t* PROJ = (bf16_t*)(ws + WS_PROJ); bf16_t* Yb = (bf16_t*)(ws + WS_Y); bf16_t* ACT = (bf16_t*)(ws + WS_ACT);
        float* XC = (float*)(ws + WS_XC);
        if (ph == 0) { phase_prep(a, lds); }
        else if (ph == NPHASES - 1) { phase_final(X, a.out, a.in[18]); }
        else {
            const int l = (ph - 1) / 9, sp = (ph - 1) % 9;
            const float* xctx = l == 0 ? a.in[2] : XC;
            const float* mod = MOD + l * 3 * NMODV;
            const int mrows = l == 0 ? MALL : MLAT;
            if (sp == 0) phase_norm(l == 0 ? a.in[0] : nullptr, X, xctx, MALL, a.in[6] + l * D, mod, 0, 1024, H, (const float*)(ws + WS_PART), l == 0 ? 0 : FF / 256, XC, l == 0 ? X : nullptr);
            else if (sp == 1) {
                pg8::Gemm g{H, (const bf16_t*)(ws + WS_WIN) + (size_t)l * INP * D, MALL, INP, D, D}; pg8::StaticOrder S; S.init(MALL, INP, G, bid_opaque()); S.ntk = D / 64;
                EpiProj E{PROJ}; pg8::gemm_phase<EpiProj, pg8::StaticOrder, GEMM_ALIGN, GEMM_SP2>(lds, g, S, E);
            }
            else if (sp == 2) phase_gla_u(a, l, lds);
            else if (sp == 3) phase_gla_scan(a, lds);
            else if (sp == 4) phase_gla_out(a, l, mrows / 64, lds);
            else if (sp == 5 || sp == 8) {
                const bool mix = sp == 5; const int KK = mix ? D : FF;
                const bf16_t* Ap = mix ? Yb : ACT; const bf16_t* Bp = mix ? (const bf16_t*)(ws + WS_WOUT) + (size_t)l * D * D : (const bf16_t*)(ws + WS_W2) + (size_t)l * D * FF;
                const float* gate = mod + (mix ? 2048 : 5120);
                pg8::Gemm g{Ap, Bp, MALL, D, KK, KK};
                pg8::MixedOrder S; S.lat.init(MLAT, D, G, bid_opaque()); S.lat.ntk = KK / 64; S.nks = l == 0 ? KK / 256 : 0; S.kslice = 256;
                EpiRes E{nullptr, X, (float*)(ws + WS_PART), gate};
                pg8::gemm_phase<EpiRes, pg8::MixedOrder, GEMM_ALIGN, GEMM_SP2>(lds, g, S, E);
            }
            else if (sp == 6) phase_norm(nullptr, X, l == 0 ? a.in[2] : (const float*)XC, mrows, a.in[7] + l * D, mod, 3072, 4096, H, (const float*)(ws + WS_PART), l == 0 ? D / 256 : 0, XC, nullptr);
            else {
                pg8::Gemm g{H, (const bf16_t*)(ws + WS_W1) + (size_t)l * FF * D, mrows, FF, D, D}; pg8::StaticOrder S; S.init(mrows, FF, G, bid_opaque()); S.ntk = D / 64;
                EpiAct E{ACT}; pg8::gemm_phase<EpiAct, pg8::StaticOrder, GEMM_ALIGN, GEMM_SP2>(lds, g, S, E);
            }
        }
      }
        if (ph + 1 < a.ph_hi) {
            if (a.ph_hi > NPHASES) {
                __builtin_amdgcn_fence(__ATOMIC_RELEASE, "agent"); asm volatile("s_waitcnt vmcnt(0)" ::: "memory");
                grid.sync();
                __builtin_amdgcn_fence(__ATOMIC_ACQUIRE, "agent"); asm volatile("s_waitcnt vmcnt(0)" ::: "memory");
            }
            xcd_barrier(bar);
        }
    }
}

extern "C" void kernel_launch(void* const* d_in, const int* in_sizes, int n_in, void* d_out, int out_size, void* d_ws, size_t ws_size, hipStream_t stream) {
    static int grid = 0;
    if (grid == 0) {
        int dev = 0, cus = 0, per_cu = 0;
        hipGetDevice(&dev);
        hipDeviceGetAttribute(&cus, hipDeviceAttributeMultiprocessorCount, dev);
        hipFuncSetAttribute((const void*)hybrid_fwd, hipFuncAttributeMaxDynamicSharedMemorySize, LDS_BYTES);
        hipOccupancyMaxActiveBlocksPerMultiprocessor(&per_cu, (const void*)hybrid_fwd, NTHREADS, LDS_BYTES);
        if (per_cu < 1) { fprintf(stderr, "kernel_launch: occupancy query reports %d blocks per CU\n", per_cu); per_cu = 1; }
        (void)hipGetLastError();
        grid = cus * per_cu;
        if (n_in != 19 || ws_size < WS_END) fprintf(stderr, "kernel_launch: unexpected n_in %d / ws_size %zu\n", n_in, ws_size);
    }
    (void)hipMemsetAsync((char*)d_ws + WS_BAR, 0, BAR_BYTES, stream);
    Args a{};
    for (int i = 0; i < 19; ++i) a.in[i] = (const float*)d_in[i];
    a.out = (float*)d_out; a.ws = (unsigned char*)d_ws;
    a.ph_lo = 0; a.ph_hi = NPHASES;
    void* args[] = {&a};
    hipError_t e = hipLaunchCooperativeKernel((const void*)hybrid_fwd, dim3(grid), dim3(NTHREADS), args, LDS_BYTES, stream);
    if (e != hipSuccess) fprintf(stderr, "cooperative launch failed: %s (grid %d)\n", hipGetErrorString(e), grid);
}
```

```cpp
#include <hip/hip_runtime.h>
#include <hip/hip_cooperative_groups.h>
#include <cstdio>
namespace cg = cooperative_groups;
__device__ __forceinline__ int tid_opaque() { int t = threadIdx.x; asm volatile("" : "+v"(t)); return t; }
__device__ __forceinline__ int bid_opaque() { int t = blockIdx.x; asm volatile("" : "+s"(t)); return t; }
namespace pg8 {
#define PG8_LAS __attribute__((address_space(3)))
typedef unsigned short bf16_t;
typedef short bf16x8 __attribute__((ext_vector_type(8)));
typedef float f32x4 __attribute__((ext_vector_type(4)));
typedef unsigned u32x4 __attribute__((ext_vector_type(4)));
constexpr int BM = 256, BK = 64, HALF = 128, HTB = HALF * BK * 2  , STAGE_BYTES = 8 * HTB, NXCD = 8, WGM = 4;

__host__ __device__ __forceinline__ int lds_byte(int r, int c) { const int st = (r >> 4) * 2 + (c >> 5), rr = r & 15, cc = c & 31, ob = rr * 64 + cc * 2; return st * 1024 + (ob ^ (((ob >> 9) & 1) << 5)); }
__host__ __device__ __forceinline__ void stage_rc(int b, int& R, int& C) { const int st = b / 1024, sb = b % 1024, swz = sb ^ (((sb >> 9) & 1) << 5); R = (st >> 1) * 16 + swz / 64; C = (st & 1) * 32 + (swz % 64) / 2; }
__host__ __device__ __forceinline__ int perm32(int rho) { const int n = rho >> 4, i = rho & 15; return 8 * (i >> 2) + 4 * n + (i & 3); }

struct Unit { int pm, pn, kofs, nt; };
struct Gemm { const bf16_t* A; const bf16_t* Bt; int M, N, K, ld; };

struct StaticOrder {
    int nM, nN, nwg, G, c, ntk;
    __host__ __device__ void init(int M, int N, int G_, int c_) { nM = M / BM; nN = N / BM; nwg = nM * nN; G = G_; c = c_; }
    __host__ __device__ bool next(int i, Unit& u) const {
        const long L = (long)i * G + c; if (L >= nwg) return false;
        int wgid = (int)L; { const int q = nwg / NXCD, r = nwg % NXCD, xcd = wgid % NXCD, off = wgid / NXCD; wgid = (xcd < r ? xcd * (q + 1) : r * (q + 1) + (xcd - r) * q) + off; }
        const int nig = WGM * nN, gid = wgid / nig, fm = gid * WGM, gsz = (nM - fm) < WGM ? (nM - fm) : WGM;
        u.pm = fm + ((wgid % nig) % gsz); u.pn = (wgid % nig) / gsz; u.kofs = 0; u.nt = ntk; return true;
    }
    __device__ __forceinline__ void a_ready(const Unit&) const {}
    __device__ __forceinline__ void done(const Unit&) const {}
};
struct MixedOrder {
    StaticOrder lat; int nks, kslice;
    __device__ __forceinline__ bool next(int i, Unit& u) const {
        const int L = i * lat.G + lat.c;
        if (L < lat.nwg) return lat.next(i, u);
        const int j = L - lat.nwg; if (j >= 8 * nks) return false;
        u.pm = 64 + (j & 1); u.pn = (j >> 1) & 3; u.kofs = (j >> 3) * kslice; u.nt = kslice / BK; return true;
    }
    __device__ __forceinline__ void a_ready(const Unit&) const {}
    __device__ __forceinline__ void done(const Unit&) const {}
};
__device__ __forceinline__ unsigned cvt_pk_bf16(float lo, float hi) { unsigned r; asm volatile("v_cvt_pk_bf16_f32 %0, %1, %2" : "=v"(r) : "v"(lo), "v"(hi)); return r; }
template <class Epi, class Sched, bool ALIGN_EPI = false, bool SP2 = false>
__device__ __forceinline__ void gemm_phase(PG8_LAS unsigned char* lds, const Gemm g, const Sched& S, const Epi& E) {
    const int tid = tid_opaque(), wid = __builtin_amdgcn_readfirstlane(tid >> 6), lane = tid & 63, wr = wid >> 2, wc = wid & 3, fr = lane & 15, fq = lane >> 4;
    const int LD = g.ld;
    unsigned voffA[2], voffB[2];
#pragma unroll
    for (int i = 0; i < 2; ++i) { int R, C; stage_rc(tid * 16 + i * 8192, R, C); const int Rb = Epi::PERM ? ((R & ~31) + perm32(R & 31)) : R;
        voffA[i] = (unsigned)(R * LD + C) * 2u; voffB[i] = (unsigned)(Rb * LD + C) * 2u; }
    const size_t kstep = (size_t)(BK * 2);
    const size_t hstep = (size_t)HALF * LD * 2;
    const size_t tstep = 2 * hstep;
    const unsigned ldsw = (unsigned)wid * 1024u;
    const int aoff = lds_byte(wr * 64 + fr, fq * 8), boff = lds_byte(wc * 32 + fr, fq * 8);
#define PG8_SA(b, h) (((b) * 2 + (h)) * HTB)
#define PG8_SB(b, h) ((4 + (b) * 2 + (h)) * HTB)
#define PG8_STAGE(bufoff, gbase, voff) do { _Pragma("unroll") for (int _i = 0; _i < 2; ++_i) \
        __builtin_amdgcn_global_load_lds((const unsigned*)((const char*)(gbase) + (voff)[_i]), (PG8_LAS unsigned*)(lds + (bufoff) + ldsw + _i * 8192), 16, 0, 0); } while (0)
#define PG8_LDA(dst, b, h) do { _Pragma("unroll") for (int m = 0; m < 4; ++m) _Pragma("unroll") for (int k = 0; k < 2; ++k) dst[m][k] = *(const PG8_LAS bf16x8*)(lds + PG8_SA(b, h) + aoff + m * 2048 + k * 1024); } while (0)
#define PG8_LDB(dst, b, h) do { _Pragma("unroll") for (int n = 0; n < 2; ++n) _Pragma("unroll") for (int k = 0; k < 2; ++k) dst[n][k] = *(const PG8_LAS bf16x8*)(lds + PG8_SB(b, h) + boff + n * 2048 + k * 1024); } while (0)
#define PG8_MMA(ai, bj, At, Bt) do { __builtin_amdgcn_s_setprio(1); _Pragma("unroll") for (int m = 0; m < 4; ++m) _Pragma("unroll") for (int n = 0; n < 2; ++n) _Pragma("unroll") for (int k = 0; k < 2; ++k) \
        acc[ai][bj][m][n] = __builtin_amdgcn_mfma_f32_16x16x32_bf16(Bt[n][k], At[m][k], acc[ai][bj][m][n], 0, 0, 0); __builtin_amdgcn_s_setprio(0); } while (0)
#define PG8_WAIT_V(n) asm volatile("s_waitcnt vmcnt(" #n ")" ::: "memory")
#define PG8_WAIT_L(n) asm volatile("s_waitcnt lgkmcnt(" #n ")" ::: "memory")
#define PG8_BAR __builtin_amdgcn_s_barrier()
#define PG8_SCHED __builtin_amdgcn_sched_barrier(0)
    Unit cur, nxt; int ui = 0;
    if (!S.next(0, cur)) return;
    f32x4 acc[2][2][4][2];
#pragma unroll
    for (int a = 0; a < 2; ++a)
#pragma unroll
        for (int b = 0; b < 2; ++b)
#pragma unroll
            for (int m = 0; m < 4; ++m)
#pragma unroll
                for (int n = 0; n < 2; ++n) acc[a][b][m][n] = (f32x4){0.f, 0.f, 0.f, 0.f};
    bf16x8 At[4][2], B0[2][2], B1[2][2];
    const char* cA = (const char*)g.A + (size_t)cur.pm * tstep + (size_t)cur.kofs * 2; const char* cB = (const char*)g.Bt + (size_t)cur.pn * tstep + (size_t)cur.kofs * 2;
    S.a_ready(cur);
    if constexpr (SP2) {
        PG8_STAGE(PG8_SB(0, 0), cB, voffB); PG8_STAGE(PG8_SB(0, 1), cB + hstep, voffB); PG8_STAGE(PG8_SA(0, 0), cA, voffA); PG8_STAGE(PG8_SA(0, 1), cA + hstep, voffA);
        if (wr == 1) PG8_BAR;
        PG8_WAIT_V(2); PG8_BAR;
        PG8_STAGE(PG8_SB(1, 0), cB + kstep, voffB); PG8_STAGE(PG8_SA(1, 0), cA + kstep, voffA); PG8_STAGE(PG8_SB(1, 1), cB + hstep + kstep, voffB);
        PG8_WAIT_V(6); PG8_BAR;
    } else {
        PG8_STAGE(PG8_SB(0, 0), cB, voffB); PG8_STAGE(PG8_SA(0, 0), cA, voffA); PG8_STAGE(PG8_SB(0, 1), cB + hstep, voffB); PG8_STAGE(PG8_SA(0, 1), cA + hstep, voffA);
        if (wr == 1) PG8_BAR;
        PG8_WAIT_V(4); PG8_BAR;
        PG8_STAGE(PG8_SB(1, 0), cB + kstep, voffB); PG8_STAGE(PG8_SA(1, 0), cA + kstep, voffA); PG8_STAGE(PG8_SB(1, 1), cB + hstep + kstep, voffB);
        PG8_WAIT_V(6); PG8_BAR;
    }
    for (;;) {
        const bool has_next = S.next(ui + 1, nxt);
        const char* nA = has_next ? (const char*)g.A + (size_t)nxt.pm * tstep + (size_t)nxt.kofs * 2 : cA; const char* nB = has_next ? (const char*)g.Bt + (size_t)nxt.pn * tstep + (size_t)nxt.kofs * 2 : cB;
        const int nt = cur.nt;
        for (int t = 0; t < nt; t += 2) {
            const bool last = (t == nt - 2);
            const char* a1 = cA + (size_t)(t + 1) * kstep;
            const char* a2 = last ? nA : cA + (size_t)(t + 2) * kstep; const char* b2 = last ? nB : cB + (size_t)(t + 2) * kstep;
            const char* a3 = a2 + kstep; const char* b3 = b2 + kstep;
            if (last && has_next) S.a_ready(nxt);
            if constexpr (SP2) {
            PG8_LDB(B0, 0, 0); PG8_LDB(B1, 0, 1); PG8_SCHED; PG8_LDA(At, 0, 0); PG8_STAGE(PG8_SA(1, 1), a1 + hstep, voffA);
            PG8_WAIT_V(8); PG8_WAIT_L(0); PG8_BAR; PG8_MMA(0, 0, At, B0); PG8_MMA(0, 1, At, B1); PG8_BAR; PG8_SCHED;
            PG8_LDA(At, 0, 1); PG8_STAGE(PG8_SB(0, 0), b2, voffB); PG8_STAGE(PG8_SB(0, 1), b2 + hstep, voffB); PG8_STAGE(PG8_SA(0, 0), a2, voffA);
            PG8_WAIT_V(8); PG8_WAIT_L(0); PG8_BAR; PG8_MMA(1, 0, At, B0); PG8_MMA(1, 1, At, B1); PG8_BAR; PG8_SCHED;
            PG8_LDB(B0, 1, 0); PG8_LDB(B1, 1, 1); PG8_SCHED; PG8_LDA(At, 1, 0); PG8_STAGE(PG8_SA(0, 1), a2 + hstep, voffA);
            PG8_WAIT_V(8); PG8_WAIT_L(0); PG8_BAR; PG8_MMA(0, 0, At, B0); PG8_MMA(0, 1, At, B1); PG8_BAR; PG8_SCHED;
            PG8_LDA(At, 1, 1); PG8_STAGE(PG8_SB(1, 0), b3, voffB); PG8_STAGE(PG8_SB(1, 1), b3 + hstep, voffB); PG8_STAGE(PG8_SA(1, 0), a3, voffA);
            PG8_WAIT_V(8); PG8_WAIT_L(0); PG8_BAR; PG8_MMA(1, 0, At, B0); PG8_MMA(1, 1, At, B1); PG8_BAR; PG8_SCHED;
            } else {
            PG8_LDB(B0, 0, 0); PG8_SCHED; PG8_LDA(At, 0, 0); PG8_STAGE(PG8_SA(1, 1), a1 + hstep, voffA);
            PG8_WAIT_L(8); PG8_BAR; PG8_WAIT_L(0); PG8_MMA(0, 0, At, B0); PG8_BAR; PG8_SCHED;
            PG8_LDB(B1, 0, 1); PG8_STAGE(PG8_SB(0, 0), b2, voffB);
            PG8_BAR; PG8_WAIT_L(0); PG8_MMA(0, 1, At, B1); PG8_BAR;
            PG8_LDA(At, 0, 1); PG8_STAGE(PG8_SA(0, 0), a2, voffA);
            PG8_BAR; PG8_WAIT_L(0); PG8_MMA(1, 0, At, B0); PG8_BAR; PG8_SCHED;
            PG8_STAGE(PG8_SB(0, 1), b2 + hstep, voffB);
            PG8_WAIT_V(6); PG8_BAR; PG8_MMA(1, 1, At, B1); PG8_BAR;
            PG8_LDB(B0, 1, 0); PG8_SCHED; PG8_LDA(At, 1, 0); PG8_STAGE(PG8_SA(0, 1), a2 + hstep, voffA);
            PG8_WAIT_L(8); PG8_BAR; PG8_WAIT_L(0); PG8_MMA(0, 0, At, B0); PG8_BAR; PG8_SCHED;
            PG8_LDB(B1, 1, 1); PG8_STAGE(PG8_SB(1, 0), b3, voffB);
            PG8_BAR; PG8_WAIT_L(0); PG8_MMA(0, 1, At, B1); PG8_BAR;
            PG8_LDA(At, 1, 1); PG8_STAGE(PG8_SA(1, 0), a3, voffA);
            PG8_BAR; PG8_WAIT_L(0); PG8_MMA(1, 0, At, B0); PG8_BAR; PG8_SCHED;
            PG8_STAGE(PG8_SB(1, 1), b3 + hstep, voffB);
            PG8_WAIT_V(6); PG8_BAR; PG8_MMA(1, 1, At, B1); PG8_BAR;
            }
        }
        if constexpr (ALIGN_EPI) { if (wr == 0) PG8_BAR; }
        if constexpr (!Epi::AFTER_DRAIN) { E(acc, cur, wr, wc, fr, fq); S.done(cur); }
        if (!has_next) break;
#pragma unroll
        for (int a = 0; a < 2; ++a)
#pragma unroll
            for (int b = 0; b < 2; ++b)
#pragma unroll
                for (int m = 0; m < 4; ++m)
#pragma unroll
                    for (int n = 0; n < 2; ++n) acc[a][b][m][n] = (f32x4){0.f, 0.f, 0.f, 0.f};
        cur = nxt; cA = nA; cB = nB; ++ui;
        if constexpr (ALIGN_EPI) { if (wr == 1) PG8_BAR; }
    }
    PG8_WAIT_V(0);
    if constexpr (!ALIGN_EPI) { if (wr == 0) PG8_BAR; }
    PG8_BAR;
    if constexpr (Epi::AFTER_DRAIN) { E.fused(acc, cur, wr, wc, fr, fq, lds, wid, lane); S.done(cur); }
#undef PG8_SA
#undef PG8_SB
#undef PG8_STAGE
#undef PG8_LDA
#undef PG8_LDB
#undef PG8_MMA
#undef PG8_WAIT_V
#undef PG8_WAIT_L
#undef PG8_BAR
#undef PG8_SCHED
}
}

#define LAS __attribute__((address_space(3)))
typedef unsigned short bf16_t;
typedef short bf16x8 __attribute__((ext_vector_type(8)));
typedef float f32x4 __attribute__((ext_vector_type(4)));
typedef unsigned u32x4 __attribute__((ext_vector_type(4)));
typedef unsigned u32x2 __attribute__((ext_vector_type(2)));

#ifndef GEMM_SP2
#define GEMM_SP2 true
#endif
#ifndef GEMM_ALIGN
#define GEMM_ALIGN true
#endif

constexpr int D = 1024, MLAT = 16384, MCTX = 512, MALL = 16896, HALFLAT = 8192;
constexpr int INC = 2592, INP = 2816, FF = 4096;
constexpr int K_OFF = 256, V_OFF = 512, G_OFF = 1024, R_OFF = 1056, CB_OFF = 1568, CC_OFF = 1824, CH_OFF = 2080, P_OFF = 2336;
constexpr int NPOS = 132, NMODV = 6144;
constexpr size_t PQ = 0, PK = PQ + (size_t)4 * MALL * 64, PV = PK + (size_t)4 * MALL * 64, PZ = PV + (size_t)4 * MALL * 128, PR = PZ + (size_t)MALL * 32,
                 PC = PR + (size_t)4 * MALL * 128, PP = PC + (size_t)MALL * 768;
static_assert(PP + (size_t)MALL * 256 == (size_t)MALL * INC, "PROJ segments");
constexpr float EPS = 1e-6f;
constexpr int NTHREADS = 512, NWAVES = 8;
constexpr int LDS_BYTES = 147456;
constexpr int NPHASES = 20;

constexpr size_t MiB = 1u << 20;
constexpr size_t WS_MOD = 0;
constexpr size_t WS_WIN = 1 * MiB;
constexpr size_t WS_WOUT = 12 * MiB;
constexpr size_t WS_W1 = 16 * MiB;
constexpr size_t WS_W2 = 32 * MiB;
constexpr size_t WS_XC = 48 * MiB;
constexpr size_t WS_X = 50 * MiB;
constexpr size_t WS_PROJ = 83 * MiB;
constexpr size_t WS_Y = 167 * MiB;
constexpr size_t WS_ACT = 83 * MiB;
constexpr size_t WS_S = 215 * MiB;
constexpr size_t WS_PART = 215 * MiB;
constexpr size_t WS_DEC = 248 * MiB;
constexpr size_t WS_BAR = 250 * MiB;
constexpr size_t BAR_BYTES = 16384;
constexpr size_t WS_END = 251 * MiB;

struct Args {
    const float* in[19];
    float* out;
    unsigned char* ws;
    int ph_lo, ph_hi;
};

__device__ __forceinline__ float bf2f(unsigned h) { return __uint_as_float(h << 16); }
__device__ __forceinline__ float bflo(unsigned w) { return __uint_as_float(w << 16); }
__device__ __forceinline__ float bfhi(unsigned w) { return __uint_as_float(w & 0xffff0000u); }
typedef __bf16 bf16v2_t __attribute__((ext_vector_type(2)));
typedef float f32v2_t __attribute__((ext_vector_type(2)));
__device__ __forceinline__ unsigned pk2(float lo, float hi) { const f32v2_t v = {lo, hi}; const bf16v2_t b = __builtin_convertvector(v, bf16v2_t); return __builtin_bit_cast(unsigned, b); }
__device__ __forceinline__ bf16_t f2bf(float f) { return (bf16_t)(pk2(f, 0.f) & 0xffffu); }
__device__ __forceinline__ float wave_sum(float v) {
#pragma unroll
    for (int o = 1; o < 64; o <<= 1) v += __shfl_xor(v, o);
    return v;
}
__device__ __forceinline__ float siluf(float x) { return x * __builtin_amdgcn_rcpf(1.0f + __builtin_amdgcn_exp2f(-1.4426950409f * x)); }
__device__ __forceinline__ int modvec_of_row(int row) { return row < HALFLAT ? 0 : (row < MLAT ? 1 : 2); }

struct EpiProj {
    static constexpr bool PERM = true, AFTER_DRAIN = false;
    bf16_t* O;
    __device__ __forceinline__ void operator()(const f32x4 (&acc)[2][2][4][2], const pg8::Unit& u, int wr, int wc, int fr, int fq) const {
        const int row0 = u.pm * 256 + wr * 64 + fr, colt = u.pn * 256;
#pragma unroll
        for (int bj = 0; bj < 2; ++bj) {
            const int cb = colt + bj * 128 + wc * 32;
            if (cb >= INC) continue;
            size_t off0; int pitch;
            if (cb < K_OFF)       { off0 = PQ + (size_t)(cb >> 6) * MALL * 64 + (cb & 63); pitch = 64; }
            else if (cb < V_OFF)  { const int c = cb - K_OFF;  off0 = PK + (size_t)(c >> 6) * MALL * 64 + (c & 63); pitch = 64; }
            else if (cb < G_OFF)  { const int c = cb - V_OFF;  off0 = PV + (size_t)(c >> 7) * MALL * 128 + (c & 127); pitch = 128; }
            else if (cb < R_OFF)  { off0 = PZ; pitch = 32; }
            else if (cb < CB_OFF) { const int c = cb - R_OFF;  off0 = PR + (size_t)(c >> 7) * MALL * 128 + (c & 127); pitch = 128; }
            else if (cb < P_OFF)  { off0 = PC + (cb - CB_OFF); pitch = 768; }
            else                  { off0 = PP + (cb - P_OFF); pitch = 256; }
            bf16_t* base = O + off0 + 8 * fq;
#pragma unroll
            for (int ai = 0; ai < 2; ++ai)
#pragma unroll
                for (int m = 0; m < 4; ++m) {
                    const f32x4 v0 = acc[ai][bj][m][0], v1 = acc[ai][bj][m][1];
                    u32x4 w; w.x = pk2(v0[0], v0[1]); w.y = pk2(v0[2], v0[3]); w.z = pk2(v1[0], v1[1]); w.w = pk2(v1[2], v1[3]);
                    *(u32x4*)(base + (size_t)(row0 + ai * 128 + m * 16) * pitch) = w;
                }
        }
    }
};
struct EpiAct {
    static constexpr bool PERM = true, AFTER_DRAIN = false;
    bf16_t* O;
    __device__ __forceinline__ void operator()(const f32x4 (&acc)[2][2][4][2], const pg8::Unit& u, int wr, int wc, int fr, int fq) const {
        const int row0 = u.pm * 256 + wr * 64 + fr, colt = u.pn * 256;
#pragma unroll
        for (int ai = 0; ai < 2; ++ai)
#pragma unroll
            for (int m = 0; m < 4; ++m) {
                bf16_t* rowp = O + (size_t)(row0 + ai * 128 + m * 16) * FF + colt + wc * 32 + 8 * fq;
#pragma unroll
                for (int bj = 0; bj < 2; ++bj) {
                    f32x4 v0 = acc[ai][bj][m][0], v1 = acc[ai][bj][m][1];
#pragma unroll
                    for (int j = 0; j < 4; ++j) { const float a = fmaxf(v0[j], 0.f), b = fmaxf(v1[j], 0.f); v0[j] = a * a; v1[j] = b * b; }
                    u32x4 w; w.x = pk2(v0[0], v0[1]); w.y = pk2(v0[2], v0[3]); w.z = pk2(v1[0], v1[1]); w.w = pk2(v1[2], v1[3]);
                    *(u32x4*)(rowp + bj * 128) = w;
                }
            }
    }
};
struct EpiRes {
    static constexpr bool PERM = true, AFTER_DRAIN = false;
    const float* xin_f32; bf16_t* X; float* part; const float* gate;
    __device__ __forceinline__ void operator()(const f32x4 (&acc)[2][2][4][2], const pg8::Unit& u, int wr, int wc, int fr, int fq) const {
        asm volatile("" ::: "memory");
        const int rbase = __builtin_amdgcn_readfirstlane(u.pm * 256), cbase = __builtin_amdgcn_readfirstlane(u.pn * 256);
        const unsigned c32 = (unsigned)(wc * 32 + 8 * fq), o32 = (unsigned)((wr * 64 + fr) * D) + c32;
        if (rbase < MLAT) {
            const float* gp = gate + (rbase < HALFLAT ? 0 : NMODV) + cbase;
            f32x4 gv[2][2];
#pragma unroll
            for (int bj = 0; bj < 2; ++bj)
#pragma unroll
                for (int n = 0; n < 2; ++n) gv[bj][n] = *(const f32x4*)(gp + c32 + bj * 128 + 4 * n);
            bf16_t* xo = X + (size_t)rbase * D + cbase;
            if (xin_f32) {
                const float* xi = xin_f32 + (size_t)rbase * D + cbase;
#pragma unroll
                for (int ai = 0; ai < 2; ++ai) {
                    f32x4 xv[4][2][2];
#pragma unroll
                    for (int m = 0; m < 4; ++m)
#pragma unroll
                        for (int bj = 0; bj < 2; ++bj)
#pragma unroll
                            for (int n = 0; n < 2; ++n) xv[m][bj][n] = *(const f32x4*)(xi + (size_t)(ai * 128 + m * 16) * D + o32 + bj * 128 + 4 * n);
#pragma unroll
                    for (int m = 0; m < 4; ++m)
#pragma unroll
                        for (int bj = 0; bj < 2; ++bj) {
                            const f32x4 y0 = xv[m][bj][0] + gv[bj][0] * acc[ai][bj][m][0], y1 = xv[m][bj][1] + gv[bj][1] * acc[ai][bj][m][1];
                            *(u32x4*)(xo + (size_t)(ai * 128 + m * 16) * D + o32 + bj * 128) = (u32x4){pk2(y0[0], y0[1]), pk2(y0[2], y0[3]), pk2(y1[0], y1[1]), pk2(y1[2], y1[3])};
                        }
                    asm volatile("" ::: "memory");
                }
            } else {
#pragma unroll
                for (int ai = 0; ai < 2; ++ai) {
                    u32x4 xb[4][2];
#pragma unroll
                    for (int m = 0; m < 4; ++m)
#pragma unroll
                        for (int bj = 0; bj < 2; ++bj) xb[m][bj] = *(const u32x4*)(xo + (size_t)(ai * 128 + m * 16) * D + o32 + bj * 128);
#pragma unroll
                    for (int m = 0; m < 4; ++m)
#pragma unroll
                        for (int bj = 0; bj < 2; ++bj) {
                            const u32x4 w = xb[m][bj];
                            const f32x4 x0 = (f32x4){bflo(w.x), bfhi(w.x), bflo(w.y), bfhi(w.y)}, x1 = (f32x4){bflo(w.z), bfhi(w.z), bflo(w.w), bfhi(w.w)};
                            const f32x4 y0 = x0 + gv[bj][0] * acc[ai][bj][m][0], y1 = x1 + gv[bj][1] * acc[ai][bj][m][1];
                            *(u32x4*)(xo + (size_t)(ai * 128 + m * 16) * D + o32 + bj * 128) = (u32x4){pk2(y0[0], y0[1]), pk2(y0[2], y0[3]), pk2(y1[0], y1[1]), pk2(y1[2], y1[3])};
                        }
                    asm volatile("" ::: "memory");
                }
            }
        } else {
            float* xo = part + ((size_t)(u.kofs >> 8) * MCTX + (size_t)(rbase - MLAT)) * D + cbase; const float* gp = gate + 2 * NMODV + cbase;
#pragma unroll
            for (int ai = 0; ai < 2; ++ai)
#pragma unroll
                for (int m = 0; m < 4; ++m) {
                    float* xw = xo + (size_t)(ai * 128 + m * 16) * D;
#pragma unroll
                    for (int bj = 0; bj < 2; ++bj)
#pragma unroll
                        for (int n = 0; n < 2; ++n) {
                            const f32x4 gv = *(const f32x4*)(gp + c32 + bj * 128 + 4 * n);
                            *(f32x4*)(xw + o32 + bj * 128 + 4 * n) = gv * acc[ai][bj][m][n];
                        }
                    asm volatile("" ::: "memory");
                }
        }
    }
};

__device__ __forceinline__ void transpose_item(const float* W, int N, bf16_t* WT, int ldt, LAS float* scr, int item, int lane) {
    const int nblk = N / 32, kb = item / nblk, nb = item % nblk, k0 = 64 * kb, n0 = 32 * nb;
#pragma unroll 8
    for (int i = 0; i < 32; ++i) { const int kk = 2 * i + (lane >> 5); scr[kk * 33 + (lane & 31)] = W[(size_t)(k0 + kk) * N + n0 + (lane & 31)]; }
    asm volatile("s_waitcnt lgkmcnt(0)" ::: "memory");
    const int c = lane & 7;
#pragma unroll
    for (int j = 0; j < 4; ++j) { const int n = (lane >> 3) + 8 * j; const LAS float* s = scr + (8 * c) * 33 + n;
        u32x4 o; o.x = pk2(s[0 * 33], s[1 * 33]); o.y = pk2(s[2 * 33], s[3 * 33]); o.z = pk2(s[4 * 33], s[5 * 33]); o.w = pk2(s[6 * 33], s[7 * 33]);
        *(u32x4*)(WT + (size_t)(n0 + n) * ldt + k0 + 8 * c) = o; }
    asm volatile("s_waitcnt lgkmcnt(0)" ::: "memory");
}

__device__ __forceinline__ void phase_prep(const Args& a, LAS unsigned char* lds) {
    const int tid = tid_opaque(), lane = tid & 63, wave = tid >> 6, G = gridDim.x;
    unsigned char* ws = a.ws;
    {
        LAS float* sc = (LAS float*)lds;
        LAS float* part = (LAS float*)(lds + 12288);
        bool have = false;
        for (int it = bid_opaque(); it < 192; it += G) {
            if (!have) {
                for (int i = tid; i < 3072; i += NTHREADS) { const int v = i >> 10, k = i & 1023; const float cv = v < 2 ? a.in[1][v * D + k] : a.in[3][k]; sc[i] = siluf(cv); }
                have = true; __syncthreads();
            }
            const int l = it / 96, cgp = it % 96, col = tid & 63, ks = tid >> 6;
            const float* W = a.in[4] + (size_t)l * D * NMODV + cgp * 64 + col;
            float a0 = 0.f, a1 = 0.f, a2 = 0.f;
#pragma unroll 32
            for (int k = ks * 128; k < ks * 128 + 128; ++k) { const float w = W[(size_t)k * NMODV]; a0 += sc[k] * w; a1 += sc[1024 + k] * w; a2 += sc[2048 + k] * w; }
            part[(ks * 3 + 0) * 64 + col] = a0; part[(ks * 3 + 1) * 64 + col] = a1; part[(ks * 3 + 2) * 64 + col] = a2;
            __syncthreads();
            if (tid < 192) { const int v = tid >> 6, c2 = tid & 63; float s = a.in[5][l * NMODV + cgp * 64 + c2];
#pragma unroll
                for (int q = 0; q < 8; ++q) s += part[(q * 3 + v) * 64 + c2];
                ((float*)(ws + WS_MOD))[(l * 3 + v) * NMODV + cgp * 64 + c2] = s; }
            __syncthreads();
        }
        __syncthreads();
    }
    {
        LAS float* scr = (LAS float*)(lds + wave * 16384);
        const int gw = bid_opaque() * NWAVES + wave, NGW = G * NWAVES;
        constexpr int I_IN = 16 * 81, I_OUT = 12 * 32, I_1 = 16 * 128, I_2 = 64 * 32, I_L = I_IN + I_OUT + I_1 + I_2;
        for (int it = gw; it < 2 * I_L; it += NGW) {
            const int l = it / I_L; int r = it % I_L;
            if (r < I_IN) { transpose_item(a.in[8] + (size_t)l * D * INC, INC, (bf16_t*)(ws + WS_WIN) + (size_t)l * INP * D, D, scr, r, lane); continue; } r -= I_IN;
            if (r < I_OUT) { transpose_item(a.in[15] + (size_t)l * D * D, D, (bf16_t*)(ws + WS_WOUT) + (size_t)l * D * D, D, scr, r, lane); continue; } r -= I_OUT;
            if (r < I_1) { transpose_item(a.in[16] + (size_t)l * D * FF, FF, (bf16_t*)(ws + WS_W1) + (size_t)l * FF * D, D, scr, r, lane); continue; } r -= I_1;
            transpose_item(a.in[17] + (size_t)l * FF * D, D, (bf16_t*)(ws + WS_W2) + (size_t)l * D * FF, FF, scr, r, lane);
        }
        for (int i = bid_opaque() * NTHREADS + tid; i < 2 * 224 * 128; i += G * NTHREADS) {
            const int l = i / (224 * 128), r = i % (224 * 128);
            *(u32x4*)((bf16_t*)(ws + WS_WIN) + (size_t)l * INP * D + (size_t)INC * D + (size_t)r * 8) = (u32x4){0u, 0u, 0u, 0u};
        }
    }
    {
        for (int i = bid_opaque() * NTHREADS + tid; i < 2 * 32 * 1024; i += G * NTHREADS) {
            const int l = i >> 15, r = i & 32767, n = r & 1023, kc8 = (r >> 10) * 8, g = kc8 >> 6, c0 = kc8 & 63;
            const float* pw = a.in[13] + ((size_t)(l * 4 + g) * 64 + c0) * 64;
            const float* sc = a.in[14] + l * 256 + g * 64;
            const float* wo = a.in[15] + (size_t)l * D * D + (size_t)(768 + g * 64) * D + n;
            float acc[8];
#pragma unroll
            for (int j = 0; j < 8; ++j) acc[j] = 0.f;
            for (int d = 0; d < 64; ++d) { const float w = wo[(size_t)d * D] * sc[d];
#pragma unroll
                for (int j = 0; j < 8; ++j) acc[j] += pw[j * 64 + d] * w; }
            u32x4 o; o.x = pk2(acc[0], acc[1]); o.y = pk2(acc[2], acc[3]); o.z = pk2(acc[4], acc[5]); o.w = pk2(acc[6], acc[7]);
            *(u32x4*)((bf16_t*)(ws + WS_WOUT) + (size_t)l * D * D + (size_t)n * D + 768 + kc8) = o;
        }
    }
}

__device__ __forceinline__ void load_row_f32(f32x4 (&v)[4], const float* p, int lane) {
#pragma unroll
    for (int j = 0; j < 2; ++j) { v[2 * j] = *(const f32x4*)(p + 8 * lane + 512 * j); v[2 * j + 1] = *(const f32x4*)(p + 8 * lane + 512 * j + 4); }
}
__device__ __forceinline__ void load_row_bf16(f32x4 (&v)[4], const bf16_t* p, int lane) {
#pragma unroll
    for (int j = 0; j < 2; ++j) { const u32x4 w = *(const u32x4*)(p + 8 * lane + 512 * j);
        v[2 * j] = (f32x4){bflo(w.x), bfhi(w.x), bflo(w.y), bfhi(w.y)}; v[2 * j + 1] = (f32x4){bflo(w.z), bfhi(w.z), bflo(w.w), bfhi(w.w)}; }
}
__device__ __forceinline__ float row_sumsq(const f32x4 (&v)[4]) {
    float s = 0.f;
#pragma unroll
    for (int j = 0; j < 4; ++j) s += (v[j].x * v[j].x + v[j].y * v[j].y) + (v[j].z * v[j].z + v[j].w * v[j].w);
    return s;
}
__device__ __forceinline__ void phase_norm(const float* xlat32, const bf16_t* X, const float* xctx, int nrows, const float* nw, const float* mod, int sh_off, int sc_off, bf16_t* H,
                                           const float* part, int npart, float* xc_store, bf16_t* xcopy) {
    const int tid = tid_opaque(), lane = tid & 63, wave = tid >> 6;
    const int gw = bid_opaque() * NWAVES + wave, NGW = gridDim.x * NWAVES;
    int cur_v = -1; f32x4 aw[4], shv[4];
#pragma unroll
    for (int j = 0; j < 4; ++j) { aw[j] = (f32x4){0.f, 0.f, 0.f, 0.f}; shv[j] = aw[j]; }
    for (int r = gw; r < nrows; r += 2 * NGW) {
        const int rowA = nrows - 1 - r, rowB0 = rowA - NGW;
        const bool hasB = rowB0 >= 0; const int rowB = hasB ? rowB0 : rowA;
        f32x4 va[4], vb[4];
        if (rowA >= MLAT) load_row_f32(va, xctx + (size_t)(rowA - MLAT) * D, lane);
        else if (xlat32) load_row_f32(va, xlat32 + (size_t)rowA * D, lane);
        else load_row_bf16(va, X + (size_t)rowA * D, lane);
        if (rowB >= MLAT) load_row_f32(vb, xctx + (size_t)(rowB - MLAT) * D, lane);
        else if (xlat32) load_row_f32(vb, xlat32 + (size_t)rowB * D, lane);
        else load_row_bf16(vb, X + (size_t)rowB * D, lane);
        if (rowA >= MLAT && npart > 0) {
            const float* pr = part + (size_t)(rowA - MLAT) * D;
            for (int k = 0; k < npart; k += 2) {
                f32x4 t0[4], t1[4];
                load_row_f32(t0, pr + (size_t)k * MCTX * D, lane); load_row_f32(t1, pr + (size_t)(k + 1) * MCTX * D, lane);
#pragma unroll
                for (int j = 0; j < 4; ++j) va[j] += t0[j] + t1[j];
            }
            float* xs = xc_store + (size_t)(rowA - MLAT) * D;
#pragma unroll
            for (int j = 0; j < 2; ++j) { *(f32x4*)(xs + 8 * lane + 512 * j) = va[2 * j]; *(f32x4*)(xs + 8 * lane + 512 * j + 4) = va[2 * j + 1]; }
        }
        if (xcopy) {
#pragma unroll
            for (int j = 0; j < 2; ++j) {
                if (rowA < MLAT) *(u32x4*)(xcopy + (size_t)rowA * D + 8 * lane + 512 * j) = (u32x4){pk2(va[2 * j].x, va[2 * j].y), pk2(va[2 * j].z, va[2 * j].w), pk2(va[2 * j + 1].x, va[2 * j + 1].y), pk2(va[2 * j + 1].z, va[2 * j + 1].w)};
                if (hasB && rowB < MLAT) *(u32x4*)(xcopy + (size_t)rowB * D + 8 * lane + 512 * j) = (u32x4){pk2(vb[2 * j].x, vb[2 * j].y), pk2(vb[2 * j].z, vb[2 * j].w), pk2(vb[2 * j + 1].x, vb[2 * j + 1].y), pk2(vb[2 * j + 1].z, vb[2 * j + 1].w)};
            }
        }
        float sa = row_sumsq(va), sb = row_sumsq(vb);
#pragma unroll
        for (int o = 1; o < 64; o <<= 1) { sa += __shfl_xor(sa, o); sb += __shfl_xor(sb, o); }
        const float ra = rsqrtf(sa * (1.0f / D) + EPS), rb = rsqrtf(sb * (1.0f / D) + EPS);
#pragma unroll 1
        for (int which = 0; which < 2; ++which) {
            if (which == 1 && !hasB) break;
            const int row = which ? rowB : rowA; const float rstd = which ? rb : ra;
            const int v = modvec_of_row(row);
            if (v != cur_v) {
                const float* mv = mod + v * NMODV;
#pragma unroll
                for (int j = 0; j < 4; ++j) { const int c = 8 * lane + 512 * (j >> 1) + 4 * (j & 1); aw[j] = *(const f32x4*)(nw + c) * (*(const f32x4*)(mv + sc_off + c) + 1.0f); shv[j] = *(const f32x4*)(mv + sh_off + c); }
                cur_v = v;
            }
#pragma unroll
            for (int j = 0; j < 2; ++j) {
                const f32x4 y0 = ((which ? vb[2 * j] : va[2 * j]) * rstd) * aw[2 * j] + shv[2 * j], y1 = ((which ? vb[2 * j + 1] : va[2 * j + 1]) * rstd) * aw[2 * j + 1] + shv[2 * j + 1];
                *(u32x4*)(H + (size_t)row * D + 8 * lane + 512 * j) = (u32x4){pk2(y0.x, y0.y), pk2(y0.z, y0.w), pk2(y1.x, y1.y), pk2(y1.z, y1.w)};
            }
        }
    }
}
__device__ __forceinline__ void phase_final(const bf16_t* X, float* out, const float* nw) {
    const int tid = tid_opaque(), lane = tid & 63, wave = tid >> 6;
    const int gw = bid_opaque() * NWAVES + wave, NGW = gridDim.x * NWAVES;
    f32x4 w[4];
    load_row_f32(w, nw, lane);
    for (int row = gw; row < MLAT; row += 2 * NGW) {
        const bool hasB = row + NGW < MLAT; const int rowB = hasB ? row + NGW : row;
        f32x4 va[4], vb[4];
        load_row_bf16(va, X + (size_t)row * D, lane); load_row_bf16(vb, X + (size_t)rowB * D, lane);
        float sa = row_sumsq(va), sb = row_sumsq(vb);
#pragma unroll
        for (int o = 1; o < 64; o <<= 1) { sa += __shfl_xor(sa, o); sb += __shfl_xor(sb, o); }
        const float ra = rsqrtf(sa * (1.0f / D) + EPS), rb = rsqrtf(sb * (1.0f / D) + EPS);
        float* oa = out + (size_t)row * D; float* ob = out + (size_t)rowB * D;
#pragma unroll
        for (int j = 0; j < 2; ++j) { *(f32x4*)(oa + 8 * lane + 512 * j) = (va[2 * j] * ra) * w[2 * j]; *(f32x4*)(oa + 8 * lane + 512 * j + 4) = (va[2 * j + 1] * ra) * w[2 * j + 1]; }
        if (hasB) {
#pragma unroll
            for (int j = 0; j < 2; ++j) { *(f32x4*)(ob + 8 * lane + 512 * j) = (vb[2 * j] * rb) * w[2 * j]; *(f32x4*)(ob + 8 * lane + 512 * j + 4) = (vb[2 * j + 1] * rb) * w[2 * j + 1]; }
        }
    }
}

constexpr int L_ZS = 0, L_GW = 8192, L_GB = 16384, L_SEG = 16896;
constexpr int BPITCH = 68;
constexpr int L_BF = 21504, L_BB = L_BF + 64 * BPITCH * 4;
constexpr int L_QEF = 56320, L_QEB = L_QEF + 9216, L_KIF = L_QEB + 9216, L_KIB = L_KIF + 9216, L_VT = L_KIB + 9216, L_PF = L_VT + 18432, L_PB = L_PF + 9216;
constexpr int PITCH = 72;
static_assert(L_PB + 9216 <= 131072, "GLA LDS map");

struct ChunkInfo { int r0, b, posf, posb, seg_lo, seg_hi; };
__device__ __forceinline__ ChunkInfo chunk_info(int cidx) {
    ChunkInfo ci;
    if (cidx < 256) { ci.b = cidx >> 7; const int c = cidx & 127; ci.r0 = cidx * 64; ci.posf = 4 + c; ci.posb = 4 + (127 - c); ci.seg_lo = ci.r0; ci.seg_hi = ci.r0 + 64; }
    else { const int cc = cidx - 256; ci.b = cc >> 2; const int j = cc & 3; ci.r0 = MLAT + cc * 64; ci.posf = j; ci.posb = 3 - j; ci.seg_lo = MLAT + ci.b * 256; ci.seg_hi = ci.seg_lo + 256; }
    return ci;
}
__device__ __forceinline__ float pick8(const f32x4& a, const f32x4& b, int i) { return i < 4 ? a[i & 3] : b[i & 3]; }
__device__ __forceinline__ float logsigmoidf(float x) { return fminf(x, 0.f) - 0.6931471806f * __builtin_amdgcn_logf(1.0f + __builtin_amdgcn_exp2f(-1.4426950409f * fabsf(x))); }

struct GFirst { u32x4 zf[4]; u32x4 k, q, v0, v1; };
__device__ __forceinline__ void gla_load_a(GFirst& R, const bf16_t* proj, int r0, int tid) {
    const int fr = tid & 15, fq = (tid >> 4) & 3;
#pragma unroll
    for (int tt = 0; tt < 4; ++tt) R.zf[tt] = *(const u32x4*)(proj + PZ + (size_t)(r0 + 16 * tt + fr) * 32 + 8 * fq);
}
struct GateConst { bf16x8 bfrag; float gbias; int h; };
__device__ __forceinline__ void gate_const(GateConst& gc, const float* gate_w, const float* gate_b, int h, int tid) {
    const int fr = tid & 15, fq = (tid >> 4) & 3, w = tid >> 6, d = w >> 2, n = h * 64 + (w & 3) * 16 + fr;
    float v[8];
#pragma unroll
    for (int j = 0; j < 8; ++j) v[j] = 0.f;
    if ((fq >> 1) == d) {
        const unsigned o = (unsigned)((d * 16 + 8 * (fq & 1)) * 256 + n);
#pragma unroll
        for (int j = 0; j < 8; ++j) v[j] = gate_w[o + (unsigned)(j * 256)];
    }
    const u32x4 p = (u32x4){pk2(v[0], v[1]), pk2(v[2], v[3]), pk2(v[4], v[5]), pk2(v[6], v[7])};
    gc.bfrag = __builtin_bit_cast(bf16x8, p);
    gc.gbias = gate_b[d * 256 + n]; gc.h = h;
}
template <bool WITH_Q>
__device__ __forceinline__ void gla_load_b(GFirst& R, const bf16_t* proj, int r0, int h, int tid) {
    const int t = tid & 63, cg = tid >> 6;
    const size_t hr = (size_t)h * MALL + (size_t)(r0 + t);
    R.k = *(const u32x4*)(proj + PK + hr * 64 + cg * 8);
    if (WITH_Q) R.q = *(const u32x4*)(proj + PQ + hr * 64 + cg * 8);
    R.v0 = *(const u32x4*)(proj + PV + hr * 128 + cg * 8);
    R.v1 = *(const u32x4*)(proj + PV + hr * 128 + 64 + cg * 8);
}
template <bool WITH_Q>
__device__ __forceinline__ void gla_load_first(GFirst& R, const bf16_t* proj, int r0, int h, int tid) {
    gla_load_a(R, proj, r0, tid); gla_load_b<WITH_Q>(R, proj, r0, h, tid);
}

__device__ __forceinline__ void gla_gates(const GFirst& R, const GateConst& gc, LAS unsigned char* lds, int tid) {
    const int lane = tid & 63, fr = lane & 15, fq = lane >> 4, w = tid >> 6, d = w >> 2, j = (w & 3) * 16 + fr;
    LAS float* BX = (LAS float*)(lds + (d ? L_BB : L_BF));
    float g[4][4];
#pragma unroll
    for (int tt = 0; tt < 4; ++tt) {
        const f32x4 acc = __builtin_amdgcn_mfma_f32_16x16x32_bf16(__builtin_bit_cast(bf16x8, R.zf[tt]), gc.bfrag, (f32x4){0.f, 0.f, 0.f, 0.f}, 0, 0, 0);
#pragma unroll
        for (int r = 0; r < 4; ++r) g[tt][r] = logsigmoidf(acc[r] + gc.gbias) * (1.0f / 16.0f);
    }
    if (d == 0) {
        float off = 0.f;
#pragma unroll
        for (int tt = 0; tt < 4; ++tt) {
            const float p0 = g[tt][0], p1 = p0 + g[tt][1], p2 = p1 + g[tt][2], p3 = p2 + g[tt][3];
            float s = p3; float v = __shfl(s, (lane - 16) & 63); s += fq >= 1 ? v : 0.f; v = __shfl(s, (lane - 32) & 63); s += fq >= 2 ? v : 0.f;
            const float e = off + (s - p3), tot = __shfl(s, 48 + fr);
            LAS float* bp = BX + (16 * tt + 4 * fq) * BPITCH + j;
            bp[0] = e + p0; bp[BPITCH] = e + p1; bp[2 * BPITCH] = e + p2; bp[3 * BPITCH] = e + p3;
            off += tot;
        }
    } else {
        float off = 0.f;
#pragma unroll
        for (int tt = 3; tt >= 0; --tt) {
            const float s3 = g[tt][3], s2 = s3 + g[tt][2], s1 = s2 + g[tt][1], s0 = s1 + g[tt][0];
            float s = s0; float v = __shfl(s, (lane + 16) & 63); s += fq <= 2 ? v : 0.f; v = __shfl(s, (lane + 32) & 63); s += fq <= 1 ? v : 0.f;
            const float e = off + (s - s0), tot = __shfl(s, fr);
            LAS float* bp = BX + (16 * tt + 4 * fq) * BPITCH + j;
            bp[0] = e + s0; bp[BPITCH] = e + s1; bp[2 * BPITCH] = e + s2; bp[3 * BPITCH] = e + s3;
            off += tot;
        }
    }
    __syncthreads();
}
__device__ __forceinline__ void gla_write_vt(const GFirst& R, LAS unsigned char* lds, int tid) {
    LAS bf16_t* VT = (LAS bf16_t*)(lds + L_VT); const int t = tid & 63, cg = tid >> 6;
    const unsigned a[4] = {R.v0.x, R.v0.y, R.v0.z, R.v0.w}, b[4] = {R.v1.x, R.v1.y, R.v1.z, R.v1.w};
#pragma unroll
    for (int i = 0; i < 4; ++i) {
        VT[(cg * 8 + 2 * i) * PITCH + t] = (bf16_t)(a[i] & 0xffffu); VT[(cg * 8 + 2 * i + 1) * PITCH + t] = (bf16_t)(a[i] >> 16);
        VT[(64 + cg * 8 + 2 * i) * PITCH + t] = (bf16_t)(b[i] & 0xffffu); VT[(64 + cg * 8 + 2 * i + 1) * PITCH + t] = (bf16_t)(b[i] >> 16);
    }
}

__device__ __forceinline__ void phase_gla_u(const Args& a, int l, LAS unsigned char* lds) {
    const int tid = tid_opaque(), lane = tid & 63, wave = tid >> 6;
    const bf16_t* proj = (const bf16_t*)(a.ws + WS_PROJ);
    bf16_t* U = (bf16_t*)a.out; float* DEC = (float*)(a.ws + WS_DEC);
    const float* gate_w = a.in[9] + (size_t)l * 2 * 16 * 256; const float* gate_b = a.in[10] + (size_t)l * 2 * 256;
    LAS float* BF = (LAS float*)(lds + L_BF); LAS float* BB = (LAS float*)(lds + L_BB);
    LAS bf16_t* KTF = (LAS bf16_t*)(lds + L_QEF); LAS bf16_t* KTB = (LAS bf16_t*)(lds + L_QEB); LAS bf16_t* VT = (LAS bf16_t*)(lds + L_VT);
    constexpr int NIT = 264 * 4;
    GFirst R; GateConst gc; gc.h = -1;
    if (bid_opaque() < NIT) { const ChunkInfo c0 = chunk_info(bid_opaque() >> 2); gla_load_first<false>(R, proj, c0.r0, bid_opaque() & 3, tid); }
#pragma unroll 1
    for (int it = bid_opaque(); it < NIT; it += gridDim.x) {
        const int cidx = it >> 2, h = it & 3; const ChunkInfo ci = chunk_info(cidx);
        const int itn = it + gridDim.x; const ChunkInfo cn = chunk_info((itn < NIT ? itn : it) >> 2);
        if (gc.h != h) gate_const(gc, gate_w, gate_b, h, tid);
        GFirst Rn;
#pragma unroll
        for (int tt = 0; tt < 4; ++tt) Rn.zf[tt] = R.zf[tt];
        if (itn < NIT) gla_load_a(Rn, proj, cn.r0, tid);
        gla_gates(R, gc, lds, tid);
        { const int t = tid & 63, cg = tid >> 6;
          const unsigned ww[4] = {R.k.x, R.k.y, R.k.z, R.k.w};
          const f32x4 bfa = *(const LAS f32x4*)(BF + t * BPITCH + cg * 8), bfb = *(const LAS f32x4*)(BF + t * BPITCH + cg * 8 + 4);
          const f32x4 bba = *(const LAS f32x4*)(BB + t * BPITCH + cg * 8), bbb = *(const LAS f32x4*)(BB + t * BPITCH + cg * 8 + 4);
          const f32x4 fla = *(const LAS f32x4*)(BF + 63 * BPITCH + cg * 8), flb = *(const LAS f32x4*)(BF + 63 * BPITCH + cg * 8 + 4);
          const f32x4 b0a = *(const LAS f32x4*)(BB + cg * 8), b0b = *(const LAS f32x4*)(BB + cg * 8 + 4);
#pragma unroll
          for (int i = 0; i < 8; ++i) { const int dk = cg * 8 + i; const float kf = (i & 1) ? bfhi(ww[i >> 1]) : bflo(ww[i >> 1]);
              KTF[dk * PITCH + t] = f2bf(kf * __expf(pick8(fla, flb, i) - pick8(bfa, bfb, i)));
              KTB[dk * PITCH + t] = f2bf(kf * __expf(pick8(b0a, b0b, i) - pick8(bba, bbb, i))); } }
        gla_write_vt(R, lds, tid);
        if (tid < 128) { const int d = tid >> 6, j = tid & 63;
            DEC[((size_t)((ci.b * 4 + h) * 2 + d) * NPOS + (d ? ci.posb : ci.posf)) * 64 + j] = __expf(d ? BB[j] : BF[63 * BPITCH + j]); }
        if (itn < NIT) gla_load_b<false>(R, proj, cn.r0, itn & 3, tid);
        __syncthreads();
        {
            const int dir = wave >> 2, jv = (wave & 3) * 32, fr = lane & 15, fq = lane >> 4;
            const LAS bf16_t* KT = dir ? KTB : KTF;
            bf16x8 af[4][2], bfr[2][2];
#pragma unroll
            for (int i = 0; i < 4; ++i)
#pragma unroll
                for (int ks = 0; ks < 2; ++ks) af[i][ks] = *(const LAS bf16x8*)(KT + (i * 16 + fr) * PITCH + ks * 32 + 8 * fq);
#pragma unroll
            for (int jt = 0; jt < 2; ++jt)
#pragma unroll
                for (int ks = 0; ks < 2; ++ks) bfr[jt][ks] = *(const LAS bf16x8*)(VT + (jv + jt * 16 + fr) * PITCH + ks * 32 + 8 * fq);
            bf16_t* Ub = U + ((size_t)((ci.b * 4 + h) * 2 + dir) * NPOS + (dir ? ci.posb : ci.posf)) * 8192 + (size_t)jv * 64;
            LAS unsigned char* wst = lds + (wave < 4 ? wave * 4608 : L_KIF + (wave - 4) * 4608);
#pragma unroll
            for (int i = 0; i < 4; ++i)
#pragma unroll
                for (int jt = 0; jt < 2; ++jt) {
                    f32x4 acc = (f32x4){0.f, 0.f, 0.f, 0.f};
#pragma unroll
                    for (int ks = 0; ks < 2; ++ks) acc = __builtin_amdgcn_mfma_f32_16x16x32_bf16(af[i][ks], bfr[jt][ks], acc, 0, 0, 0);
                    u32x2 o; o.x = pk2(acc[0], acc[1]); o.y = pk2(acc[2], acc[3]);
                    *(LAS u32x2*)(wst + (jt * 16 + fr) * 144 + (i * 16 + 4 * fq) * 2) = o;
                }
#pragma unroll
            for (int c4 = 0; c4 < 4; ++c4) {
                const int c = c4 * 64 + lane, row = c >> 3, piece = c & 7;
                const u32x4 w = *(const LAS u32x4*)(wst + row * 144 + piece * 16);
                *(u32x4*)(Ub + (size_t)c * 8) = w;
            }
        }
#pragma unroll
        for (int tt = 0; tt < 4; ++tt) R.zf[tt] = Rn.zf[tt];
    }
}

__device__ __forceinline__ void phase_gla_scan(const Args& a, LAS unsigned char* lds) {
    const unsigned* U = (const unsigned*)a.out; unsigned* S = (unsigned*)(a.ws + WS_S); const float* DEC = (const float*)(a.ws + WS_DEC);
    constexpr int SEGL = NPOS / 4;
    const int tid = tid_opaque(), lane = tid & 63, wave = tid >> 6, seg = wave & 3, grp = wave >> 2;
    LAS float* X = (LAS float*)lds;
    for (int bi = bid_opaque(); bi < 16 * 4096 / 128; bi += gridDim.x) {
        const int pidx = bi * 128 + grp * 64 + lane, seq = pidx >> 12, e2 = pidx & 4095, dk = (e2 * 2) & 63, pl = grp * 64 + lane;
        const unsigned* up = U + ((size_t)seq * NPOS + seg * SEGL) * 4096 + e2; unsigned* sp = S + ((size_t)seq * NPOS + seg * SEGL) * 4096 + e2;
        const float* dp = DEC + ((size_t)seq * NPOS + seg * SEGL) * 64 + dk;
        unsigned u[SEGL]; float d0[SEGL], d1[SEGL];
#pragma unroll
        for (int i = 0; i < SEGL; ++i) { u[i] = up[(size_t)i * 4096]; const float2 dd = *(const float2*)(dp + i * 64); d0[i] = dd.x; d1[i] = dd.y; }
        float s0 = 0.f, s1 = 0.f, c0 = 1.f, c1 = 1.f;
#pragma unroll
        for (int i = 0; i < SEGL; ++i) { s0 = d0[i] * s0 + bflo(u[i]); s1 = d1[i] * s1 + bfhi(u[i]); c0 *= d0[i]; c1 *= d1[i]; }
        X[(0 * 4 + seg) * 128 + pl] = s0; X[(1 * 4 + seg) * 128 + pl] = s1; X[(2 * 4 + seg) * 128 + pl] = c0; X[(3 * 4 + seg) * 128 + pl] = c1;
        __syncthreads();
        float k0 = 0.f, k1 = 0.f;
#pragma unroll
        for (int k = 0; k < 3; ++k) {
            if (k < seg) { k0 = X[(2 * 4 + k) * 128 + pl] * k0 + X[(0 * 4 + k) * 128 + pl]; k1 = X[(3 * 4 + k) * 128 + pl] * k1 + X[(1 * 4 + k) * 128 + pl]; }
        }
        s0 = k0; s1 = k1;
#pragma unroll
        for (int i = 0; i < SEGL; ++i) { sp[(size_t)i * 4096] = pk2(s0, s1); s0 = d0[i] * s0 + bflo(u[i]); s1 = d1[i] * s1 + bfhi(u[i]); }
        __syncthreads();
    }
}

template <int HALF>
__device__ __forceinline__ void pool_rows(const bf16_t* proj, bf16_t* Y, int c0, int t0, int seg_lo, int seg_hi) {
    constexpr int NR = 2 * HALF + 3;
    u32x4 uw[NR];
#pragma unroll
    for (int j = 0; j < NR; ++j) { const int rc = min(max(t0 - HALF + j, seg_lo), seg_hi - 1); uw[j] = *(const u32x4*)(proj + PP + (size_t)rc * 256 + c0); }
    float sm[8];
#pragma unroll
    for (int i = 0; i < 8; ++i) sm[i] = 0.f;
#pragma unroll
    for (int j = 0; j < NR; ++j) {
        const int rr = t0 - HALF + j; const bool inseg = rr >= seg_lo && rr < seg_hi;
        const unsigned uu[4] = {uw[j].x, uw[j].y, uw[j].z, uw[j].w};
        float uv[8];
#pragma unroll
        for (int i = 0; i < 4; ++i) { uv[2 * i] = inseg ? bflo(uu[i]) : 0.f; uv[2 * i + 1] = inseg ? bfhi(uu[i]) : 0.f; }
#pragma unroll
        for (int i = 0; i < 8; ++i) sm[i] += uv[i];
        if (j >= 2 * HALF - 1) {
            const int tt = j - (2 * HALF - 1), tk = t0 + tt, lo = max(tk - HALF, seg_lo), hi = min(tk + HALF, seg_hi);
            const float inv = 1.0f / (float)(hi - lo);
            const unsigned su[4] = {uw[HALF + tt].x, uw[HALF + tt].y, uw[HALF + tt].z, uw[HALF + tt].w};
            float pp[8];
#pragma unroll
            for (int i = 0; i < 8; ++i) pp[i] = sm[i] * inv - ((i & 1) ? bfhi(su[i >> 1]) : bflo(su[i >> 1]));
            *(u32x4*)(Y + (size_t)tk * D + 768 + c0) = (u32x4){pk2(pp[0], pp[1]), pk2(pp[2], pp[3]), pk2(pp[4], pp[5]), pk2(pp[6], pp[7])};
            const int jl = tt; const int rl = t0 - HALF + jl; const bool insl = rl >= seg_lo && rl < seg_hi;
            const unsigned ul[4] = {uw[jl].x, uw[jl].y, uw[jl].z, uw[jl].w};
#pragma unroll
            for (int i = 0; i < 4; ++i) { sm[2 * i] -= insl ? bflo(ul[i]) : 0.f; sm[2 * i + 1] -= insl ? bfhi(ul[i]) : 0.f; }
        }
    }
}

__device__ __forceinline__ void phase_gla_out(const Args& a, int l, int nchunks, LAS unsigned char* lds) {
    const int tid = tid_opaque(), lane = tid & 63, wave = tid >> 6, fr = lane & 15, fq = lane >> 4;
    const bf16_t* proj = (const bf16_t*)(a.ws + WS_PROJ);
    const bf16_t* S = (const bf16_t*)(a.ws + WS_S); bf16_t* Y = (bf16_t*)(a.ws + WS_Y);
    const float* gate_w = a.in[9] + (size_t)l * 2 * 16 * 256; const float* gate_b = a.in[10] + (size_t)l * 2 * 256;
    const float* gnw = a.in[11] + l * 128; const float* conv_w = a.in[12] + l * 3 * 256;
    LAS float* BF = (LAS float*)(lds + L_BF); LAS float* BB = (LAS float*)(lds + L_BB); LAS float* SSX = (LAS float*)(lds + L_SEG);
    LAS bf16_t* QEF = (LAS bf16_t*)(lds + L_QEF); LAS bf16_t* QEB = (LAS bf16_t*)(lds + L_QEB);
    LAS bf16_t* KIF = (LAS bf16_t*)(lds + L_KIF); LAS bf16_t* KIB = (LAS bf16_t*)(lds + L_KIB);
    LAS bf16_t* VT = (LAS bf16_t*)(lds + L_VT); LAS bf16_t* PF = (LAS bf16_t*)(lds + L_PF); LAS bf16_t* PB = (LAS bf16_t*)(lds + L_PB);
    const int n_gla = nchunks * 4;
    GFirst R; GateConst gc; gc.h = -1;
    const int Gd = (int)gridDim.x, bidv = bid_opaque();
    const int ig0 = bidv < n_gla ? bidv + ((n_gla - 1 - bidv) / Gd) * Gd : -1;
    const int itop = bidv < n_gla + nchunks ? bidv + ((n_gla + nchunks - 1 - bidv) / Gd) * Gd : -1;
    if (ig0 >= 0) { const ChunkInfo c0 = chunk_info(ig0 >> 2); gla_load_first<true>(R, proj, c0.r0, ig0 & 3, tid); }
#pragma unroll 1
    for (int it = itop; it >= 0; it -= Gd) {
        if (it < n_gla) {
            const int cidx = it >> 2, h = it & 3; const ChunkInfo ci = chunk_info(cidx);
            const int tt = wave & 3, trow = tt * 16 + fr;
            const int dvr = wave * 16 + fr;
            bf16x8 sfa[2], sba[2]; u32x2 rw[4];
            {
                const bf16_t* Sf = S + ((size_t)((ci.b * 4 + h) * 2 + 0) * NPOS + ci.posf) * 8192;
                const bf16_t* Sb = S + ((size_t)((ci.b * 4 + h) * 2 + 1) * NPOS + ci.posb) * 8192;
#pragma unroll
                for (int ks = 0; ks < 2; ++ks) { sfa[ks] = *(const bf16x8*)(Sf + (size_t)dvr * 64 + ks * 32 + 8 * fq); sba[ks] = *(const bf16x8*)(Sb + (size_t)dvr * 64 + ks * 32 + 8 * fq); }
#pragma unroll
                for (int t4 = 0; t4 < 4; ++t4) rw[t4] = *(const u32x2*)(proj + PR + ((size_t)h * MALL + (size_t)(ci.r0 + t4 * 16 + fr)) * 128 + wave * 16 + 4 * fq);
            }
            const int itn = it - Gd; const ChunkInfo cn = chunk_info((itn >= 0 ? itn : it) >> 2);
            if (gc.h != h) gate_const(gc, gate_w, gate_b, h, tid);
            GFirst Rn;
#pragma unroll
            for (int tt = 0; tt < 4; ++tt) Rn.zf[tt] = R.zf[tt];
            if (itn >= 0) gla_load_a(Rn, proj, cn.r0, tid);
            gla_gates(R, gc, lds, tid);
            { const int t = tid & 63, cg = tid >> 6;
              const unsigned qq[4] = {R.q.x, R.q.y, R.q.z, R.q.w}, kk[4] = {R.k.x, R.k.y, R.k.z, R.k.w};
              const f32x4 bfa = *(const LAS f32x4*)(BF + t * BPITCH + cg * 8), bfb = *(const LAS f32x4*)(BF + t * BPITCH + cg * 8 + 4);
              const f32x4 bba = *(const LAS f32x4*)(BB + t * BPITCH + cg * 8), bbb = *(const LAS f32x4*)(BB + t * BPITCH + cg * 8 + 4);
              unsigned oqf[4], oqb[4], okf[4], okb[4];
#pragma unroll
              for (int i = 0; i < 4; ++i) {
                  const float ef0 = __expf(pick8(bfa, bfb, 2 * i)), ef1 = __expf(pick8(bfa, bfb, 2 * i + 1)), eb0 = __expf(pick8(bba, bbb, 2 * i)), eb1 = __expf(pick8(bba, bbb, 2 * i + 1));
                  const float q0 = bflo(qq[i]) * 0.125f, q1 = bfhi(qq[i]) * 0.125f, k0 = bflo(kk[i]), k1 = bfhi(kk[i]);
                  oqf[i] = pk2(q0 * ef0, q1 * ef1); oqb[i] = pk2(q0 * eb0, q1 * eb1);
                  okf[i] = pk2(k0 * __builtin_amdgcn_rcpf(ef0), k1 * __builtin_amdgcn_rcpf(ef1)); okb[i] = pk2(k0 * __builtin_amdgcn_rcpf(eb0), k1 * __builtin_amdgcn_rcpf(eb1));
              }
              *(LAS u32x4*)(QEF + t * PITCH + cg * 8) = (u32x4){oqf[0], oqf[1], oqf[2], oqf[3]};
              *(LAS u32x4*)(QEB + t * PITCH + cg * 8) = (u32x4){oqb[0], oqb[1], oqb[2], oqb[3]};
              *(LAS u32x4*)(KIF + t * PITCH + cg * 8) = (u32x4){okf[0], okf[1], okf[2], okf[3]};
              *(LAS u32x4*)(KIB + t * PITCH + cg * 8) = (u32x4){okb[0], okb[1], okb[2], okb[3]}; }
            gla_write_vt(R, lds, tid);
            if (itn >= 0) gla_load_b<true>(R, proj, cn.r0, itn & 3, tid);
            __syncthreads();
            {
                const int dir = wave >> 2;
                const LAS bf16_t* KI = dir ? KIB : KIF; const LAS bf16_t* QE = dir ? QEB : QEF; LAS bf16_t* P = dir ? PB : PF;
                bf16x8 qb[2];
#pragma unroll
                for (int ks = 0; ks < 2; ++ks) qb[ks] = *(const LAS bf16x8*)(QE + trow * PITCH + ks * 32 + 8 * fq);
#pragma unroll
                for (int st = 0; st < 4; ++st) {
                    f32x4 acc = (f32x4){0.f, 0.f, 0.f, 0.f};
#pragma unroll
                    for (int ks = 0; ks < 2; ++ks) { const bf16x8 ka = *(const LAS bf16x8*)(KI + (st * 16 + fr) * PITCH + ks * 32 + 8 * fq);
                        acc = __builtin_amdgcn_mfma_f32_16x16x32_bf16(ka, qb[ks], acc, 0, 0, 0); }
                    const int s0 = st * 16 + 4 * fq;
#pragma unroll
                    for (int r = 0; r < 4; ++r) { const int s = s0 + r; const bool keep = dir ? (s >= trow) : (s <= trow); acc[r] = keep ? acc[r] : 0.f; }
                    u32x2 o; o.x = pk2(acc[0], acc[1]); o.y = pk2(acc[2], acc[3]);
                    *(LAS u32x2*)(P + trow * PITCH + s0) = o;
                }
            }
            __syncthreads();
            {
                f32x4 acc[4];
#pragma unroll
                for (int t4 = 0; t4 < 4; ++t4) acc[t4] = (f32x4){0.f, 0.f, 0.f, 0.f};
#pragma unroll
                for (int ks = 0; ks < 2; ++ks) {
                    const bf16x8 va = *(const LAS bf16x8*)(VT + dvr * PITCH + ks * 32 + 8 * fq);
#pragma unroll
                    for (int t4 = 0; t4 < 4; ++t4) {
                        const int tr = t4 * 16 + fr;
                        const bf16x8 pf = *(const LAS bf16x8*)(PF + tr * PITCH + ks * 32 + 8 * fq), pb = *(const LAS bf16x8*)(PB + tr * PITCH + ks * 32 + 8 * fq);
                        const bf16x8 qf = *(const LAS bf16x8*)(QEF + tr * PITCH + ks * 32 + 8 * fq), qb = *(const LAS bf16x8*)(QEB + tr * PITCH + ks * 32 + 8 * fq);
                        acc[t4] = __builtin_amdgcn_mfma_f32_16x16x32_bf16(va, pf, acc[t4], 0, 0, 0);
                        acc[t4] = __builtin_amdgcn_mfma_f32_16x16x32_bf16(va, pb, acc[t4], 0, 0, 0);
                        acc[t4] = __builtin_amdgcn_mfma_f32_16x16x32_bf16(sfa[ks], qf, acc[t4], 0, 0, 0);
                        acc[t4] = __builtin_amdgcn_mfma_f32_16x16x32_bf16(sba[ks], qb, acc[t4], 0, 0, 0);
                    }
                }
#pragma unroll
                for (int t4 = 0; t4 < 4; ++t4) {
                    float ss = (acc[t4][0] * acc[t4][0] + acc[t4][1] * acc[t4][1]) + (acc[t4][2] * acc[t4][2] + acc[t4][3] * acc[t4][3]);
                    ss += __shfl_xor(ss, 16); ss += __shfl_xor(ss, 32);
                    if (fq == 0) SSX[wave * 64 + t4 * 16 + fr] = ss;
                }
                __syncthreads();
                const f32x4 nw = *(const f32x4*)(gnw + wave * 16 + 4 * fq);
#pragma unroll
                for (int t4 = 0; t4 < 4; ++t4) {
                    const int tr = t4 * 16 + fr;
                    float tot = 0.f;
#pragma unroll
                    for (int w8 = 0; w8 < 8; ++w8) tot += SSX[w8 * 64 + tr];
                    const float rs = rsqrtf(tot * (1.0f / 128.0f) + EPS);
                    const float y0 = acc[t4][0] * rs * nw.x * siluf(bflo(rw[t4].x)), y1 = acc[t4][1] * rs * nw.y * siluf(bfhi(rw[t4].x));
                    const float y2 = acc[t4][2] * rs * nw.z * siluf(bflo(rw[t4].y)), y3 = acc[t4][3] * rs * nw.w * siluf(bfhi(rw[t4].y));
                    u32x2 o; o.x = pk2(y0, y1); o.y = pk2(y2, y3);
                    *(u32x2*)(Y + (size_t)(ci.r0 + tr) * D + h * 128 + wave * 16 + 4 * fq) = o;
                }
            }
#pragma unroll
            for (int t4 = 0; t4 < 4; ++t4) R.zf[t4] = Rn.zf[t4];
        } else {
            const ChunkInfo ci = chunk_info(it - n_gla);
            const int c0 = (tid & 31) * 8, t0 = ci.r0 + (tid >> 5) * 4;
            {
                float z[6][8];
#pragma unroll
                for (int j = 0; j < 6; ++j) {
                    const int rr = t0 + j - 1; const bool ok = rr >= ci.seg_lo && rr < ci.seg_hi; const int rc = min(max(rr, ci.seg_lo), ci.seg_hi - 1);
                    const u32x4 cw = *(const u32x4*)(proj + PC + (size_t)rc * 768 + 256 + c0), hw = *(const u32x4*)(proj + PC + (size_t)rc * 768 + 512 + c0);
                    const unsigned cc[4] = {cw.x, cw.y, cw.z, cw.w}, hh[4] = {hw.x, hw.y, hw.z, hw.w};
#pragma unroll
                    for (int i = 0; i < 4; ++i) { z[j][2 * i] = ok ? bflo(cc[i]) * bflo(hh[i]) : 0.f; z[j][2 * i + 1] = ok ? bfhi(cc[i]) * bfhi(hh[i]) : 0.f; }
                }
                float w0[8], w1[8], w2[8];
#pragma unroll
                for (int i = 0; i < 8; ++i) { w0[i] = conv_w[c0 + i]; w1[i] = conv_w[256 + c0 + i]; w2[i] = conv_w[512 + c0 + i]; }
#pragma unroll
                for (int tt = 0; tt < 4; ++tt) {
                    const u32x4 bw = *(const u32x4*)(proj + PC + (size_t)(t0 + tt) * 768 + c0);
                    const unsigned bbv[4] = {bw.x, bw.y, bw.z, bw.w};
                    float yc[8];
#pragma unroll
                    for (int i = 0; i < 8; ++i) { const float bgv = (i & 1) ? bfhi(bbv[i >> 1]) : bflo(bbv[i >> 1]); yc[i] = bgv * (w0[i] * z[tt][i] + w1[i] * z[tt + 1][i] + w2[i] * z[tt + 2][i]); }
                    *(u32x4*)(Y + (size_t)(t0 + tt) * D + 512 + c0) = (u32x4){pk2(yc[0], yc[1]), pk2(yc[2], yc[3]), pk2(yc[4], yc[5]), pk2(yc[6], yc[7])};
                }
            }
            {
                const int pg = __builtin_amdgcn_readfirstlane(wave & 3);
                const int pc0 = pg * 64 + (lane & 7) * 8, pt0 = ci.r0 + ((wave >> 2) * 8 + (lane >> 3)) * 4;
                if (pg == 0) pool_rows<1>(proj, Y, pc0, pt0, ci.seg_lo, ci.seg_hi);
                else if (pg == 1) pool_rows<2>(proj, Y, pc0, pt0, ci.seg_lo, ci.seg_hi);
                else if (pg == 2) pool_rows<4>(proj, Y, pc0, pt0, ci.seg_lo, ci.seg_hi);
                else pool_rows<8>(proj, Y, pc0, pt0, ci.seg_lo, ci.seg_hi);
            }
        }
    }
}

#define XB_TMO      128
#define XB_XCNT(j)  (256  + 64 * (j))
#define XB_XSUB(j)  (1280 + 64 * (j))
#define XB_XGEN(j)  (2304 + 64 * (j))
#define XB_TOP      3328
#define XB_TOPGEN   3392
#define XCD_BAR_WORDS 3456
#define XB_SPIN_CAP (1u << 18)

__device__ __forceinline__ unsigned xb_ld(unsigned* p)              { return __hip_atomic_load(p, __ATOMIC_RELAXED, __HIP_MEMORY_SCOPE_AGENT); }
__device__ __forceinline__ unsigned xb_add(unsigned* p, unsigned v) { return __hip_atomic_fetch_add(p, v, __ATOMIC_RELAXED, __HIP_MEMORY_SCOPE_AGENT); }
__device__ __forceinline__ unsigned xb_xcc_id() { return (unsigned)__builtin_amdgcn_s_getreg((3 << 11) | 20) & 0xFu; }
#define XB_SPIN(cond, bar) do { unsigned _sp = 0; while (cond) { __builtin_amdgcn_s_sleep(1); \
    if ((++_sp & 255u) == 0u) { if (xb_ld(&(bar)[XB_TMO])) break; if (_sp > XB_SPIN_CAP) { atomicAdd(&(bar)[XB_TMO], 1u); break; } } } } while (0)

struct XcdBarrier {
    unsigned* bar; unsigned x;
    volatile LAS unsigned* st;
};

__device__ __forceinline__ XcdBarrier xcd_barrier_post(unsigned* bar, volatile LAS unsigned* st) {
    XcdBarrier b; b.bar = bar; b.x = xb_xcc_id(); b.st = st;
    if (threadIdx.x == 0) (void)xb_add(&bar[XB_XCNT(b.x)], 1u);
    return b;
}
__device__ __forceinline__ void xcd_barrier_complete(unsigned* bar, unsigned x, unsigned& nloc, unsigned& nx) {
    const unsigned G = gridDim.x * gridDim.y * gridDim.z;
    unsigned sum, cnt, mine, sp = 0u;
    for (;;) {
        sum = 0u; cnt = 0u; mine = 0u;
#pragma unroll
        for (unsigned j = 0; j < 16; ++j) { const unsigned c = xb_ld(&bar[XB_XCNT(j)]); sum += c; cnt += (c > 0u) ? 1u : 0u; mine = (j == x) ? c : mine; }
        if (sum == G) break;
        __builtin_amdgcn_s_sleep(1);
        if ((++sp & 255u) == 0u) { if (xb_ld(&bar[XB_TMO])) break; if (sp > XB_SPIN_CAP) { atomicAdd(&bar[XB_TMO], 1u); break; } }
    }
    nloc = mine > 0u ? mine : 1u; nx = cnt > 0u ? cnt : 1u;
}

__device__ __forceinline__ void xcd_barrier(const XcdBarrier& b) {
    asm volatile("s_waitcnt vmcnt(0)" ::: "memory");
    __syncthreads();
    if (threadIdx.x == 0) {
        unsigned* bar = b.bar; asm volatile("" : "+s"(bar));
        __builtin_amdgcn_s_waitcnt(0);
        unsigned nloc = b.st[0], nx = b.st[1];
        if (nloc == 0u) { xcd_barrier_complete(bar, b.x, nloc, nx); b.st[0] = nloc; b.st[1] = nx; }
        const unsigned old = xb_add(&bar[XB_XSUB(b.x)], 1u);
        const unsigned gen = old / nloc;
        if (old + 1u == (gen + 1u) * nloc) {
            __builtin_amdgcn_fence(__ATOMIC_RELEASE, "agent");
            asm volatile("s_waitcnt vmcnt(0)" ::: "memory");
            const unsigned og = xb_add(&bar[XB_TOP], 1u);
            const unsigned tg = og / nx;
            if (og + 1u == (tg + 1u) * nx) xb_add(&bar[XB_TOPGEN], 1u);
            else XB_SPIN(xb_ld(&bar[XB_TOPGEN]) == tg, bar);
            __builtin_amdgcn_fence(__ATOMIC_ACQUIRE, "agent");
            xb_add(&bar[XB_XGEN(b.x)], 1u);
            asm volatile("s_waitcnt vmcnt(0)" ::: "memory");
        } else {
            XB_SPIN(xb_ld(&bar[XB_XGEN(b.x)]) == gen, bar);
            __builtin_amdgcn_fence(__ATOMIC_ACQUIRE, "agent");
            asm volatile("s_waitcnt vmcnt(0)" ::: "memory");
        }
    }
    __syncthreads();
}


__global__ void __launch_bounds__(NTHREADS, 2) hybrid_fwd(Args a) {
    extern __shared__ __attribute__((aligned(16))) unsigned char smem[];
    LAS unsigned char* lds = (LAS unsigned char*)smem;
    cg::grid_group grid = cg::this_grid();
    const int G = gridDim.x;
    volatile LAS unsigned* bst = (volatile LAS unsigned*)(lds + 131072 + 64);
    if (tid_opaque() < 2) bst[tid_opaque()] = 0u;
    __syncthreads();
    const XcdBarrier bar = xcd_barrier_post((unsigned*)(a.ws + WS_BAR), bst);
#pragma unroll 1
    for (int ph = a.ph_lo; ph < a.ph_hi; ++ph) {
      {
        unsigned char* ws = a.ws; asm volatile("" : "+s"(ws));
        float* MOD = (float*)(ws + WS_MOD);
        bf16_t* H = (bf16_t*)a.out; bf16_t* X = (bf16_t*)(ws + WS_X); bf16_t* PROJ = (bf16_t*)(ws + WS_PROJ); bf16_t* Yb = (bf16_t*)(ws + WS_Y); bf16_t* ACT = (bf16_t*)(ws + WS_ACT);
        float* XC = (float*)(ws + WS_XC);
        if (ph == 0) { phase_prep(a, lds); }
        else if (ph == NPHASES - 1) { phase_final(X, a.out, a.in[18]); }
        else {
            const int l = (ph - 1) / 9, sp = (ph - 1) % 9;
            const float* xctx = l == 0 ? a.in[2] : XC;
            const float* mod = MOD + l * 3 * NMODV;
            const int mrows = l == 0 ? MALL : MLAT;
            if (sp == 0) phase_norm(l == 0 ? a.in[0] : nullptr, X, xctx, MALL, a.in[6] + l * D, mod, 0, 1024, H, (const float*)(ws + WS_PART), l == 0 ? 0 : FF / 256, XC, l == 0 ? X : nullptr);
            else if (sp == 1) {
                pg8::Gemm g{H, (const bf16_t*)(ws + WS_WIN) + (size_t)l * INP * D, MALL, INP, D, D}; pg8::StaticOrder S; S.init(MALL, INP, G, bid_opaque()); S.ntk = D / 64;
                EpiProj E{PROJ}; pg8::gemm_phase<EpiProj, pg8::StaticOrder, GEMM_ALIGN, GEMM_SP2>(lds, g, S, E);
            }
            else if (sp == 2) phase_gla_u(a, l, lds);
            else if (sp == 3) phase_gla_scan(a, lds);
            else if (sp == 4) phase_gla_out(a, l, mrows / 64, lds);
            else if (sp == 5 || sp == 8) {
                const bool mix = sp == 5; const int KK = mix ? D : FF;
                const bf16_t* Ap = mix ? Yb : ACT; const bf16_t* Bp = mix ? (const bf16_t*)(ws + WS_WOUT) + (size_t)l * D * D : (const bf16_t*)(ws + WS_W2) + (size_t)l * D * FF;
                const float* gate = mod + (mix ? 2048 : 5120);
                pg8::Gemm g{Ap, Bp, MALL, D, KK, KK};
                pg8::MixedOrder S; S.lat.init(MLAT, D, G, bid_opaque()); S.lat.ntk = KK / 64; S.nks = l == 0 ? KK / 256 : 0; S.kslice = 256;
                EpiRes E{nullptr, X, (float*)(ws + WS_PART), gate};
                pg8::gemm_phase<EpiRes, pg8::MixedOrder, GEMM_ALIGN, GEMM_SP2>(lds, g, S, E);
            }
            else if (sp == 6) phase_norm(nullptr, X, l == 0 ? a.in[2] : (const float*)XC, mrows, a.in[7] + l * D, mod, 3072, 4096, H, (const float*)(ws + WS_PART), l == 0 ? D / 256 : 0, XC, nullptr);
            else {
                pg8::Gemm g{H, (const bf16_t*)(ws + WS_W1) + (size_t)l * FF * D, mrows, FF, D, D}; pg8::StaticOrder S; S.init(mrows, FF, G, bid_opaque()); S.ntk = D / 64;
                EpiAct E{ACT}; pg8::gemm_phase<EpiAct, pg8::StaticOrder, GEMM_ALIGN, GEMM_SP2>(lds, g, S, E);
            }
        }
      }
        if (ph + 1 < a.ph_hi) {
            if (a.ph_hi > NPHASES) {
                __builtin_amdgcn_fence(__ATOMIC_RELEASE, "agent"); asm volatile("s_waitcnt vmcnt(0)" ::: "memory");
                grid.sync();
                __builtin_amdgcn_fence(__ATOMIC_ACQUIRE, "agent"); asm volatile("s_waitcnt vmcnt(0)" ::: "memory");
            }
            xcd_barrier(bar);
        }
    }
}

extern "C" void kernel_launch(void* const* d_in, const int* in_sizes, int n_in, void* d_out, int out_size, void* d_ws, size_t ws_size, hipStream_t stream) {
    static int grid = 0;
    if (grid == 0) {
        int dev = 0, cus = 0, per_cu = 0;
        hipGetDevice(&dev);
        hipDeviceGetAttribute(&cus, hipDeviceAttributeMultiprocessorCount, dev);
        hipFuncSetAttribute((const void*)hybrid_fwd, hipFuncAttributeMaxDynamicSharedMemorySize, LDS_BYTES);
        hipOccupancyMaxActiveBlocksPerMultiprocessor(&per_cu, (const void*)hybrid_fwd, NTHREADS, LDS_BYTES);
        if (per_cu < 1) { fprintf(stderr, "kernel_launch: occupancy query reports %d blocks per CU\n", per_cu); per_cu = 1; }
        (void)hipGetLastError();
        grid = cus * per_cu;
        if (n_in != 19 || ws_size < WS_END) fprintf(stderr, "kernel_launch: unexpected n_in %d / ws_size %zu\n", n_in, ws_size);
    }
    (void)hipMemsetAsync((char*)d_ws + WS_BAR, 0, BAR_BYTES, stream);
    Args a{};
    for (int i = 0; i < 19; ++i) a.in[i] = (const float*)d_in[i];
    a.out = (float*)d_out; a.ws = (unsigned char*)d_ws;
    a.ph_lo = 0; a.ph_hi = NPHASES;
    void* args[] = {&a};
    hipError_t e = hipLaunchCooperativeKernel((const void*)hybrid_fwd, dim3(grid), dim3(NTHREADS), args, LDS_BYTES, stream);
    if (e != hipSuccess) fprintf(stderr, "cooperative launch failed: %s (grid %d)\n", hipGetErrorString(e), grid);
}
```
